# Optimizing an MI355X kernel written in HIP

```python
import jax
import jax.numpy as jnp
from jax import lax
import numpy as np

D_MODEL = 1024
BATCH = 8
SEQ = 4096
DEPTH = 4

CTX_LEN = 256
GRID_W = 64
HEAD_DIM = 64
EPS = 1e-6

GLA_HEADS = 4
GLA_DK = 64
GLA_DV = 128
GLA_RANK = 16
GLA_TAU = 16.0
GLA_CHUNK = 64

NA_HEADS = 8
NA_KH = 8
NA_KW = 16
NA_QCOLS = 16
NA_KCOLS = NA_QCOLS + NA_KW

SW_HEADS = 16
SW_KV_HEADS = 2
SW_WINDOW = 128
SW_BLOCK = 128
ROPE_BASE = 10000.0

N_EXPERTS = 32
TOP_K = 4
D_EXPERT = 1024
SWIGLU_LIMIT = 7.0
SWIGLU_ALPHA = 1.702
MOE_BLOCK = 512

N_EVEN = (DEPTH + 1) // 2
N_ODD = DEPTH // 2
GLA_QK = GLA_HEADS * GLA_DK
GLA_V = GLA_HEADS * GLA_DV
NA_W = NA_HEADS * HEAD_DIM
EVEN_IN = 2 * GLA_QK + 2 * GLA_V + 2 * GLA_RANK + 3 * NA_W
EVEN_MIX = GLA_V + NA_W
SW_Q = SW_HEADS * HEAD_DIM
SW_KV = SW_KV_HEADS * HEAD_DIM
ODD_IN = SW_Q + 2 * SW_KV
ODD_MIX = SW_Q

kernel_name = 'hybrid_gla_natten_swa_moe_dit'


def rmsnorm(x, g):
    xf = x.astype(jnp.float32)
    y = xf * lax.rsqrt(jnp.mean(xf * xf, axis=-1, keepdims=True) + EPS)
    return (y * g.astype(jnp.float32)).astype(x.dtype)


def split_heads(x, h):
    b, t, _ = x.shape
    return x.reshape(b, t, h, -1).transpose(0, 2, 1, 3)


def merge_heads(x):
    b, h, t, d = x.shape
    return x.transpose(0, 2, 1, 3).reshape(b, t, h * d)


def axial_rope(x):
    t = jnp.arange(x.shape[2])
    pos = jnp.stack([t // GRID_W, t % GRID_W], axis=-1).astype(jnp.float32)
    quarter = HEAD_DIM // 4
    inv_freq = ROPE_BASE ** (-jnp.arange(quarter, dtype=jnp.float32) / quarter)
    ang = pos[:, :, None] * inv_freq
    cos, sin = jnp.cos(ang), jnp.sin(ang)
    xa = x.astype(jnp.float32).reshape(*x.shape[:-1], 2, 2, quarter)
    x1, x2 = xa[..., 0, :], xa[..., 1, :]
    out = jnp.stack([x1 * cos - x2 * sin, x1 * sin + x2 * cos], axis=-2)
    return out.reshape(x.shape).astype(x.dtype)


def gla_chunked(q, k, v, log_a, s0):
    b, h, t, dk = q.shape
    dv = v.shape[-1]
    n = t // GLA_CHUNK

    def to_chunks(a):
        return a.reshape(b, h, n, GLA_CHUNK, a.shape[-1]).transpose(2, 0, 1, 3, 4)

    causal = jnp.tril(jnp.ones((GLA_CHUNK, GLA_CHUNK), dtype=bool))

    def step(s, inp):
        qc, kc, vc, gc = inp
        cum = jnp.cumsum(gc, axis=-2)
        o_inter = jnp.einsum('bhcd,bhde->bhce', qc * jnp.exp(cum), s)
        diff = cum[:, :, :, None, :] - cum[:, :, None, :, :]
        decay = jnp.exp(jnp.where(causal[:, :, None], diff, -jnp.inf))
        attn = jnp.einsum('bhid,bhjd,bhijd->bhij', qc, kc, decay)
        o = o_inter + jnp.einsum('bhij,bhje->bhie', attn, vc)
        last = cum[:, :, -1:, :]
        s_new = jnp.exp(last[:, :, 0, :, None]) * s + jnp.einsum('bhcd,bhce->bhde', kc * jnp.exp(last - cum), vc)
        return s_new, o

    s_fin, o = lax.scan(step, s0, (to_chunks(q), to_chunks(k), to_chunks(v), to_chunks(log_a)))
    return o.transpose(1, 2, 0, 3, 4).reshape(b, h, t, dv), s_fin


def bidirectional_gla(lat, ctx):
    ql, kl, vl, (al_f, al_b) = lat
    qc, kc, vc, (ac_f, ac_b) = ctx
    b, h, _, dk = ql.shape
    s0 = jnp.zeros((b, h, dk, vl.shape[-1]), ql.dtype)
    rev = lambda a: jnp.flip(a, axis=2)
    oc_f, sc_f = gla_chunked(qc, kc, vc, ac_f, s0)
    oc_b, sc_b = gla_chunked(rev(qc), rev(kc), rev(vc), rev(ac_b), s0)
    ol_f, _ = gla_chunked(ql, kl, vl, al_f, sc_f)
    ol_b, _ = gla_chunked(rev(ql), rev(kl), rev(vl), rev(al_b), sc_b)
    return ol_f + rev(ol_b), oc_f + rev(oc_b)


def gla_readout(o, gate, g_norm):
    return merge_heads(rmsnorm(o, g_norm)) * jax.nn.silu(gate)


def context_attention(q, k, v, sinks=None):
    b, hq, l, d = q.shape
    hkv = k.shape[1]
    g = hq // hkv
    s = jnp.einsum('bkgqd,bkld->bkgql', q.reshape(b, hkv, g, l, d), k).astype(jnp.float32) * d ** -0.5
    if sinks is not None:
        sink = jnp.broadcast_to(sinks.astype(jnp.float32).reshape(1, hkv, g, 1, 1), s.shape[:-1] + (1,))
        s = jnp.concatenate([s, sink], axis=-1)
    p = jax.nn.softmax(s, axis=-1)[..., :l].astype(v.dtype)
    return jnp.einsum('bkgql,bkld->bkgqd', p, v).reshape(b, hq, l, d)


def neighbourhood_attention(q, k, v, kc, vc, rpb):
    b, h, s_len, d = q.shape
    rows = s_len // GRID_W
    kh = min(NA_KH, rows)
    r = np.arange(rows)
    row_idx = np.clip(r - kh // 2, 0, rows - kh)[:, None] + np.arange(kh)[None, :]
    d_row = row_idx - r[:, None]
    qg, kg, vg = (a.reshape(b, h, rows, GRID_W, d) for a in (q, k, v))
    scale = d ** -0.5
    s_ctx = jnp.einsum('bhrcd,bhld->bhrcl', qg, kc).astype(jnp.float32) * scale
    outs = []
    for cb in range(GRID_W // NA_QCOLS):
        c0 = cb * NA_QCOLS
        q_cols = c0 + np.arange(NA_QCOLS)
        k0 = int(np.clip(c0 - NA_KW // 2, 0, GRID_W - NA_KCOLS))
        k_cols = k0 + np.arange(NA_KCOLS)
        win0 = np.clip(q_cols - NA_KW // 2, 0, GRID_W - NA_KW)
        valid = (k_cols[None, :] >= win0[:, None]) & (k_cols[None, :] < win0[:, None] + NA_KW)
        d_col = np.clip(k_cols[None, :] - q_cols[:, None], -(NA_KW - 1), NA_KW - 1)
        kb = kg[:, :, :, k0:k0 + NA_KCOLS][:, :, row_idx]
        vb = vg[:, :, :, k0:k0 + NA_KCOLS][:, :, row_idx]
        qb = qg[:, :, :, c0:c0 + NA_QCOLS]
        s_nb = jnp.einsum('bhrqd,bhrjkd->bhrqjk', qb, kb).astype(jnp.float32) * scale
        bias = rpb[:, (d_row + NA_KH - 1)[:, None, :, None], (d_col + NA_KW - 1)[None, :, None, :]]
        s_nb = jnp.where(valid[:, None, :], s_nb + bias.astype(jnp.float32), -jnp.inf)
        s_nb = s_nb.reshape(b, h, rows, NA_QCOLS, kh * NA_KCOLS)
        p = jax.nn.softmax(jnp.concatenate([s_nb, s_ctx[:, :, :, c0:c0 + NA_QCOLS]], axis=-1), axis=-1).astype(v.dtype)
        p_nb = p[..., :kh * NA_KCOLS].reshape(b, h, rows, NA_QCOLS, kh, NA_KCOLS)
        o = jnp.einsum('bhrqjk,bhrjkd->bhrqd', p_nb, vb) + jnp.einsum('bhrql,bhld->bhrqd', p[..., kh * NA_KCOLS:], vc)
        outs.append(o)
    return jnp.concatenate(outs, axis=3).reshape(b, h, s_len, d)


def window_attention(q, k, v, kc, vc, sinks):
    b, hq, s_len, d = q.shape
    g = hq // SW_KV_HEADS
    nb = s_len // SW_BLOCK
    l = kc.shape[2]
    qb = q.reshape(b, SW_KV_HEADS, g, nb, SW_BLOCK, d)

    def bands(a):
        ap = jnp.pad(a, ((0, 0), (0, 0), (SW_BLOCK, SW_BLOCK), (0, 0)))
        return jnp.concatenate([ap[:, :, i * SW_BLOCK:i * SW_BLOCK + s_len].reshape(b, SW_KV_HEADS, nb, SW_BLOCK, d)
                                for i in range(3)], axis=3)

    kb, vb = bands(k), bands(v)
    qpos = jnp.arange(s_len).reshape(nb, SW_BLOCK)
    kpos = (jnp.arange(nb)[:, None] - 1) * SW_BLOCK + jnp.arange(3 * SW_BLOCK)[None, :]
    mask = ((jnp.abs(qpos[:, :, None] - kpos[:, None, :]) <= SW_WINDOW)
            & (kpos[:, None, :] >= 0) & (kpos[:, None, :] < s_len))
    scale = d ** -0.5
    s_loc = jnp.einsum('bkgnqd,bknjd->bkgnqj', qb, kb).astype(jnp.float32) * scale
    s_loc = jnp.where(mask, s_loc, -jnp.inf)
    s_ctx = jnp.einsum('bkgnqd,bkld->bkgnql', qb, kc).astype(jnp.float32) * scale
    sink = jnp.broadcast_to(sinks.astype(jnp.float32).reshape(1, SW_KV_HEADS, g, 1, 1, 1), s_loc.shape[:-1] + (1,))
    p = jax.nn.softmax(jnp.concatenate([s_loc, s_ctx, sink], axis=-1), axis=-1).astype(v.dtype)
    nk = 3 * SW_BLOCK
    o = (jnp.einsum('bkgnqj,bknjd->bkgnqd', p[..., :nk], vb)
         + jnp.einsum('bkgnql,bkld->bkgnqd', p[..., nk:nk + l], vc))
    return o.reshape(b, hq, s_len, d)


def even_mixer(h_lat, h_ctx, w_in, w_out, gla_w_a2, gla_b_a2, gla_norm_g, na_q_g, na_k_g, na_rpb, with_ctx):
    cuts = [int(v) for v in np.cumsum([GLA_QK, GLA_QK, GLA_V, GLA_V, GLA_RANK, GLA_RANK, NA_W, NA_W])]

    def project(h):
        q, k, v, gate, a_f, a_b, nq, nk, nv = jnp.split(h @ w_in, cuts, axis=-1)
        log_a = tuple(split_heads(jax.nn.log_sigmoid(a @ gla_w_a2[i] + gla_b_a2[i]) / GLA_TAU, GLA_HEADS)
                      for i, a in enumerate((a_f, a_b)))
        gla = (split_heads(q, GLA_HEADS) * GLA_DK ** -0.5, split_heads(k, GLA_HEADS), split_heads(v, GLA_HEADS), log_a)
        na = (rmsnorm(split_heads(nq, NA_HEADS), na_q_g), rmsnorm(split_heads(nk, NA_HEADS), na_k_g),
              split_heads(nv, NA_HEADS))
        return gla, gate, na

    gla_l, gate_l, (nq_l, nk_l, nv_l) = project(h_lat)
    gla_c, gate_c, (nq_c, nk_c, nv_c) = project(h_ctx)
    o_gla_l, o_gla_c = bidirectional_gla(gla_l, gla_c)
    o_na_l = neighbourhood_attention(nq_l, nk_l, nv_l, nk_c, nv_c, na_rpb)
    out_l = jnp.concatenate([gla_readout(o_gla_l, gate_l, gla_norm_g), merge_heads(o_na_l)], axis=-1) @ w_out
    if not with_ctx:
        return out_l, None
    o_na_c = context_attention(nq_c, nk_c, nv_c)
    out_c = jnp.concatenate([gla_readout(o_gla_c, gate_c, gla_norm_g), merge_heads(o_na_c)], axis=-1) @ w_out
    return out_l, out_c


def odd_mixer(h_lat, h_ctx, w_in, w_out, q_g, k_g, sinks, with_ctx):
    def project(h):
        q, k, v = jnp.split(h @ w_in, [SW_Q, SW_Q + SW_KV], axis=-1)
        return (rmsnorm(split_heads(q, SW_HEADS), q_g), rmsnorm(split_heads(k, SW_KV_HEADS), k_g),
                split_heads(v, SW_KV_HEADS))

    q_l, k_l, v_l = project(h_lat)
    q_c, k_c, v_c = project(h_ctx)
    o_l = window_attention(axial_rope(q_l), axial_rope(k_l), v_l, k_c, v_c, sinks)
    out_l = merge_heads(o_l) @ w_out
    if not with_ctx:
        return out_l, None
    out_c = merge_heads(context_attention(q_c, k_c, v_c, sinks)) @ w_out
    return out_l, out_c


def moe(h, w_router, b_router, w_gate_up, b_gate_up, w_down, b_down):
    t, d = h.shape
    logits = (h @ w_router + b_router).astype(jnp.float32)
    top_vals, top_idx = lax.top_k(logits, TOP_K)
    weights = jax.nn.softmax(top_vals, axis=-1).astype(h.dtype)
    flat_e = top_idx.reshape(-1)
    flat_tok = jnp.repeat(jnp.arange(t, dtype=jnp.int32), TOP_K)
    flat_w = weights.reshape(-1)
    order = jnp.argsort(flat_e)
    e_sorted = flat_e[order]
    counts = jnp.bincount(flat_e, length=N_EXPERTS)
    padded = (counts + MOE_BLOCK - 1) // MOE_BLOCK * MOE_BLOCK
    start = jnp.cumsum(counts) - counts
    pend = jnp.cumsum(padded)
    pstart = pend - padded
    slot = pstart[e_sorted] + (jnp.arange(t * TOP_K) - start[e_sorted])
    n_blocks = (t * TOP_K + MOE_BLOCK - 1) // MOE_BLOCK + N_EXPERTS
    n_slots = n_blocks * MOE_BLOCK
    slot_tok = jnp.full((n_slots,), t, jnp.int32).at[slot].set(flat_tok[order])
    slot_w = jnp.zeros((n_slots,), h.dtype).at[slot].set(flat_w[order])
    h_pad = jnp.concatenate([h, jnp.zeros((1, d), h.dtype)], axis=0)
    xs = h_pad[slot_tok].reshape(n_blocks, MOE_BLOCK, d)
    block_e = jnp.minimum(jnp.searchsorted(pend, jnp.arange(n_blocks) * MOE_BLOCK, side='right'), N_EXPERTS - 1)

    def expert_block(args):
        xb, e = args
        gu = xb @ w_gate_up[e] + b_gate_up[e]
        glu, lin = jnp.split(gu, 2, axis=-1)
        glu = jnp.minimum(glu, SWIGLU_LIMIT)
        lin = jnp.clip(lin, -SWIGLU_LIMIT, SWIGLU_LIMIT)
        act = glu * jax.nn.sigmoid(SWIGLU_ALPHA * glu) * (lin + 1.0)
        return act @ w_down[e] + b_down[e]

    ys = lax.map(expert_block, (xs, block_e)).reshape(n_slots, d)
    out = jnp.zeros((t + 1, d), h.dtype).at[slot_tok].add(ys * slot_w[:, None])
    return out[:t]


def setup_inputs(seed: int = 0) -> dict:
    key = jax.random.key(seed)
    keys = iter(jax.random.split(key, 40))

    def nrm(shape, scale):
        return scale * jax.random.normal(next(keys), shape, jnp.float32)

    d = D_MODEL
    return {
        'x': nrm((BATCH, SEQ, d), 1.0),
        'c': nrm((BATCH, d), 1.0),
        'ctx': nrm((BATCH, CTX_LEN, d), 1.0),
        'c_ctx': nrm((d,), 1.0),
        'mod_w': nrm((DEPTH, d, 6 * d), 0.5 * d ** -0.5),
        'mod_b': nrm((DEPTH, 6 * d), 0.02),
        'norm_mix_g': 1.0 + nrm((DEPTH, d), 0.05),
        'norm_ffn_g': 1.0 + nrm((DEPTH, d), 0.05),
        'ev_w_in': nrm((N_EVEN, d, EVEN_IN), d ** -0.5),
        'ev_w_out': nrm((N_EVEN, EVEN_MIX, d), EVEN_MIX ** -0.5),
        'ev_gla_w_a2': nrm((N_EVEN, 2, GLA_RANK, GLA_QK), GLA_RANK ** -0.5),
        'ev_gla_b_a2': nrm((N_EVEN, 2, GLA_QK), 0.5),
        'ev_gla_norm_g': 1.0 + nrm((N_EVEN, GLA_DV), 0.05),
        'ev_na_q_g': 1.0 + nrm((N_EVEN, HEAD_DIM), 0.05),
        'ev_na_k_g': 1.0 + nrm((N_EVEN, HEAD_DIM), 0.05),
        'ev_na_rpb': nrm((N_EVEN, NA_HEADS, 2 * NA_KH - 1, 2 * NA_KW - 1), 0.1),
        'od_w_in': nrm((N_ODD, d, ODD_IN), d ** -0.5),
        'od_w_out': nrm((N_ODD, ODD_MIX, d), ODD_MIX ** -0.5),
        'od_q_g': 1.0 + nrm((N_ODD, HEAD_DIM), 0.05),
        'od_k_g': 1.0 + nrm((N_ODD, HEAD_DIM), 0.05),
        'od_sinks': nrm((N_ODD, SW_HEADS), 0.5),
        'moe_w_router': nrm((DEPTH, d, N_EXPERTS), d ** -0.5),
        'moe_b_router': nrm((DEPTH, N_EXPERTS), 0.01),
        'moe_w_gate_up': nrm((DEPTH, N_EXPERTS, d, 2 * D_EXPERT), d ** -0.5),
        'moe_b_gate_up': nrm((DEPTH, N_EXPERTS, 2 * D_EXPERT), 0.02),
        'moe_w_down': nrm((DEPTH, N_EXPERTS, D_EXPERT, d), D_EXPERT ** -0.5),
        'moe_b_down': nrm((DEPTH, N_EXPERTS, d), 0.02),
    }


def reference(x, c, ctx, c_ctx, mod_w, mod_b, norm_mix_g, norm_ffn_g,
              ev_w_in, ev_w_out, ev_gla_w_a2, ev_gla_b_a2, ev_gla_norm_g, ev_na_q_g, ev_na_k_g, ev_na_rpb,
              od_w_in, od_w_out, od_q_g, od_k_g, od_sinks,
              moe_w_router, moe_b_router, moe_w_gate_up, moe_b_gate_up, moe_w_down, moe_b_down):
    b, s_len, d = x.shape
    l = ctx.shape[1]
    silu_c = jax.nn.silu(c)
    silu_cc = jax.nn.silu(c_ctx)
    for layer in range(DEPTH):
        with_ctx = layer < DEPTH - 1
        idx = layer // 2
        m_lat = (silu_c @ mod_w[layer] + mod_b[layer])[:, None, :]
        m_ctx = silu_cc @ mod_w[layer] + mod_b[layer]
        sh1, sc1, g1, sh2, sc2, g2 = jnp.split(m_lat, 6, axis=-1)
        csh1, csc1, cg1, csh2, csc2, cg2 = jnp.split(m_ctx, 6, axis=-1)
        h_lat = rmsnorm(x, norm_mix_g[layer]) * (1.0 + sc1) + sh1
        h_ctx = rmsnorm(ctx, norm_mix_g[layer]) * (1.0 + csc1) + csh1
        if layer % 2 == 0:
            o_lat, o_ctx = even_mixer(h_lat, h_ctx, ev_w_in[idx], ev_w_out[idx], ev_gla_w_a2[idx], ev_gla_b_a2[idx],
                                      ev_gla_norm_g[idx], ev_na_q_g[idx], ev_na_k_g[idx], ev_na_rpb[idx], with_ctx)
        else:
            o_lat, o_ctx = odd_mixer(h_lat, h_ctx, od_w_in[idx], od_w_out[idx], od_q_g[idx], od_k_g[idx],
                                     od_sinks[idx], with_ctx)
        x = x + g1 * o_lat
        f_lat = (rmsnorm(x, norm_ffn_g[layer]) * (1.0 + sc2) + sh2).reshape(b * s_len, d)
        moe_args = (moe_w_router[layer], moe_b_router[layer], moe_w_gate_up[layer], moe_b_gate_up[layer],
                    moe_w_down[layer], moe_b_down[layer])
        if with_ctx:
            ctx = ctx + cg1 * o_ctx
            f_ctx = (rmsnorm(ctx, norm_ffn_g[layer]) * (1.0 + csc2) + csh2).reshape(b * l, d)
            y = moe(jnp.concatenate([f_lat, f_ctx], axis=0), *moe_args)
            x = x + g2 * y[:b * s_len].reshape(b, s_len, d)
            ctx = ctx + cg2 * y[b * s_len:].reshape(b, l, d)
        else:
            x = x + g2 * moe(f_lat, *moe_args).reshape(b, s_len, d)
    return x
```

```cpp
#include <hip/hip_runtime.h>
#include <cstdio>
#include <cstdint>

#define LAS __attribute__((address_space(3)))
#define GAS __attribute__((address_space(1)))
#define DI __device__ __forceinline__
typedef unsigned short bf16_t;
typedef short bf16x8 __attribute__((ext_vector_type(8)));
typedef short s16x4 __attribute__((ext_vector_type(4)));
typedef float f32x2 __attribute__((ext_vector_type(2)));
typedef float f32x4 __attribute__((ext_vector_type(4)));
typedef float f32x16 __attribute__((ext_vector_type(16)));
typedef unsigned u32x2 __attribute__((ext_vector_type(2)));
typedef unsigned u32x4 __attribute__((ext_vector_type(4)));
typedef __bf16 bf16x2_t __attribute__((ext_vector_type(2)));

constexpr int D = 1024, NBATCH = 8, SEQ = 4096, CTXL = 256, DEPTH = 4;
constexpr int TLAT = NBATCH * SEQ, TCTX = NBATCH * CTXL, TALL = TLAT + TCTX;
constexpr int EVEN_IN = 3104, EVEN_LD = 3328, ODD_IN = 1280;
constexpr int NEXP = 32, TOPK = 4, DEXP = 1024;
constexpr int C_Q = 0, C_K = 256, C_V = 512, C_G = 1024, C_NQ = 1536, C_NK = 2048, C_NV = 2560, C_AF = 3072, C_AB = 3088;
DI size_t pidx(int tok, int col) { return ((size_t)(col >> 6) * TALL + tok) * 64 + (col & 63); }
constexpr int O_Q = 0, O_K = 1024, O_V = 1152;
constexpr float EPS = 1e-6f;
constexpr float LOG2E = 1.4426950408889634f;

constexpr size_t MiB = 1u << 20;
constexpr size_t WS_CTL = 0, CTL_ZERO_BYTES = 1 * MiB;
constexpr size_t WS_MODV = 1 * MiB;
constexpr size_t WS_WGU = 2 * MiB;
constexpr size_t WS_WDN = WS_WGU + 512 * MiB;
constexpr size_t WS_WINE = WS_WDN + 256 * MiB;
constexpr size_t WS_WINO = WS_WINE + 13 * MiB;
constexpr size_t WS_WOUT = WS_WINO + 5 * MiB;
constexpr size_t WS_X = WS_WOUT + 8 * MiB;
constexpr size_t WS_H = WS_X + 136 * MiB;
constexpr size_t WS_PRJ = WS_H + 68 * MiB;
constexpr size_t WS_OMIX = WS_PRJ + 221 * MiB;
constexpr size_t WS_ACT = WS_OMIX + 68 * MiB;
constexpr size_t WS_Y = WS_ACT + 288 * MiB;
constexpr size_t WS_LIST = WS_Y + 272 * MiB;
constexpr size_t WS_WTOK = WS_LIST + 5 * MiB;
constexpr size_t WS_GU = WS_WTOK + 5 * MiB;
constexpr size_t WS_GD = WS_GU + 136 * MiB;
constexpr size_t WS_GS = WS_GD + 2 * MiB;
constexpr size_t WS_GQ = WS_GS + 68 * MiB;
constexpr size_t WS_GK = WS_GQ + 34 * MiB;
constexpr size_t WS_RTB = WS_GK + 34 * MiB;
constexpr size_t WS_RTBIAS = WS_MODV + 917504;
constexpr size_t WS_END = WS_RTB + 5 * MiB;
static_assert(TALL * (size_t)D * 4 <= 136 * MiB && TALL * (size_t)EVEN_LD * 2 <= 221 * MiB && (size_t)TALL * 4 * D * 2 <= 272 * MiB, "ws map");
constexpr int CW_BAR = 4096;
constexpr int CW_CNT = 8192;

constexpr int RING_BYTES = 131072;
constexpr int MISC_OFF = RING_BYTES;
constexpr int MISC_BYTES = 12288;
constexpr int LDS_BYTES = 9 * 16896 + 8192 + 1264 + 16;
constexpr int XB_OFF = LDS_BYTES - 16;
static_assert(MISC_OFF + MISC_BYTES <= XB_OFF && 9 * 16896 + 8192 <= XB_OFF && XB_OFF + 16 <= LDS_BYTES && LDS_BYTES <= 163840 && XB_OFF % 16 == 0, "LDS map");

DI unsigned f2bf(float f) { unsigned u = __builtin_bit_cast(unsigned, f); return (u + 0x7fffu + ((u >> 16) & 1u)) >> 16; }
DI unsigned pk2(float lo, float hi) { f32x2 v = {lo, hi}; bf16x2_t b = __builtin_convertvector(v, bf16x2_t); return __builtin_bit_cast(unsigned, b); }
DI float bflo(unsigned u) { return __builtin_bit_cast(float, u << 16); }
DI float bfhi(unsigned u) { return __builtin_bit_cast(float, u & 0xffff0000u); }
DI float bf2f(bf16_t b) { return __builtin_bit_cast(float, ((unsigned)b) << 16); }
DI float wave_sum(float v) {
#pragma unroll
    for (int o = 1; o < 64; o <<= 1) v += __shfl_xor(v, o);
    return v;
}
DI float xhalf_max(float x) { const auto rr = __builtin_amdgcn_permlane32_swap(__builtin_bit_cast(unsigned, x), __builtin_bit_cast(unsigned, x), false, false); return fmaxf(__builtin_bit_cast(float, rr[0]), __builtin_bit_cast(float, rr[1])); }
DI float xhalf_sum(float x) { const auto rr = __builtin_amdgcn_permlane32_swap(__builtin_bit_cast(unsigned, x), __builtin_bit_cast(unsigned, x), false, false); return __builtin_bit_cast(float, rr[0]) + __builtin_bit_cast(float, rr[1]); }
DI float dpp_xor1(float x) { return __builtin_bit_cast(float, __builtin_amdgcn_update_dpp(0, __builtin_bit_cast(int, x), 0xB1, 0xF, 0xF, true)); }
DI float dpp_xor2(float x) { return __builtin_bit_cast(float, __builtin_amdgcn_update_dpp(0, __builtin_bit_cast(int, x), 0x4E, 0xF, 0xF, true)); }
DI float dpp_hmirror(float x) { return __builtin_bit_cast(float, __builtin_amdgcn_update_dpp(0, __builtin_bit_cast(int, x), 0x141, 0xF, 0xF, true)); }
#define LDS_WAIT() asm volatile("s_waitcnt lgkmcnt(0)" ::: "memory")
#define VM_WAIT() asm volatile("s_waitcnt vmcnt(0)" ::: "memory")

#define XB_TMO      128
#define XB_XCNT(j)  (256  + 64 * (j))
#define XB_XSUB(j)  (1280 + 64 * (j))
#define XB_XGEN(j)  (2304 + 64 * (j))
#define XB_TOP      3328
#define XB_TOPGEN   3392
#define XCD_BAR_WORDS 3456
#define XB_SPIN_CAP (1u << 22)
DI unsigned xb_ld(unsigned* p)              { return __hip_atomic_load(p, __ATOMIC_RELAXED, __HIP_MEMORY_SCOPE_AGENT); }
DI unsigned xb_add(unsigned* p, unsigned v) { return __hip_atomic_fetch_add(p, v, __ATOMIC_RELAXED, __HIP_MEMORY_SCOPE_AGENT); }
DI unsigned xb_xcc_id() { return (unsigned)__builtin_amdgcn_s_getreg((3 << 11) | 20) & 0xFu; }
#define XB_SPIN(cond, bar) do { unsigned _sp = 0; while (cond) { __builtin_amdgcn_s_sleep(1); \
    if ((++_sp & 255u) == 0u) { if (xb_ld(&(bar)[XB_TMO])) break; if (_sp > XB_SPIN_CAP) { atomicAdd(&(bar)[XB_TMO], 1u); break; } } } } while (0)
struct XcdBarrier { unsigned* bar; unsigned x; volatile LAS unsigned* st; int wave; };
DI bool xb_first(int wave) { return wave == 0 && __builtin_amdgcn_mbcnt_hi(~0u, __builtin_amdgcn_mbcnt_lo(~0u, 0u)) == 0u; }
DI XcdBarrier xcd_barrier_post(unsigned* bar, volatile LAS unsigned* st, int wave) {
    XcdBarrier b; b.bar = bar; b.x = xb_xcc_id(); b.st = st; b.wave = wave;
    if (xb_first(wave)) (void)xb_add(&bar[XB_XCNT(b.x)], 1u);
    return b;
}
DI void xcd_barrier_complete(unsigned* bar, unsigned x, unsigned& nloc, unsigned& nx) {
    const unsigned G = gridDim.x * gridDim.y * gridDim.z;
    unsigned sum, cnt, mine, sp = 0u;
    for (;;) {
        sum = 0u; cnt = 0u; mine = 0u;
#pragma unroll
        for (unsigned j = 0; j < 16; ++j) { const unsigned c = xb_ld(&bar[XB_XCNT(j)]); sum += c; cnt += (c > 0u) ? 1u : 0u; mine = (j == x) ? c : mine; }
        if (sum == G) break;
        __builtin_amdgcn_s_sleep(1);
        if ((++sp & 255u) == 0u) { if (xb_ld(&bar[XB_TMO])) break; if (sp > XB_SPIN_CAP) { atomicAdd(&bar[XB_TMO], 1u); break; } }
    }
    nloc = mine > 0u ? mine : 1u; nx = cnt > 0u ? cnt : 1u;
}
DI void xcd_barrier(const XcdBarrier& b) {
    asm volatile("s_waitcnt vmcnt(0)" ::: "memory");
    __syncthreads();
    if (xb_first(b.wave)) {
        unsigned* bar = b.bar;
        __builtin_amdgcn_s_waitcnt(0);
        unsigned nloc = b.st[0], nx = b.st[1];
        if (nloc == 0u) { xcd_barrier_complete(bar, b.x, nloc, nx); b.st[0] = nloc; b.st[1] = nx; }
        const unsigned old = xb_add(&bar[XB_XSUB(b.x)], 1u);
        const unsigned gen = old / nloc;
        if (old + 1u == (gen + 1u) * nloc) {
            __builtin_amdgcn_fence(__ATOMIC_RELEASE, "agent");
            asm volatile("s_waitcnt vmcnt(0)" ::: "memory");
            const unsigned og = xb_add(&bar[XB_TOP], 1u);
            const unsigned tg = og / nx;
            if (og + 1u == (tg + 1u) * nx) xb_add(&bar[XB_TOPGEN], 1u);
            else XB_SPIN(xb_ld(&bar[XB_TOPGEN]) == tg, bar);
            __builtin_amdgcn_fence(__ATOMIC_ACQUIRE, "agent");
            xb_add(&bar[XB_XGEN(b.x)], 1u);
            asm volatile("s_waitcnt vmcnt(0)" ::: "memory");
        } else {
            XB_SPIN(xb_ld(&bar[XB_XGEN(b.x)]) == gen, bar);
            __builtin_amdgcn_fence(__ATOMIC_ACQUIRE, "agent");
            asm volatile("s_waitcnt vmcnt(0)" ::: "memory");
        }
    }
    __syncthreads();
}

namespace pg8 {
constexpr int BM = 256, BK = 64, HALF = 128, HTB = HALF * BK * 2, STAGE_BYTES = 8 * HTB, NXCD = 8, WGM = 8, KDIM = 1024, NT = KDIM / BK;
DI int lds_byte(int r, int c) { const int st = (r >> 4) * 2 + (c >> 5), rr = r & 15, cc = c & 31, ob = rr * 64 + cc * 2; return st * 1024 + (ob ^ (((ob >> 9) & 1) << 5)); }
DI void stage_rc(int b, int& R, int& C) { const int st = b / 1024, sb = b % 1024, swz = sb ^ (((sb >> 9) & 1) << 5); R = (st >> 1) * 16 + swz / 64; C = (st & 1) * 32 + (swz % 64) / 2; }
DI int perm32(int rho) { const int n = rho >> 4, i = rho & 15; return 8 * (i >> 2) + 4 * n + (i & 3); }

struct Unit { const char* A; const char* B; int r0, c0, e, nvalid; const int* gl; const float* wl; };
struct TileOrder {
    int nM, nN, nwg, G, c;
    DI void init(int nM_, int nN_, int G_, int c_) { nM = nM_; nN = nN_; nwg = nM * nN; G = G_; c = c_; }
    DI bool tile(int i, int& pm, int& pn) const {
        const long L = (long)i * G + c; if (L >= nwg) return false;
        int wgid = (int)L; { const int q = nwg / NXCD, r = nwg % NXCD, xcd = wgid % NXCD, off = wgid / NXCD; wgid = (xcd < r ? xcd * (q + 1) : r * (q + 1) + (xcd - r) * q) + off; }
        const int nig = WGM * nN, gid = wgid / nig, fm = gid * WGM, gsz = (nM - fm) < WGM ? (nM - fm) : WGM;
        pm = fm + ((wgid % nig) % gsz); pn = (wgid % nig) / gsz; return true;
    }
};

template <class Epi, class Sched, bool GATHER>
DI void gemm_phase(LAS unsigned char* lds, const Sched& S, const Epi& E, const int wave_sgpr, LAS unsigned* side) {
    int tid = wave_sgpr * 64 + (int)__builtin_amdgcn_mbcnt_hi(~0u, __builtin_amdgcn_mbcnt_lo(~0u, 0u)); asm volatile("" : "+v"(tid));
    const int wid = __builtin_amdgcn_readfirstlane(tid >> 6), lane = tid & 63, wr = wid >> 2, wc = wid & 3, fr = lane & 15, fq = lane >> 4;
    constexpr int K = KDIM, nt = NT;
    unsigned voffA, voffB;
    { int R, C; stage_rc(tid * 16, R, C); const int Rb = Epi::PERM ? ((R & ~31) + perm32(R & 31)) : R;
      voffA = GATHER ? (unsigned)(C * 2) : (unsigned)(R * K + C) * 2u; voffB = (unsigned)(Rb * K + C) * 2u; }
    constexpr size_t pstep = (size_t)64 * K * 2;
    constexpr size_t kstep = (size_t)(BK * 2);
    constexpr size_t hstep = (size_t)HALF * K * 2;
    const unsigned ldsw = (unsigned)wid * 1024u;
    const int aoff = lds_byte(wr * 64 + fr, fq * 8), boff = lds_byte(wc * 32 + fr, fq * 8);
#define PG8_SA(b, h) (((b) * 2 + (h)) * HTB)
#define PG8_SB(b, h) ((4 + (b) * 2 + (h)) * HTB)
#define PG8_STAGE(bufoff, gbase, voff) do { _Pragma("unroll") for (int _i = 0; _i < 2; ++_i) \
        __builtin_amdgcn_global_load_lds((const unsigned*)((const char*)(gbase) + (size_t)_i * pstep + (voff)), (LAS unsigned*)(lds + (bufoff) + ldsw + _i * 8192), 16, 0, 0); } while (0)
#define PG8_STAGE_A(bufoff, gbase, ko, h, go) do { _Pragma("unroll") for (int _i = 0; _i < 2; ++_i) \
        __builtin_amdgcn_global_load_lds((const unsigned*)((const char*)(gbase) + (ko) + (GATHER ? (size_t)(go)[h][_i] : (size_t)(h) * hstep + (size_t)_i * pstep) + voffA), (LAS unsigned*)(lds + (bufoff) + ldsw + _i * 8192), 16, 0, 0); } while (0)
#define PG8_LDA(dst, b, h) do { _Pragma("unroll") for (int m = 0; m < 4; ++m) _Pragma("unroll") for (int k = 0; k < 2; ++k) dst[m][k] = *(const LAS bf16x8*)(lds + PG8_SA(b, h) + aoff + m * 2048 + k * 1024); } while (0)
#define PG8_LDB(dst, b, h) do { _Pragma("unroll") for (int n = 0; n < 2; ++n) _Pragma("unroll") for (int k = 0; k < 2; ++k) dst[n][k] = *(const LAS bf16x8*)(lds + PG8_SB(b, h) + boff + n * 2048 + k * 1024); } while (0)
#define PG8_MMA(ai, bj, At, Bt) do { __builtin_amdgcn_s_setprio(1); _Pragma("unroll") for (int m = 0; m < 4; ++m) _Pragma("unroll") for (int n = 0; n < 2; ++n) _Pragma("unroll") for (int k = 0; k < 2; ++k) \
        acc[ai][bj][m][n] = __builtin_amdgcn_mfma_f32_16x16x32_bf16(Bt[n][k], At[m][k], acc[ai][bj][m][n], 0, 0, 0); __builtin_amdgcn_s_setprio(0); } while (0)
#define PG8_WAIT_V(n) asm volatile("s_waitcnt vmcnt(" #n ")" ::: "memory")
#define PG8_WAIT_L(n) asm volatile("s_waitcnt lgkmcnt(" #n ")" ::: "memory")
#define PG8_BAR __builtin_amdgcn_s_barrier()
#define PG8_SCHED __builtin_amdgcn_sched_barrier(0)
    Unit cur, nxt; int ui = 0;
    if (!S.next(0, cur)) return;
    f32x4 acc[2][2][4][2];
#pragma unroll
    for (int a = 0; a < 2; ++a)
#pragma unroll
        for (int b = 0; b < 2; ++b)
#pragma unroll
            for (int m = 0; m < 4; ++m)
#pragma unroll
                for (int n = 0; n < 2; ++n) acc[a][b][m][n] = (f32x4){0.f, 0.f, 0.f, 0.f};
    bf16x8 At[4][2], B0[2][2], B1[2][2];
    unsigned gc[2][2] = {{0u, 0u}, {0u, 0u}}, gn[2][2] = {{0u, 0u}, {0u, 0u}};
    if (GATHER) {
#pragma unroll
        for (int i = 0; i < 2; ++i) { int R, C; stage_rc(tid * 16 + i * 8192, R, C);
#pragma unroll
            for (int h = 0; h < 2; ++h) gc[h][i] = S.goff(cur, h * HALF + R); }
#pragma unroll
        for (int i = 0; i < 2; ++i)
#pragma unroll
            for (int h = 0; h < 2; ++h) gc[h][i] = Sched::gbytes(gc[h][i]);
    }
    const char* cA = cur.A; const char* cB = cur.B;
    PG8_STAGE(PG8_SB(0, 0), cB, voffB); PG8_STAGE(PG8_SB(0, 1), cB + hstep, voffB); PG8_STAGE_A(PG8_SA(0, 0), cA, 0, 0, gc); PG8_STAGE_A(PG8_SA(0, 1), cA, 0, 1, gc);
    if (wr == 1) PG8_BAR;
    PG8_WAIT_V(2); PG8_BAR;
    PG8_STAGE(PG8_SB(1, 0), cB + kstep, voffB); PG8_STAGE_A(PG8_SA(1, 0), cA, kstep, 0, gc); PG8_STAGE(PG8_SB(1, 1), cB + hstep + kstep, voffB);
    PG8_WAIT_V(6); PG8_BAR;
    for (;;) {
        LAS unsigned* side_u = side + (ui & 1) * 768;
        if (Epi::NSIDE > 0 && wid < 4) E.side_issue(cur, tid, side_u);
        const bool has_next = S.next(ui + 1, nxt);
        const char* nA = has_next ? nxt.A : cA; const char* nB = has_next ? nxt.B : cB;
        for (int t = 0; t < nt; t += 2) {
            const bool last = (t == nt - 2);
            if (GATHER && t == nt - 6) {
                int t2 = tid; asm volatile("" : "+v"(t2));
#pragma unroll
                for (int i = 0; i < 2; ++i) { int R, C; stage_rc(t2 * 16 + i * 8192, R, C);
#pragma unroll
                    for (int h = 0; h < 2; ++h) gn[h][i] = S.goff(has_next ? nxt : cur, h * HALF + R); }
            }
            const size_t k1 = (size_t)(t + 1) * kstep;
            const char* a2 = last ? nA : cA; const size_t ka2 = last ? 0 : (size_t)(t + 2) * kstep;
            const char* b2 = last ? nB : cB + (size_t)(t + 2) * kstep;
            const char* b3 = b2 + kstep;
            PG8_LDB(B0, 0, 0); PG8_LDB(B1, 0, 1); PG8_SCHED; PG8_LDA(At, 0, 0); PG8_STAGE_A(PG8_SA(1, 1), cA, k1, 1, gc);
            if (GATHER && last) {
#pragma unroll
                for (int h = 0; h < 2; ++h)
#pragma unroll
                    for (int i = 0; i < 2; ++i) gc[h][i] = Sched::gbytes(gn[h][i]);
            }
            PG8_WAIT_V(8); PG8_WAIT_L(0); PG8_BAR; PG8_MMA(0, 0, At, B0); PG8_MMA(0, 1, At, B1); PG8_BAR; PG8_SCHED;
            PG8_LDA(At, 0, 1); PG8_STAGE(PG8_SB(0, 0), b2, voffB); PG8_STAGE(PG8_SB(0, 1), b2 + hstep, voffB); PG8_STAGE_A(PG8_SA(0, 0), a2, ka2, 0, gc);
            PG8_WAIT_V(8); PG8_WAIT_L(0); PG8_BAR; PG8_MMA(1, 0, At, B0); PG8_MMA(1, 1, At, B1); PG8_BAR; PG8_SCHED;
            PG8_LDB(B0, 1, 0); PG8_LDB(B1, 1, 1); PG8_SCHED; PG8_LDA(At, 1, 0); PG8_STAGE_A(PG8_SA(0, 1), a2, ka2, 1, gc);
            PG8_WAIT_V(8); PG8_WAIT_L(0); PG8_BAR; PG8_MMA(0, 0, At, B0); PG8_MMA(0, 1, At, B1); PG8_BAR; PG8_SCHED;
            PG8_LDA(At, 1, 1); PG8_STAGE(PG8_SB(1, 0), b3, voffB); PG8_STAGE(PG8_SB(1, 1), b3 + hstep, voffB); PG8_STAGE_A(PG8_SA(1, 0), a2, ka2 + kstep, 0, gc);
            PG8_WAIT_V(8); PG8_WAIT_L(0); PG8_BAR; PG8_MMA(1, 0, At, B0); PG8_MMA(1, 1, At, B1); PG8_BAR; PG8_SCHED;
        }
        if (wr == 0) PG8_BAR;
        E(acc, cur, wr, wc, fr, fq, side_u);
        if (!has_next) break;
#pragma unroll
        for (int a = 0; a < 2; ++a)
#pragma unroll
            for (int b = 0; b < 2; ++b)
#pragma unroll
                for (int m = 0; m < 4; ++m)
#pragma unroll
                    for (int n = 0; n < 2; ++n) acc[a][b][m][n] = (f32x4){0.f, 0.f, 0.f, 0.f};
        cur = nxt; cA = nA; cB = nB; ++ui;
        if (wr == 1) PG8_BAR;
    }
    PG8_WAIT_V(0);
    PG8_BAR;
#undef PG8_SA
#undef PG8_SB
#undef PG8_STAGE
#undef PG8_STAGE_A
#undef PG8_LDA
#undef PG8_LDB
#undef PG8_MMA
#undef PG8_WAIT_V
#undef PG8_WAIT_L
#undef PG8_BAR
#undef PG8_SCHED
}
}

struct Frame {
    LAS unsigned char* lds;
    unsigned* ctl;
    unsigned char* ws;
    const float* const* in;
    float* out;
    int wave, G, blk;
};
DI int lane_id() { return (int)__builtin_amdgcn_mbcnt_hi(~0u, __builtin_amdgcn_mbcnt_lo(~0u, 0u)); }
DI const float* inp(const Frame& F, int i) {
    const unsigned long long v = (unsigned long long)F.in[i];
    const unsigned lo = __builtin_amdgcn_readfirstlane((unsigned)v), hi = __builtin_amdgcn_readfirstlane((unsigned)(v >> 32));
    return (const float*)(((unsigned long long)hi << 32) | lo);
}
DI float* modv(const Frame& F, int l, int r) { return (float*)(F.ws + WS_MODV) + ((size_t)l * 9 + r) * 6144; }
DI int bidx_of(int row) { return row < TLAT ? (row >> 12) : 8; }

struct CvtRegs { f32x4 v[16]; };
DI void convert_load(CvtRegs& R, const float* src, int ld, int nvalid, int lane) {
    const int c4 = (lane & 15) * 4, kr = lane >> 4;
#pragma unroll
    for (int i = 0; i < 16; ++i) R.v[i] = (c4 < nvalid) ? __builtin_nontemporal_load((const f32x4*)(src + (size_t)(kr + 4 * i) * ld + c4)) : (f32x4){0.f, 0.f, 0.f, 0.f};
}
DI void convert_store(const CvtRegs& R, int nvalid, bf16_t* dst, LAS float* scr, int lane, bf16_t* dst_hi = nullptr) {
    const int c4 = (lane & 15) * 4, kr = lane >> 4;
#pragma unroll
    for (int i = 0; i < 16; ++i) { LAS float* p = scr + (kr + 4 * i) * 65 + c4; p[0] = R.v[i][0]; p[1] = R.v[i][1]; p[2] = R.v[i][2]; p[3] = R.v[i][3]; }
    LDS_WAIT(); asm volatile("" ::: "memory");
#pragma unroll
    for (int j = 0; j < 8; ++j) {
        const int q = lane + 64 * j, n = q >> 3, c8 = q & 7;
        const LAS float* s = scr + (8 * c8) * 65 + n;
        u32x4 o; o.x = pk2(s[0], s[65]); o.y = pk2(s[2 * 65], s[3 * 65]); o.z = pk2(s[4 * 65], s[5 * 65]); o.w = pk2(s[6 * 65], s[7 * 65]);
        if (n < nvalid) *(u32x4*)(((dst_hi && n >= 32) ? dst_hi : dst) + (size_t)n * 1024 + 8 * c8) = o;
    }
    LDS_WAIT(); asm volatile("" ::: "memory");
}
DI void convert_tile(const float* src, int ld, int nvalid, bf16_t* dst, LAS float* scr, int lane, bf16_t* dst_hi = nullptr) {
    CvtRegs R; convert_load(R, src, ld, nvalid, lane); convert_store(R, nvalid, dst, scr, lane, dst_hi);
}
DI float silu_f(float x) { return x / (1.f + __expf(-x)); }
DI void convert_moe_layer(const Frame& F, int l, int bidx, int nblk) {
    const int lane = lane_id();
    LAS float* scr = (LAS float*)(F.lds + F.wave * 16640);
    const int gw = bidx * 8 + F.wave, NGW = nblk * 8;
    constexpr int T_GU = 32 * 512, T_DN = 32 * 256;
    const float* gu = inp(F, 23) + (size_t)l * 32 * 1024 * 2048; const float* dn = inp(F, 25) + (size_t)l * 32 * 1024 * 1024;
    bf16_t* wgu = (bf16_t*)(F.ws + WS_WGU) + (size_t)l * 32 * 2048 * 1024; bf16_t* wdn = (bf16_t*)(F.ws + WS_WDN) + (size_t)l * 32 * 1024 * 1024;
    auto tsrc = [&](int t, int& ld) -> const float* { if (t < T_GU) { const int mat = t >> 9, kb = (t >> 5) & 15, nb = t & 31; ld = 2048; return gu + (size_t)mat * 1024 * 2048 + (size_t)(kb * 64) * 2048 + nb * 64; }
        const int r = t - T_GU, mat = r >> 8, kb = (r >> 4) & 15, nb = r & 15; ld = 1024; return dn + (size_t)mat * 1024 * 1024 + (size_t)(kb * 64) * 1024 + nb * 64; };
    auto tdst = [&](int t) -> bf16_t* { if (t < T_GU) { const int mat = t >> 9, kb = (t >> 5) & 15, nb = t & 31, n0 = nb * 64;
            const int drow = n0 < 1024 ? ((n0 >> 7) * 256 + (n0 & 127)) : ((((n0 - 1024) >> 7) * 256) + 128 + ((n0 - 1024) & 127));
            return wgu + (size_t)mat * 2048 * 1024 + (size_t)drow * 1024 + kb * 64; }
        const int r = t - T_GU, mat = r >> 8, kb = (r >> 4) & 15, nb = r & 15; return wdn + (size_t)mat * 1024 * 1024 + (size_t)(nb * 64) * 1024 + kb * 64; };
    constexpr int NT_ALL = T_GU + T_DN;
    CvtRegs RA, RB; int ld;
    if (gw < NT_ALL) { const float* sp = tsrc(gw, ld); convert_load(RA, sp, ld, 64, lane); }
    for (int t = gw; t < NT_ALL; t += 2 * NGW) {
        const int t1 = t + NGW, t2 = t + 2 * NGW;
        if (t1 < NT_ALL) { const float* sp = tsrc(t1, ld); convert_load(RB, sp, ld, 64, lane); }
        convert_store(RA, 64, tdst(t), scr, lane);
        if (t1 < NT_ALL) {
            if (t2 < NT_ALL) { const float* sp = tsrc(t2, ld); convert_load(RA, sp, ld, 64, lane); }
            convert_store(RB, 64, tdst(t1), scr, lane);
        }
    }
}
DI void convert_small(const Frame& F) {
    const int lane = lane_id();
    LAS float* scr = (LAS float*)(F.lds + F.wave * 16640);
    const int gw = F.blk * 8 + F.wave, NGW = F.G * 8;
    constexpr int T_WO = 4 * 256, T_WE = 2 * 16 * 49, T_WD = 2 * 16 * 20;
    for (int t = gw; t < T_WO + T_WE + T_WD; t += NGW) {
        int r = t;
        if (r < T_WO) { const int l = r >> 8, kb = (r >> 4) & 15, nb = r & 15; const float* src = ((l & 1) ? inp(F, 17) : inp(F, 9)) + (size_t)(l >> 1) * 1024 * 1024;
            convert_tile(src + (size_t)(kb * 64) * 1024 + nb * 64, 1024, 64, (bf16_t*)(F.ws + WS_WOUT) + (size_t)l * 1024 * 1024 + (size_t)(nb * 64) * 1024 + kb * 64, scr, lane); continue; }
        r -= T_WO;
        if (r < T_WE) { const int i = r / (16 * 49), q = r % (16 * 49), kb = q / 49, nb = q % 49; const int nv = (EVEN_IN - nb * 64) < 64 ? (EVEN_IN - nb * 64) : 64;
            const int n0 = nb * 64, d0 = n0 < 1536 ? n0 : (n0 == 1536 ? 3072 : n0 - 32), d1 = n0 == 1536 ? 1536 : d0 + 32;
            bf16_t* wb = (bf16_t*)(F.ws + WS_WINE) + (size_t)i * EVEN_LD * 1024 + kb * 64;
            convert_tile(inp(F, 8) + (size_t)i * 1024 * EVEN_IN + (size_t)(kb * 64) * EVEN_IN + n0, EVEN_IN, nv, wb + (size_t)d0 * 1024, scr, lane, wb + (size_t)(d1 - 32) * 1024); continue; }
        r -= T_WE;
        { const int i = r / (16 * 20), q = r % (16 * 20), kb = q / 20, nb = q % 20;
            convert_tile(inp(F, 16) + (size_t)i * 1024 * ODD_IN + (size_t)(kb * 64) * ODD_IN + nb * 64, ODD_IN, 64, (bf16_t*)(F.ws + WS_WINO) + (size_t)i * ODD_IN * 1024 + (size_t)(nb * 64) * 1024 + kb * 64, scr, lane); }
    }
}
DI void phase_p0(const Frame& F) {
    const int lane = lane_id(), tid = F.wave * 64 + lane; (void)tid; (void)lane;
    for (int item = F.blk; item < 96; item += F.G) {
        const int l = item / 24, cc = item % 24;
        LAS float* sil = (LAS float*)F.lds;
        LAS float* part = (LAS float*)(F.lds + 36864);
        for (int i = tid; i < 9 * 1024; i += 512) { const int r = i >> 10, k = i & 1023; const float c = r < 8 ? inp(F, 1)[r * 1024 + k] : inp(F, 3)[k]; sil[i] = silu_f(c); }
        __syncthreads();
        const float* W = inp(F, 4) + (size_t)l * 1024 * 6144 + cc * 256 + 4 * lane;
        f32x4 acc[9];
#pragma unroll
        for (int r = 0; r < 9; ++r) acc[r] = (f32x4){0.f, 0.f, 0.f, 0.f};
        for (int k = 128 * F.wave; k < 128 * F.wave + 128; ++k) {
            const f32x4 w = *(const f32x4*)(W + (size_t)k * 6144);
#pragma unroll
            for (int r = 0; r < 9; ++r) { const float s = sil[r * 1024 + k]; acc[r] += w * s; }
        }
#pragma unroll
        for (int r = 0; r < 9; ++r) *(LAS f32x4*)(part + (F.wave * 9 + r) * 256 + 4 * lane) = acc[r];
        __syncthreads();
        for (int i = tid; i < 9 * 256; i += 512) { const int r = i >> 8, c = i & 255; float s = 0.f;
#pragma unroll
            for (int w = 0; w < 8; ++w) s += part[(w * 9 + r) * 256 + c];
            modv(F, l, r)[cc * 256 + c] = s + inp(F, 5)[l * 6144 + cc * 256 + c]; }
        __syncthreads();
    }
    convert_small(F);
    convert_moe_layer(F, 0, F.blk, F.G);
}

DI void norm_mod_store(const f32x4 (&v)[4], float rs, const float* gam, const float* mv_sh, const float* mv_sc, bf16_t* orow, int lane) {
#pragma unroll
    for (int j = 0; j < 4; ++j) {
        const int c = 4 * lane + 256 * j;
        const f32x4 g = *(const f32x4*)(gam + c), sc = *(const f32x4*)(mv_sc + c), sh = *(const f32x4*)(mv_sh + c);
        const f32x4 h = v[j] * rs * g * (sc + 1.0f) + sh;
        u32x2 o; o.x = pk2(h[0], h[1]); o.y = pk2(h[2], h[3]);
        *(u32x2*)(orow + c) = o;
    }
}
DI void phase_norm1_l0(const Frame& F) {
    const int lane = lane_id(), tid = F.wave * 64 + lane; (void)tid; (void)lane;
    {
        float* rtb = (float*)(F.ws + WS_RTB); float* rtbias = (float*)(F.ws + WS_RTBIAS);
        const float* gam2 = inp(F, 7); const float* wr_all = inp(F, 21); const float* br_all = inp(F, 22);
        const int gt = F.blk * 512 + tid, NGT = F.G * 512;
        for (int i = gt; i < 4 * 9 * 1024 * 32; i += NGT) { const int e = i & 31, k = (i >> 5) & 1023, lb = i >> 15, l = lb / 9, b = lb % 9;
            rtb[i] = gam2[l * D + k] * (1.0f + modv(F, l, b)[4096 + k]) * wr_all[((size_t)l * D + k) * NEXP + e]; }
        LAS float* red = (LAS float*)F.lds;
        for (int item = F.blk; item < 36; item += F.G) {
            const int l = item / 9, b = item % 9, e = tid & 31, part = tid >> 5; const float* sh = modv(F, l, b) + 3072 + part * 64; const float* wr = wr_all + ((size_t)l * D + part * 64) * NEXP + e;
            float a0 = 0.f, a1 = 0.f, a2 = 0.f, a3 = 0.f;
#pragma unroll 4
            for (int k = 0; k < 64; k += 4) { a0 += sh[k] * wr[(size_t)k * NEXP]; a1 += sh[k + 1] * wr[(size_t)(k + 1) * NEXP]; a2 += sh[k + 2] * wr[(size_t)(k + 2) * NEXP]; a3 += sh[k + 3] * wr[(size_t)(k + 3) * NEXP]; }
            red[part * 32 + e] = (a0 + a1) + (a2 + a3);
            __syncthreads();
            if (tid < 32) { float sacc = 0.f;
#pragma unroll
                for (int q = 0; q < 16; ++q) sacc += red[q * 32 + tid];
                rtbias[(l * 9 + b) * NEXP + tid] = sacc + br_all[l * NEXP + tid]; }
            __syncthreads();
        }
    }
    const int gw = F.blk * 8 + F.wave, NGW = F.G * 8;
    bf16_t* H = (bf16_t*)(F.ws + WS_H);
    for (int row = gw; row < TALL; row += NGW) {
        const float* xr = row < TLAT ? inp(F, 0) + (size_t)row * D : inp(F, 2) + (size_t)(row - TLAT) * D;
        f32x4 v[4]; float s = 0.f;
#pragma unroll
        for (int j = 0; j < 4; ++j) { v[j] = *(const f32x4*)(xr + 4 * lane + 256 * j); s += (v[j][0] * v[j][0] + v[j][1] * v[j][1]) + (v[j][2] * v[j][2] + v[j][3] * v[j][3]); }
        const float rs = 1.0f / sqrtf(wave_sum(s) * (1.f / D) + EPS);
        const float* mv = modv(F, 0, bidx_of(row));
        norm_mod_store(v, rs, inp(F, 6), mv, mv + 1024, H + (size_t)row * D, lane);
    }
}
DI void phase_combine(const Frame& F, int l) {
    const int lane = lane_id(), tid = F.wave * 64 + lane; (void)tid; (void)lane;
    const int gw = F.blk * 8 + F.wave, NGW = F.G * 8;
    const int nrows = l < DEPTH - 1 ? TALL : TLAT;
    float* X = (float*)(F.ws + WS_X); bf16_t* H = (bf16_t*)(F.ws + WS_H); const bf16_t* Y = (const bf16_t*)(F.ws + WS_Y);
    for (int row = gw; row < nrows; row += NGW) {
        const int b = bidx_of(row);
        const float* g2 = modv(F, l, b) + 5120;
        f32x4 v[4]; float s = 0.f;
#pragma unroll
        for (int j = 0; j < 4; ++j) {
            const int c = 4 * lane + 256 * j;
            f32x4 y = (f32x4){0.f, 0.f, 0.f, 0.f};
#pragma unroll
            for (int k = 0; k < 4; ++k) { const u32x2 w = *(const u32x2*)(Y + ((size_t)row * 4 + k) * D + c); y += (f32x4){bflo(w.x), bfhi(w.x), bflo(w.y), bfhi(w.y)}; }
            v[j] = *(const f32x4*)(X + (size_t)row * D + c) + *(const f32x4*)(g2 + c) * y;
            s += (v[j][0] * v[j][0] + v[j][1] * v[j][1]) + (v[j][2] * v[j][2] + v[j][3] * v[j][3]);
        }
        if (l == DEPTH - 1) {
#pragma unroll
            for (int j = 0; j < 4; ++j) *(f32x4*)(F.out + (size_t)row * D + 4 * lane + 256 * j) = v[j];
        } else {
#pragma unroll
            for (int j = 0; j < 4; ++j) *(f32x4*)(X + (size_t)row * D + 4 * lane + 256 * j) = v[j];
            const float rs = 1.0f / sqrtf(wave_sum(s) * (1.f / D) + EPS);
            const float* mv = modv(F, l + 1, b);
            norm_mod_store(v, rs, inp(F, 6) + (l + 1) * D, mv, mv + 1024, H + (size_t)row * D, lane);
        }
    }
}

struct DenseSched {
    pg8::TileOrder ord; const char* A; const char* B; int pm0 = 0;
    DI bool next(int i, pg8::Unit& u) const { int pm, pn; if (!ord.tile(i, pm, pn)) return false; pm += pm0;
        u.A = A + (size_t)pm * 256 * 2048; u.B = B + (size_t)pn * 256 * 2048; u.r0 = pm * 256; u.c0 = pn * 256; u.e = 0; u.nvalid = 256; u.gl = nullptr; u.wl = nullptr; return true; }
    DI unsigned goff(const pg8::Unit&, int) const { return 0u; }
    static DI unsigned gbytes(unsigned e) { return e; }
};
struct MoeTables { const LAS int* tstart; const LAS int* cnt; };
DI void moe_tables_build(const Frame& F, int l, LAS int* tstart, LAS int* cnt) {
    const int lane = lane_id(), tid = F.wave * 64 + lane;
    if (tid < 64) {
        const int c = lane < NEXP ? (int)F.ctl[CW_CNT + 64 * l + lane] : 0; const int tiles = (c + 255) >> 8;
        int incl = tiles;
#pragma unroll
        for (int o = 1; o < 32; o <<= 1) { const int v = __shfl_up(incl, o); if (lane >= o) incl += v; }
        if (lane < NEXP) { cnt[lane] = c; tstart[lane] = incl - tiles; }
        if (lane == NEXP - 1) tstart[NEXP] = incl;
    }
    __syncthreads();
}
template <bool GATEUP> struct MoeSched {
    pg8::TileOrder ord; MoeTables T; const char* A; const char* W; const int* list; const float* wlist;
    DI bool next(int i, pg8::Unit& u) const { int mtg, pn; if (!ord.tile(i, mtg, pn)) return false;
        int e = 0;
#pragma unroll
        for (int s = 16; s >= 1; s >>= 1) { if (T.tstart[e + s] <= mtg) e += s; }
        const int mt = mtg - T.tstart[e];
        u.e = e; u.nvalid = T.cnt[e] - mt * 256; if (u.nvalid > 256) u.nvalid = 256; u.gl = list + (size_t)e * TALL + mt * 256; u.wl = wlist + (size_t)e * TALL + mt * 256; u.r0 = mtg * 256;
        if (GATEUP) { u.A = A; u.B = W + (size_t)e * (2048 * 2048) + (size_t)pn * 256 * 2048; u.c0 = pn * 128; }
        else { u.A = A + (size_t)mtg * 256 * 2048; u.B = W + (size_t)e * (1024 * 2048) + (size_t)pn * 256 * 2048; u.c0 = pn * 256; }
        return true; }
    DI unsigned goff(const pg8::Unit& u, int row) const { const int r = row < u.nvalid ? row : 0; return (unsigned)u.gl[r]; }
    static DI unsigned gbytes(unsigned entry) { return (entry >> 2) * 2048u; }
};

DI void dma4(const void* g, LAS unsigned* dst_wave_base) { __builtin_amdgcn_global_load_lds((const unsigned*)g, dst_wave_base, 4, 0, 0); }
struct EpiPrj {
    static constexpr bool PERM = true; static constexpr int NSIDE = 0;
    DI void side_issue(const pg8::Unit&, int, LAS unsigned*) const {}
    bf16_t* O; int ldc;
    DI void operator()(const f32x4 (&acc)[2][2][4][2], const pg8::Unit& u, int wr, int wc, int fr, int fq, const LAS unsigned*) const {
        const int row0 = u.r0 + wr * 64 + fr, col0 = u.c0 + wc * 32 + 8 * fq;
#pragma unroll
        for (int ai = 0; ai < 2; ++ai)
#pragma unroll
            for (int m = 0; m < 4; ++m) { const int row = row0 + ai * 128 + m * 16;
#pragma unroll
                for (int bj = 0; bj < 2; ++bj) { const f32x4 v0 = acc[ai][bj][m][0], v1 = acc[ai][bj][m][1];
                    u32x4 w; w.x = pk2(v0[0], v0[1]); w.y = pk2(v0[2], v0[3]); w.z = pk2(v1[0], v1[1]); w.w = pk2(v1[2], v1[3]);
                    *(u32x4*)(O + pidx(row, col0 + bj * 128)) = w; } }
    }
};
struct EpiRes {
    static constexpr bool PERM = false; static constexpr int NSIDE = 1;
    const float* xlat; const float* xctx; float* xout; const float* gate;
    DI void side_issue(const pg8::Unit& u, int t, LAS unsigned* side) const { dma4(gate + (size_t)bidx_of(u.r0) * 6144 + u.c0 + t, side + (t & ~63)); }
    DI void operator()(const f32x4 (&acc)[2][2][4][2], const pg8::Unit& u, int wr, int wc, int fr, int fq, const LAS unsigned* side) const {
        const int row0 = u.r0 + wr * 64 + fr, col0 = u.c0 + wc * 32 + 4 * fq;
        const float* xin = u.r0 < TLAT ? xlat : xctx - (size_t)TLAT * D;
        f32x4 gv[2][2];
#pragma unroll
        for (int bj = 0; bj < 2; ++bj)
#pragma unroll
            for (int n = 0; n < 2; ++n) gv[bj][n] = *(const LAS f32x4*)(side + wc * 32 + 4 * fq + bj * 128 + n * 16);
#pragma unroll
        for (int ai = 0; ai < 2; ++ai) {
            f32x4 xv[4][2][2];
#pragma unroll
            for (int m = 0; m < 4; ++m) { const size_t off = (size_t)(row0 + ai * 128 + m * 16) * D + col0;
#pragma unroll
                for (int bj = 0; bj < 2; ++bj)
#pragma unroll
                    for (int n = 0; n < 2; ++n) xv[m][bj][n] = *(const f32x4*)(xin + off + bj * 128 + n * 16); }
            asm volatile("" : "+v"(xv[0][0][0]), "+v"(xv[0][0][1]), "+v"(xv[0][1][0]), "+v"(xv[0][1][1]), "+v"(xv[1][0][0]), "+v"(xv[1][0][1]), "+v"(xv[1][1][0]), "+v"(xv[1][1][1]));
            asm volatile("" : "+v"(xv[2][0][0]), "+v"(xv[2][0][1]), "+v"(xv[2][1][0]), "+v"(xv[2][1][1]), "+v"(xv[3][0][0]), "+v"(xv[3][0][1]), "+v"(xv[3][1][0]), "+v"(xv[3][1][1]));
#pragma unroll
            for (int m = 0; m < 4; ++m) { const size_t off = (size_t)(row0 + ai * 128 + m * 16) * D + col0;
#pragma unroll
                for (int bj = 0; bj < 2; ++bj)
#pragma unroll
                    for (int n = 0; n < 2; ++n) *(f32x4*)(xout + off + bj * 128 + n * 16) = xv[m][bj][n] + gv[bj][n] * acc[ai][bj][m][n]; }
        }
    }
};
struct EpiSwiglu {
    static constexpr bool PERM = true; static constexpr int NSIDE = 1;
    bf16_t* ACT; const float* bgu;
    DI void side_issue(const pg8::Unit& u, int t, LAS unsigned* side) const { dma4(bgu + (size_t)u.e * 2048 + u.c0 + (t < 128 ? t : 1024 + t - 128), side + (t & ~63)); }
    DI void operator()(const f32x4 (&acc)[2][2][4][2], const pg8::Unit& u, int wr, int wc, int fr, int fq, const LAS unsigned* side) const {
        const int row0 = u.r0 + wr * 64 + fr, lc = wc * 32 + 8 * fq;
        f32x4 bgl[2], bli[2];
#pragma unroll
        for (int n = 0; n < 2; ++n) { bgl[n] = *(const LAS f32x4*)(side + lc + 4 * n); bli[n] = *(const LAS f32x4*)(side + 128 + lc + 4 * n); }
#pragma unroll
        for (int ai = 0; ai < 2; ++ai)
#pragma unroll
            for (int m = 0; m < 4; ++m) {
                float o[8];
#pragma unroll
                for (int n = 0; n < 2; ++n)
#pragma unroll
                    for (int j = 0; j < 4; ++j) {
                        float g = acc[ai][0][m][n][j] + bgl[n][j], li = acc[ai][1][m][n][j] + bli[n][j];
                        g = fminf(g, 7.0f); li = fminf(fmaxf(li, -7.0f), 7.0f);
                        const float sg = __builtin_amdgcn_rcpf(1.0f + __expf(-1.702f * g));
                        o[4 * n + j] = g * sg * (li + 1.0f);
                    }
                u32x4 w; w.x = pk2(o[0], o[1]); w.y = pk2(o[2], o[3]); w.z = pk2(o[4], o[5]); w.w = pk2(o[6], o[7]);
                *(u32x4*)(ACT + (size_t)(row0 + ai * 128 + m * 16) * 1024 + u.c0 + lc) = w;
            }
    }
};
struct EpiDown {
    static constexpr bool PERM = true; static constexpr int NSIDE = 3;
    bf16_t* Y; const float* bdn;
    DI void side_issue(const pg8::Unit& u, int t, LAS unsigned* side) const {
        const int r = t < u.nvalid ? t : 0;
        dma4(u.gl + r, side + (t & ~63)); dma4(u.wl + r, side + 256 + (t & ~63)); dma4(bdn + (size_t)u.e * 1024 + u.c0 + t, side + 512 + (t & ~63)); }
    DI void operator()(const f32x4 (&acc)[2][2][4][2], const pg8::Unit& u, int wr, int wc, int fr, int fq, const LAS unsigned* side) const {
        const int rl0 = wr * 64 + fr, lc = wc * 32 + 8 * fq, col0 = u.c0 + lc;
        f32x4 bv[2][2];
#pragma unroll
        for (int bj = 0; bj < 2; ++bj)
#pragma unroll
            for (int n = 0; n < 2; ++n) bv[bj][n] = *(const LAS f32x4*)(side + 512 + lc + bj * 128 + 4 * n);
#pragma unroll
        for (int ai = 0; ai < 2; ++ai)
#pragma unroll
            for (int m = 0; m < 4; ++m) {
                const int r = rl0 + ai * 128 + m * 16; const int ent = (int)side[r]; const float w = __builtin_bit_cast(float, side[256 + r]);
                if (r < u.nvalid) { bf16_t* rowp = Y + (size_t)ent * 1024 + col0;
#pragma unroll
                    for (int bj = 0; bj < 2; ++bj) { const f32x4 v0 = (acc[ai][bj][m][0] + bv[bj][0]) * w, v1 = (acc[ai][bj][m][1] + bv[bj][1]) * w;
                        u32x4 o; o.x = pk2(v0[0], v0[1]); o.y = pk2(v0[2], v0[3]); o.z = pk2(v1[0], v1[1]); o.w = pk2(v1[2], v1[3]);
                        *(u32x4*)(rowp + bj * 128) = o; } }
            }
    }
};

DI void phase_router(const Frame& F, int l, int grp_begin, int grp_end) {
    const int lane = lane_id(), tid = F.wave * 64 + lane;
    const int ngroups = grp_end - grp_begin;
    const float* __restrict__ X = (const float*)(F.ws + WS_X); bf16_t* __restrict__ Hh = (bf16_t*)(F.ws + WS_H);
    const float* gam = inp(F, 7) + l * D;
    LAS float* P = (LAS float*)F.lds;
    LAS float* SSq = (LAS float*)(F.lds + 32768);
    LAS int* cntL = (LAS int*)(F.lds + 36864 + 128);
    LAS int* baseL = (LAS int*)(F.lds + 36864 + 256);
    LAS int* entE = (LAS int*)(F.lds + 40960);
    LAS float* entW = (LAS float*)(F.lds + 40960 + 16384);
    LAS int* entT = (LAS int*)(F.lds + 40960 + 32768);
    if (tid < 32) cntL[tid] = 0;
    const int e_l = lane & 31, kk = lane >> 5;
    const int kbase = 128 * F.wave + 64 * kk;
    float Breg[64]; float bias_e = 0.f; int cur_b = -1;
#pragma unroll
    for (int s = 0; s < 64; ++s) Breg[s] = 0.f;
    __syncthreads();
    int nent = 0;
    const int g_lo = grp_begin + (int)(((long)F.blk * ngroups) / F.G), g_hi = grp_begin + (int)(((long)(F.blk + 1) * ngroups) / F.G);
    for (int g = g_lo; g < g_hi; ++g) {
        const int t0 = g * 32, b = bidx_of(t0);
        const float* mv = modv(F, l, b);
        const float* xr = X + (size_t)(t0 + e_l) * D + kbase;
        f32x4 xv[16];
#pragma unroll
        for (int q = 0; q < 16; ++q) xv[q] = *(const f32x4*)(xr + 4 * q);
        if (b != cur_b) {
            cur_b = b;
            const float* bp = (const float*)(F.ws + WS_RTB) + ((size_t)(l * 9 + b) * 1024 + kbase) * NEXP + e_l; const float* bp2 = bp + 32 * NEXP;
#pragma unroll
            for (int s = 0; s < 32; ++s) { Breg[s] = bp[s * NEXP]; Breg[32 + s] = bp2[s * NEXP]; }
            bias_e = ((const float*)(F.ws + WS_RTBIAS))[(l * 9 + b) * NEXP + e_l];
        }
        asm volatile("" : "+v"(xv[0]), "+v"(xv[1]), "+v"(xv[2]), "+v"(xv[3]), "+v"(xv[4]), "+v"(xv[5]), "+v"(xv[6]), "+v"(xv[7]));
        asm volatile("" : "+v"(xv[8]), "+v"(xv[9]), "+v"(xv[10]), "+v"(xv[11]), "+v"(xv[12]), "+v"(xv[13]), "+v"(xv[14]), "+v"(xv[15]));
        f32x16 acc;
#pragma unroll
        for (int i = 0; i < 16; ++i) acc[i] = 0.f;
        float ss = 0.f;
#pragma unroll
        for (int q = 0; q < 16; ++q) {
            ss += (xv[q][0] * xv[q][0] + xv[q][1] * xv[q][1]) + (xv[q][2] * xv[q][2] + xv[q][3] * xv[q][3]);
#pragma unroll
            for (int j = 0; j < 4; ++j) acc = __builtin_amdgcn_mfma_f32_32x32x2f32(xv[q][j], Breg[4 * q + j], acc, 0, 0, 0);
        }
        ss = xhalf_sum(ss);
        if (kk == 0) SSq[F.wave * 32 + e_l] = ss;
#pragma unroll
        for (int r = 0; r < 16; ++r) { const int i = (r & 3) + 8 * (r >> 2) + 4 * kk; P[(F.wave * 32 + i) * 32 + e_l] = acc[r]; }
        __syncthreads();
        {
            float tot = 0.f;
#pragma unroll
            for (int w = 0; w < 8; ++w) tot += SSq[w * 32 + e_l];
            const float rs = 1.0f / sqrtf(tot * (1.f / D) + EPS);
            bf16_t* hr = Hh + (size_t)(t0 + e_l) * D + kbase;
#pragma unroll
            for (int q = 0; q < 16; q += 2) {
                const f32x4 g0 = *(const f32x4*)(gam + kbase + 4 * q), c0 = *(const f32x4*)(mv + 4096 + kbase + 4 * q), h0 = *(const f32x4*)(mv + 3072 + kbase + 4 * q);
                const f32x4 g1 = *(const f32x4*)(gam + kbase + 4 * q + 4), c1 = *(const f32x4*)(mv + 4096 + kbase + 4 * q + 4), h1 = *(const f32x4*)(mv + 3072 + kbase + 4 * q + 4);
                const f32x4 f0 = xv[q] * rs * g0 * (c0 + 1.0f) + h0, f1 = xv[q + 1] * rs * g1 * (c1 + 1.0f) + h1;
                u32x4 o; o.x = pk2(f0[0], f0[1]); o.y = pk2(f0[2], f0[3]); o.z = pk2(f1[0], f1[1]); o.w = pk2(f1[2], f1[3]);
                *(u32x4*)(hr + 4 * q) = o;
            }
        }
#pragma unroll 1
        for (int pass = 0; pass < 2; ++pass) {
            const int ti = 4 * F.wave + 2 * pass + kk;
            float v = 0.f, tot = 0.f;
#pragma unroll
            for (int w = 0; w < 8; ++w) { v += P[(w * 32 + ti) * 32 + e_l]; tot += SSq[w * 32 + ti]; }
            v = (1.0f / sqrtf(tot * (1.f / D) + EPS)) * v + bias_e;
            float tv[4]; int te[4];
#pragma unroll
            for (int k = 0; k < 4; ++k) {
                float m = v;
#pragma unroll
                for (int o = 16; o >= 1; o >>= 1) m = fmaxf(m, __shfl_xor(m, o));
                const unsigned long long bal = __ballot(v == m);
                const unsigned half = (unsigned)(bal >> (32 * kk));
                const int idx = __builtin_ctz(half);
                tv[k] = m; te[k] = idx;
                if (e_l == idx) v = -3.0e38f;
            }
            const float e1 = __expf(tv[1] - tv[0]), e2 = __expf(tv[2] - tv[0]), e3 = __expf(tv[3] - tv[0]);
            const float inv = 1.0f / (1.0f + e1 + e2 + e3);
            const float wk[4] = {inv, e1 * inv, e2 * inv, e3 * inv};
            if (e_l < 4) {
                const int k = e_l; const int ex = k == 0 ? te[0] : k == 1 ? te[1] : k == 2 ? te[2] : te[3]; const float ww = k == 0 ? wk[0] : k == 1 ? wk[1] : k == 2 ? wk[2] : wk[3];
                const int rk = atomicAdd((int*)(cntL + ex), 1);
                const int n = nent + ti * 4 + k;
                entE[n] = (ex << 20) | rk; entW[n] = ww; entT[n] = (t0 + ti) * 4 + k;
            }
        }
        nent += 128;
        __syncthreads();
    }
    if (tid < 32) baseL[tid] = cntL[tid] > 0 ? (int)atomicAdd(F.ctl + CW_CNT + 64 * l + tid, (unsigned)cntL[tid]) : 0;
    __syncthreads();
    int* list = (int*)(F.ws + WS_LIST); float* wtok = (float*)(F.ws + WS_WTOK);
    for (int n = tid; n < nent; n += 512) { const int er = entE[n], ex = er >> 20, rk = er & 0xfffff, ent = entT[n];
        list[(size_t)ex * TALL + baseL[ex] + rk] = ent; wtok[(size_t)ex * TALL + baseL[ex] + rk] = entW[n]; }
    __syncthreads();
}

constexpr int KS = 128;
constexpr int VS = 136;
constexpr int K_IMG = 64 * KS, V_IMG = 64 * VS, KV_PAIR = K_IMG + V_IMG;
#define MFMA32(a, b, c) __builtin_amdgcn_mfma_f32_32x32x16_bf16((a), (b), (c), 0, 0, 0)
DI int crow(int r, int h) { return (r & 3) + 8 * (r >> 2) + 4 * h; }
struct KVRegs { u32x4 k, v; };
DI KVRegs kv_load(const bf16_t* prj, int ld, int tok, int kcol, int vcol, int part) {
    (void)ld; KVRegs x; x.k = *(const u32x4*)(prj + pidx(tok, kcol + part * 8)); x.v = *(const u32x4*)(prj + pidx(tok, vcol + part * 8)); return x;
}
template <bool ROPE> DI void kv_write(const KVRegs& x, LAS unsigned char* Kb, LAS unsigned char* VTb, int key, int part, const float* gk, const LAS f32x2* rtab, int prow, int pcol) {
    float kf[8];
    kf[0] = bflo(x.k.x); kf[1] = bfhi(x.k.x); kf[2] = bflo(x.k.y); kf[3] = bfhi(x.k.y); kf[4] = bflo(x.k.z); kf[5] = bfhi(x.k.z); kf[6] = bflo(x.k.w); kf[7] = bfhi(x.k.w);
    float ss = 0.f;
#pragma unroll
    for (int i = 0; i < 8; ++i) ss += kf[i] * kf[i];
    ss += dpp_xor1(ss); ss += dpp_xor2(ss); ss += dpp_hmirror(ss);
    const float rs = 1.0f / sqrtf(ss * (1.f / 64.f) + EPS);
    const f32x4 g0 = *(const f32x4*)(gk + part * 8), g1 = *(const f32x4*)(gk + part * 8 + 4);
#pragma unroll
    for (int i = 0; i < 8; ++i) kf[i] *= rs * (i < 4 ? g0[i] : g1[i - 4]);
    if (ROPE) {
        const int pos = (part >> 2) ? pcol : prow, i0 = (part & 1) * 8; const bool isx2 = (part >> 1) & 1;
#pragma unroll
        for (int i = 0; i < 8; ++i) { const float pk = dpp_xor2(kf[i]); const f32x2 cs = rtab[pos * 16 + i0 + i];
            kf[i] = isx2 ? (pk * cs.y + kf[i] * cs.x) : (kf[i] * cs.x - pk * cs.y); }
    }
    u32x4 o; o.x = pk2(kf[0], kf[1]); o.y = pk2(kf[2], kf[3]); o.z = pk2(kf[4], kf[5]); o.w = pk2(kf[6], kf[7]);
    *(LAS u32x4*)(Kb + key * KS + ((part ^ ((key >> 1) & 7)) << 4)) = o;
    LAS unsigned short* vt = (LAS unsigned short*)(VTb + (part * 8) * VS + (((key >> 2) ^ part) * 4 + (key & 3)) * 2);
    vt[0 * (VS / 2)] = (unsigned short)(x.v.x & 0xffffu); vt[1 * (VS / 2)] = (unsigned short)(x.v.x >> 16);
    vt[2 * (VS / 2)] = (unsigned short)(x.v.y & 0xffffu); vt[3 * (VS / 2)] = (unsigned short)(x.v.y >> 16);
    vt[4 * (VS / 2)] = (unsigned short)(x.v.z & 0xffffu); vt[5 * (VS / 2)] = (unsigned short)(x.v.z >> 16);
    vt[6 * (VS / 2)] = (unsigned short)(x.v.w & 0xffffu); vt[7 * (VS / 2)] = (unsigned short)(x.v.w >> 16);
}
template <bool ROPE> DI void q_load(bf16x8 (&qf)[4], const bf16_t* qrow, int h, const float* gq, float scale, const LAS f32x2* rtab, int prow, int pcol) {
    float x[4][8]; float ss = 0.f;
#pragma unroll
    for (int ks = 0; ks < 4; ++ks) { const u32x4 w = *(const u32x4*)(qrow + 16 * ks + 8 * h);
        x[ks][0] = bflo(w.x); x[ks][1] = bfhi(w.x); x[ks][2] = bflo(w.y); x[ks][3] = bfhi(w.y); x[ks][4] = bflo(w.z); x[ks][5] = bfhi(w.z); x[ks][6] = bflo(w.w); x[ks][7] = bfhi(w.w);
#pragma unroll
        for (int j = 0; j < 8; ++j) ss += x[ks][j] * x[ks][j]; }
    ss = xhalf_sum(ss);
    const float rs = 1.0f / sqrtf(ss * (1.f / 64.f) + EPS);
#pragma unroll
    for (int ks = 0; ks < 4; ++ks) { const f32x4 g0 = *(const f32x4*)(gq + 16 * ks + 8 * h), g1 = *(const f32x4*)(gq + 16 * ks + 8 * h + 4);
#pragma unroll
        for (int j = 0; j < 8; ++j) x[ks][j] *= rs * (j < 4 ? g0[j] : g1[j - 4]); }
    if (ROPE) {
#pragma unroll
        for (int a = 0; a < 2; ++a) { const int pos = a ? pcol : prow;
#pragma unroll
            for (int j = 0; j < 8; ++j) { const f32x2 cs = rtab[pos * 16 + 8 * h + j]; const float x1 = x[2 * a][j], x2 = x[2 * a + 1][j];
                x[2 * a][j] = x1 * cs.x - x2 * cs.y; x[2 * a + 1][j] = x1 * cs.y + x2 * cs.x; } }
    }
#pragma unroll
    for (int ks = 0; ks < 4; ++ks) { u32x4 o; o.x = pk2(x[ks][0] * scale, x[ks][1] * scale); o.y = pk2(x[ks][2] * scale, x[ks][3] * scale); o.z = pk2(x[ks][4] * scale, x[ks][5] * scale); o.w = pk2(x[ks][6] * scale, x[ks][7] * scale);
        qf[ks] = __builtin_bit_cast(bf16x8, o); }
}
template <class MaskF> DI void attn_tile(const LAS unsigned char* Kimg, const LAS unsigned char* VTt, const int vtile, const bf16x8 (&qf)[4], f32x16 (&o)[2], float& m, float& l, int r32, int h, const MaskF& mask) {
    __builtin_amdgcn_sched_barrier(0);
    f32x16 s;
#pragma unroll
    for (int i = 0; i < 16; ++i) s[i] = 0.f;
#pragma unroll
    for (int ks = 0; ks < 4; ++ks) { const int kk = 32 * vtile + r32; const bf16x8 kf = *(const LAS bf16x8*)(Kimg + kk * KS + (((2 * ks + h) ^ ((kk >> 1) & 7)) << 4)); s = MFMA32(kf, qf[ks], s); }
    float mt = -1.0e30f;
    mask(s);
#pragma unroll
    for (int r = 0; r < 16; ++r) mt = fmaxf(mt, s[r]);
    mt = xhalf_max(mt);
    const float mn = fmaxf(m, mt), alpha = __builtin_amdgcn_exp2f(m - mn);
    m = mn;
    float ps = 0.f;
#pragma unroll
    for (int r = 0; r < 16; ++r) { s[r] = __builtin_amdgcn_exp2f(s[r] - mn); ps += s[r]; }
    l = l * alpha + ps;
#pragma unroll
    for (int i = 0; i < 16; ++i) { o[0][i] *= alpha; o[1][i] *= alpha; }
    bf16x8 pa[2];
#pragma unroll
    for (int st = 0; st < 2; ++st) { u32x4 w; w.x = pk2(s[8 * st], s[8 * st + 1]); w.y = pk2(s[8 * st + 2], s[8 * st + 3]); w.z = pk2(s[8 * st + 4], s[8 * st + 5]); w.w = pk2(s[8 * st + 6], s[8 * st + 7]); pa[st] = __builtin_bit_cast(bf16x8, w); }
#pragma unroll
    for (int dvb = 0; dvb < 2; ++dvb)
#pragma unroll
        for (int st = 0; st < 2; ++st) {
            const int dv = 32 * dvb + r32, c0 = 8 * vtile + 4 * st + h;
            const LAS unsigned char* vrow = VTt + dv * VS;
            const u32x2 lo = *(const LAS u32x2*)(vrow + ((c0 ^ (dv >> 3)) << 3)), hi = *(const LAS u32x2*)(vrow + (((c0 + 2) ^ (dv >> 3)) << 3));
            u32x4 w; w.x = lo.x; w.y = lo.y; w.z = hi.x; w.w = hi.y;
            o[dvb] = MFMA32(__builtin_bit_cast(bf16x8, w), pa[st], o[dvb]);
        }
    __builtin_amdgcn_sched_barrier(0);
}
DI void attn_store(const f32x16 (&o)[2], float l, float extra, bf16_t* orow, int h) {
    const float lt = xhalf_sum(l) + extra;
    const float inv = 1.0f / lt;
#pragma unroll
    for (int dvb = 0; dvb < 2; ++dvb)
#pragma unroll
        for (int g = 0; g < 4; ++g) { u32x2 w; w.x = pk2(o[dvb][4 * g] * inv, o[dvb][4 * g + 1] * inv); w.y = pk2(o[dvb][4 * g + 2] * inv, o[dvb][4 * g + 3] * inv);
            *(u32x2*)(orow + 32 * dvb + 8 * g + 4 * h) = w; }
}

DI void phase_swa(const Frame& F, int l) {
    const int lane = lane_id(), tid = F.wave * 64 + lane, r32 = lane & 31, h = lane >> 5, key = tid >> 3, part = tid & 7;
    const bf16_t* PRJ = (const bf16_t*)(F.ws + WS_PRJ); bf16_t* OM = (bf16_t*)(F.ws + WS_OMIX);
    const int idx = l >> 1; const float* gq = inp(F, 18) + idx * 64; const float* gk = inp(F, 19) + idx * 64; const float* sinks = inp(F, 20) + idx * 16;
    LAS unsigned char* CTXI = F.lds;
    LAS unsigned char* RING = F.lds + 4 * KV_PAIR;
    LAS f32x2* rtab = (LAS f32x2*)(F.lds + 9 * KV_PAIR);
    for (int i = tid; i < 1024; i += 512) { const float ang = (float)(i >> 4) * exp2f(-(float)(i & 15) * (13.287712379549449f / 16.0f)); rtab[i] = (f32x2){cosf(ang), sinf(ang)}; }
    __syncthreads();
    const bool with_ctx = l < DEPTH - 1;
    const int nunits = 2048 + (with_ctx ? 128 : 0);
    const float qscale = 0.125f * LOG2E;
    const int u_lo = (int)(((long)F.blk * nunits) / F.G), u_hi = (int)(((long)(F.blk + 1) * nunits) / F.G);
    int cur_grp = -1, have_lo = 0, have_hi = -1;
    for (int u = u_lo; u < u_hi; ++u) {
        const bool is_ctx = u >= 2048;
        int b, kvh, qb, hh2; if (!is_ctx) { b = u >> 8; kvh = (u >> 7) & 1; qb = (u >> 1) & 63; hh2 = u & 1; } else { const int v = u - 2048; b = v >> 4; kvh = (v >> 3) & 1; qb = (v >> 1) & 3; hh2 = v & 1; }
        const int hq = kvh * 8 + hh2 * 4 + (F.wave >> 1), qs = F.wave & 1, q0 = qb * 64, a = q0 + 32 * qs, tq = a + r32;
        const int kcol = O_K + kvh * 64, vcol = O_V + kvh * 64;
        const int tokq = is_ctx ? TLAT + b * CTXL + tq : b * SEQ + tq;
        if (b * 2 + kvh != cur_grp) {
            cur_grp = b * 2 + kvh; have_lo = 0; have_hi = -1;
            KVRegs cx[4];
#pragma unroll
            for (int s = 0; s < 4; ++s) cx[s] = kv_load(PRJ, ODD_IN, TLAT + b * CTXL + 64 * s + key, kcol, vcol, part);
#pragma unroll
            for (int s = 0; s < 4; ++s) kv_write<false>(cx[s], CTXI + s * KV_PAIR, CTXI + s * KV_PAIR + K_IMG, key, part, gk, rtab, 0, 0);
        }
        const int need_lo = qb - 2 < 0 ? 0 : qb - 2, need_hi = qb + 2 > 63 ? 63 : qb + 2;
        if (!is_ctx) {
            const int first = have_hi + 1 > need_lo ? have_hi + 1 : need_lo;
#pragma unroll 1
            for (int kb = first; kb <= need_hi; ++kb) {
                const KVRegs x = kv_load(PRJ, ODD_IN, b * SEQ + 64 * kb + key, kcol, vcol, part);
                LAS unsigned char* Kn = RING + (kb % 5) * KV_PAIR; kv_write<true>(x, Kn, Kn + K_IMG, key, part, gk, rtab, kb, key);
            }
            have_lo = need_lo; have_hi = need_hi;
        }
        KVRegs pf; int pf_kb = -1;
        { const int nu = u + 1;
          if (!is_ctx && nu < u_hi && nu < 2048 && (nu >> 7) == (u >> 7)) { const int nqb = (nu >> 1) & 63; const int want = nqb + 2 > 63 ? 63 : nqb + 2;
              if (want > have_hi) { pf_kb = want; pf = kv_load(PRJ, ODD_IN, b * SEQ + 64 * want + key, kcol, vcol, part); } } }
        bf16x8 qf[4]; f32x16 o[2]; float m = -1.0e30f, lsum = 0.f;
        if (is_ctx) q_load<false>(qf, PRJ + pidx(tokq, O_Q + hq * 64), h, gq, qscale, rtab, 0, 0);
        else q_load<true>(qf, PRJ + pidx(tokq, O_Q + hq * 64), h, gq, qscale, rtab, tq >> 6, tq & 63);
#pragma unroll
        for (int i = 0; i < 16; ++i) { o[0][i] = 0.f; o[1][i] = 0.f; }
        __syncthreads();
#pragma unroll 1
        for (int s = 0; s < 4; ++s) {
            const LAS unsigned char* Kc = CTXI + s * KV_PAIR; const LAS unsigned char* Vc = Kc + K_IMG;
#pragma unroll
            for (int tt = 0; tt < 2; ++tt) attn_tile(Kc, Vc, tt, qf, o, m, lsum, r32, h, [](f32x16&) {});
        }
        if (!is_ctx) {
#pragma unroll 1
            for (int kb = need_lo; kb <= need_hi; ++kb) {
                const LAS unsigned char* Kc = RING + (kb % 5) * KV_PAIR; const LAS unsigned char* Vc = Kc + K_IMG;
#pragma unroll
                for (int tt = 0; tt < 2; ++tt) {
                    const int kt0 = 64 * kb + 32 * tt;
                    if (kt0 + 31 >= a - 128 && kt0 <= a + 31 + 128)
                        attn_tile(Kc, Vc, tt, qf, o, m, lsum, r32, h,
                                  [&](f32x16& sc) {
#pragma unroll
                                      for (int r = 0; r < 16; ++r) { const int kp = kt0 + crow(r, h); sc[r] = ((unsigned)(tq - kp + 128) <= 256u) ? sc[r] : -1.0e30f; } });
                }
            }
        }
        attn_store(o, lsum, __builtin_amdgcn_exp2f(sinks[hq] * LOG2E - m), OM + (size_t)tokq * D + hq * 64, h);
        __syncthreads();
        if (pf_kb >= 0) { LAS unsigned char* Kn = RING + (pf_kb % 5) * KV_PAIR; kv_write<true>(pf, Kn, Kn + K_IMG, key, part, gk, rtab, pf_kb, key); have_hi = pf_kb; }
    }
}

DI void na_units(const Frame& F, int l) {
    const int lane = lane_id(), tid = F.wave * 64 + lane, r32 = lane & 31, h = lane >> 5, key = tid >> 3, part = tid & 7;
    const bf16_t* PRJ = (const bf16_t*)(F.ws + WS_PRJ); bf16_t* OM = (bf16_t*)(F.ws + WS_OMIX);
    const int idx = l >> 1; const float* gq = inp(F, 13) + idx * 64; const float* gk = inp(F, 14) + idx * 64;
    LAS unsigned char* CTXI = F.lds;
    LAS unsigned char* RING = F.lds + 4 * KV_PAIR;
    LAS float* rpbL = (LAS float*)(F.lds + 6 * KV_PAIR);
    const bool with_ctx = l < DEPTH - 1;
    const int nunits = 1024 + (with_ctx ? 64 : 0);
    const float qscale = 0.125f * LOG2E;
    const float* rpb_all = inp(F, 15) + (size_t)idx * 8 * 465;
    const int u_lo = (int)(((long)F.blk * nunits) / F.G), u_hi = (int)(((long)(F.blk + 1) * nunits) / F.G);
    int cur_grp = -1;
    for (int u = u_lo; u < u_hi; ++u) {
        const bool is_ctx = u >= 1024;
        int b, hh, rg; if (!is_ctx) { b = u >> 7; hh = (u >> 4) & 7; rg = u & 15; } else { const int v = u - 1024; b = v >> 3; hh = v & 7; rg = 0; }
        const int R0 = 4 * rg, R = R0 + (F.wave >> 1), qh = F.wave & 1, c = 32 * qh + r32;
        const int kcol = C_NK + hh * 64, vcol = C_NV + hh * 64;
        const int tokq = is_ctx ? TLAT + b * CTXL + 32 * F.wave + r32 : b * SEQ + R * 64 + c;
        if (b * 8 + hh != cur_grp) {
            cur_grp = b * 8 + hh;
            KVRegs cx[4];
#pragma unroll
            for (int s = 0; s < 4; ++s) cx[s] = kv_load(PRJ, EVEN_LD, TLAT + b * CTXL + 64 * s + key, kcol, vcol, part);
            const float* rp = rpb_all + (size_t)hh * 465; for (int i = tid; i < 465; i += 512) rpbL[i] = rp[i] * LOG2E;
#pragma unroll
            for (int s = 0; s < 4; ++s) kv_write<false>(cx[s], CTXI + s * KV_PAIR, CTXI + s * KV_PAIR + K_IMG, key, part, gk, (const LAS f32x2*)nullptr, 0, 0);
        }
        bf16x8 qf[4]; f32x16 o[2]; float m = -1.0e30f, lsum = 0.f;
        q_load<false>(qf, PRJ + pidx(tokq, C_NQ + hh * 64), h, gq, qscale, (const LAS f32x2*)nullptr, 0, 0);
#pragma unroll
        for (int i = 0; i < 16; ++i) { o[0][i] = 0.f; o[1][i] = 0.f; }
        const int sR = R - 4 < 0 ? 0 : (R - 4 > 56 ? 56 : R - 4);
        const int klo = R0 - 4 < 0 ? 0 : (R0 - 4 > 56 ? 56 : R0 - 4), khi = (R0 - 1 < 0 ? 0 : (R0 - 1 > 56 ? 56 : R0 - 1)) + 7;
        const int nrow = is_ctx ? 0 : (khi - klo + 1);
        KVRegs nx;
        if (!is_ctx) nx = kv_load(PRJ, EVEN_LD, b * SEQ + klo * 64 + key, kcol, vcol, part);
        __syncthreads();
#pragma unroll 1
        for (int s = 0; s < 4; ++s) {
            const LAS unsigned char* Kc = CTXI + s * KV_PAIR; const LAS unsigned char* Vc = Kc + K_IMG;
#pragma unroll
            for (int tt = 0; tt < 2; ++tt) attn_tile(Kc, Vc, tt, qf, o, m, lsum, r32, h, [](f32x16&) {});
        }
        if (!is_ctx) {
            kv_write<false>(nx, RING, RING + K_IMG, key, part, gk, (const LAS f32x2*)nullptr, 0, 0);
            __syncthreads();
            const int w0 = c - 8 < 0 ? 0 : (c - 8 > 48 ? 48 : c - 8);
            for (int s = 0; s < nrow; ++s) {
                const bool more = s + 1 < nrow;
                if (more) nx = kv_load(PRJ, EVEN_LD, b * SEQ + (klo + s + 1) * 64 + key, kcol, vcol, part);
                const LAS unsigned char* Kc = RING + (s & 1) * KV_PAIR; const LAS unsigned char* Vc = Kc + K_IMG;
                const int kr = klo + s;
                if (kr >= sR && kr < sR + 8) {
                    const LAS float* brow = rpbL + (kr - R + 7) * 31 + 15 - c;
#pragma unroll
                    for (int tt = 0; tt < 2; ++tt)
                        attn_tile(Kc, Vc, tt, qf, o, m, lsum, r32, h,
                                  [&](f32x16& sc) { float bv[16];
#pragma unroll
                                      for (int r = 0; r < 16; ++r) { const int kc = 32 * tt + crow(r, h); const int bi = kc < w0 ? w0 : (kc > w0 + 15 ? w0 + 15 : kc); bv[r] = brow[bi]; }
#pragma unroll
                                      for (int r = 0; r < 16; ++r) { const int kc = 32 * tt + crow(r, h); const unsigned ok = (unsigned)(kc - w0) < 16u; sc[r] = ok ? sc[r] + bv[r] : -1.0e30f; } });
                }
                if (more) { LAS unsigned char* Kn = RING + ((s + 1) & 1) * KV_PAIR; kv_write<false>(nx, Kn, Kn + K_IMG, key, part, gk, (const LAS f32x2*)nullptr, 0, 0); }
                __syncthreads();
            }
        }
        attn_store(o, lsum, 0.f, OM + (size_t)tokq * D + 512 + hh * 64, h);
        __syncthreads();
    }
}

constexpr int GLA_CH = 68, GLA_ITEMS = NBATCH * 4 * 2 * GLA_CH;
DI int gla_tok0(int b, int dir, int p) { const int q = dir ? (p < 4 ? 3 - p : 67 - p) : (p < 4 ? p : p - 4); return p < 4 ? TLAT + b * CTXL + 64 * q : b * SEQ + 64 * q; }
DI float logsig16(float z) { return (fminf(z, 0.f) - __logf(1.0f + __expf(-fabsf(z)))) * (1.0f / 16.0f); }
constexpr int GT_STRIDE = 136;
DI void gla_local(const Frame& F, int l) {
    const int lane = lane_id(), r32 = lane & 31, h = lane >> 5;
    const bf16_t* PRJ = (const bf16_t*)(F.ws + WS_PRJ);
    const int idx = l >> 1;
    LAS unsigned char* KT = F.lds + F.wave * 17408;
    LAS unsigned char* VT = KT + 8704;
    bf16_t* Ug = (bf16_t*)(F.ws + WS_GU); float* Dg = (float*)(F.ws + WS_GD); bf16_t* QTg = (bf16_t*)(F.ws + WS_GQ); bf16_t* KTg = (bf16_t*)(F.ws + WS_GK);
    const float* wa2 = inp(F, 10) + (size_t)idx * 2 * 16 * 256; const float* ba2 = inp(F, 11) + idx * 2 * 256;
    for (int it = F.blk * 8 + F.wave; it < GLA_ITEMS; it += F.G * 8) {
        const int ch = it / GLA_CH, p = it % GLA_CH, dir = ch & 1, hd = (ch >> 1) & 3, b = ch >> 3;
        const int tok0 = gla_tok0(b, dir, p);
        { const bf16_t* ap = PRJ + pidx(tok0 + lane, dir ? C_AB : C_AF); const u32x4 a0 = *(const u32x4*)ap, a1 = *(const u32x4*)(ap + 8);
          *(LAS u32x4*)(VT + lane * 32) = a0; *(LAS u32x4*)(VT + lane * 32 + 16) = a1; }
        float w[16];
#pragma unroll
        for (int r = 0; r < 16; ++r) w[r] = wa2[((size_t)dir * 16 + r) * 256 + hd * 64 + lane];
        const float bb = ba2[dir * 256 + hd * 64 + lane];
        const bf16_t* kp = PRJ + pidx(tok0, C_K + hd * 64) + lane;
        const bf16_t* qp = PRJ + pidx(tok0, C_Q + hd * 64) + lane;
        LDS_WAIT();
        float g[64]; float tot = 0.f;
#pragma unroll
        for (int t = 0; t < 64; ++t) {
            const u32x4 a0 = *(const LAS u32x4*)(VT + t * 32), a1 = *(const LAS u32x4*)(VT + t * 32 + 16);
            float z = bb;
            z += bflo(a0.x) * w[0] + bfhi(a0.x) * w[1] + bflo(a0.y) * w[2] + bfhi(a0.y) * w[3] + bflo(a0.z) * w[4] + bfhi(a0.z) * w[5] + bflo(a0.w) * w[6] + bfhi(a0.w) * w[7];
            z += bflo(a1.x) * w[8] + bfhi(a1.x) * w[9] + bflo(a1.y) * w[10] + bfhi(a1.y) * w[11] + bflo(a1.z) * w[12] + bfhi(a1.z) * w[13] + bflo(a1.w) * w[14] + bfhi(a1.w) * w[15];
            g[t] = logsig16(z); tot += g[t];
        }
        Dg[(size_t)it * 64 + lane] = __expf(tot);
        float run = 0.f;
        bf16_t* qo = QTg + ((size_t)dir * TALL + tok0) * 256 + hd * 64 + lane; bf16_t* ko = KTg + ((size_t)dir * TALL + tok0) * 256 + hd * 64 + lane;
#pragma unroll
        for (int c8 = 0; c8 < 8; ++c8) {
            unsigned short kr[8], qr[8];
#pragma unroll
            for (int e = 0; e < 8; ++e) { kr[e] = kp[(size_t)(8 * c8 + e) * 64]; qr[e] = qp[(size_t)(8 * c8 + e) * 64]; }
            float kh[8];
#pragma unroll
            for (int e = 0; e < 8; ++e) {
                const int t = 8 * c8 + e;
                const float C = dir ? (tot - run) : (run + g[t]);
                run += g[t];
                const float kf = bf2f(kr[e]), qf_ = bf2f(qr[e]);
                kh[e] = kf * __expf(tot - C);
                ko[(size_t)t * 256] = (bf16_t)f2bf(kf * __expf(-C));
                qo[(size_t)t * 256] = (bf16_t)f2bf(qf_ * 0.125f * __expf(C));
            }
#pragma unroll
            for (int e = 0; e < 8; e += 2) *(LAS unsigned*)(KT + lane * GT_STRIDE + (8 * c8 + e) * 2) = pk2(kh[e], kh[e + 1]);
        }
        LDS_WAIT();
#pragma unroll 1
        for (int hv = 0; hv < 2; ++hv) {
            const bf16_t* vp = PRJ + pidx(tok0, C_V + hd * 128 + 64 * hv) + lane;
            unsigned short vv[64];
#pragma unroll
            for (int t = 0; t < 64; ++t) vv[t] = vp[(size_t)t * 64];
#pragma unroll
            for (int t = 0; t < 64; t += 2) *(LAS unsigned*)(VT + lane * GT_STRIDE + t * 2) = (unsigned)vv[t] | ((unsigned)vv[t + 1] << 16);
            LDS_WAIT();
            f32x16 acc[2][2];
#pragma unroll
            for (int mb = 0; mb < 2; ++mb)
#pragma unroll
                for (int nb = 0; nb < 2; ++nb)
#pragma unroll
                    for (int i = 0; i < 16; ++i) acc[mb][nb][i] = 0.f;
#pragma unroll
            for (int ks = 0; ks < 4; ++ks) {
                bf16x8 af[2], bfr[2];
#pragma unroll
                for (int mb = 0; mb < 2; ++mb) { const LAS unsigned char* ap = KT + (32 * mb + r32) * GT_STRIDE + (16 * ks + 8 * h) * 2; const u32x2 lo = *(const LAS u32x2*)ap, hi = *(const LAS u32x2*)(ap + 8);
                    u32x4 x; x.x = lo.x; x.y = lo.y; x.z = hi.x; x.w = hi.y; af[mb] = __builtin_bit_cast(bf16x8, x); }
#pragma unroll
                for (int nb = 0; nb < 2; ++nb) { const LAS unsigned char* bp = VT + (32 * nb + r32) * GT_STRIDE + (16 * ks + 8 * h) * 2; const u32x2 lo = *(const LAS u32x2*)bp, hi = *(const LAS u32x2*)(bp + 8);
                    u32x4 x; x.x = lo.x; x.y = lo.y; x.z = hi.x; x.w = hi.y; bfr[nb] = __builtin_bit_cast(bf16x8, x); }
#pragma unroll
                for (int mb = 0; mb < 2; ++mb)
#pragma unroll
                    for (int nb = 0; nb < 2; ++nb) acc[mb][nb] = MFMA32(af[mb], bfr[nb], acc[mb][nb]);
            }
            bf16_t* up = Ug + (size_t)it * 8192 + (size_t)(64 * hv + r32) * 64;
#pragma unroll
            for (int mb = 0; mb < 2; ++mb)
#pragma unroll
                for (int nb = 0; nb < 2; ++nb)
#pragma unroll
                    for (int g = 0; g < 4; ++g) { u32x2 w; w.x = pk2(acc[mb][nb][4 * g], acc[mb][nb][4 * g + 1]); w.y = pk2(acc[mb][nb][4 * g + 2], acc[mb][nb][4 * g + 3]);
                        *(u32x2*)(up + (size_t)(32 * nb) * 64 + 32 * mb + 8 * g + 4 * h) = w; }
            LDS_WAIT();
        }
    }
}
DI void phase_even_a(const Frame& F, int l) { gla_local(F, l); __syncthreads(); na_units(F, l); }

DI void phase_gla_scan(const Frame& F, int l) {
    const int lane = lane_id(), gt = (F.blk * 8 + F.wave) * 64 + lane, NGT = F.G * 512;
    const bf16_t* Ug = (const bf16_t*)(F.ws + WS_GU); const float* Dg = (const float*)(F.ws + WS_GD); bf16_t* ST = (bf16_t*)(F.ws + WS_GS);
    for (int w = gt; w < 64 * 2048; w += NGT) {
        const int ch = w >> 11, dv = (w >> 4) & 127, dkg = w & 15;
        float s[4] = {0.f, 0.f, 0.f, 0.f};
#pragma unroll 4
        for (int p = 0; p < GLA_CH; ++p) {
            const size_t it = (size_t)ch * GLA_CH + p;
            u32x2 o; o.x = pk2(s[0], s[1]); o.y = pk2(s[2], s[3]);
            *(u32x2*)(ST + it * 8192 + (size_t)dv * 64 + 4 * dkg) = o;
            const f32x4 dk = *(const f32x4*)(Dg + it * 64 + 4 * dkg); const u32x2 uw = *(const u32x2*)(Ug + it * 8192 + (size_t)dv * 64 + 4 * dkg); const f32x4 u = (f32x4){bflo(uw.x), bfhi(uw.x), bflo(uw.y), bfhi(uw.y)};
#pragma unroll
            for (int i = 0; i < 4; ++i) s[i] = dk[i] * s[i] + u[i];
        }
    }
}

DI void phase_gla_out(const Frame& F, int l) {
    const int lane = lane_id(), r32 = lane & 31, h = lane >> 5;
    const bf16_t* PRJ = (const bf16_t*)(F.ws + WS_PRJ); bf16_t* OM = (bf16_t*)(F.ws + WS_OMIX); const bf16_t* ST = (const bf16_t*)(F.ws + WS_GS);
    const bf16_t* QTg = (const bf16_t*)(F.ws + WS_GQ); const bf16_t* KTg = (const bf16_t*)(F.ws + WS_GK);
    const int idx = l >> 1; const bool with_ctx = l < DEPTH - 1;
    LAS unsigned char* VT = F.lds;
    LAS float* SS = (LAS float*)(F.lds + 128 * GT_STRIDE);
    const int iblk = F.wave & 1, dvq = F.wave >> 1;
    const float* gn = inp(F, 12) + idx * 128 + 32 * dvq;
    const int nitems = NBATCH * 4 * GLA_CH;
    for (int it = F.blk; it < nitems; it += F.G) {
        const int sc = it % GLA_CH, hd = (it / GLA_CH) & 3, b = it / (GLA_CH * 4);
        if (sc < 4 && !with_ctx) continue;
        const int tok0 = sc < 4 ? TLAT + b * CTXL + 64 * sc : b * SEQ + 64 * (sc - 4);
        const int ti = 32 * iblk + r32;
        unsigned short v0[8], v1[8];
        { const bf16_t* vp = PRJ + pidx(tok0 + 8 * F.wave, C_V + hd * 128) + lane; const bf16_t* vp1 = PRJ + pidx(tok0 + 8 * F.wave, C_V + hd * 128 + 64) + lane;
#pragma unroll
          for (int e = 0; e < 8; ++e) { v0[e] = vp[(size_t)e * 64]; v1[e] = vp1[(size_t)e * 64]; } }
        u32x4 qw[2][4], kd[2][4], ko[4], sw[2][4];
        const int odir = iblk ? 0 : 1, ojb = 1 - iblk;
        size_t item[2];
#pragma unroll
        for (int dir = 0; dir < 2; ++dir) {
            const int pp = dir ? (sc < 4 ? 3 - sc : 71 - sc) : sc;
            item[dir] = (size_t)(((b * 4 + hd) * 2 + dir) * GLA_CH + pp);
            const bf16_t* qp = QTg + ((size_t)dir * TALL + tok0 + ti) * 256 + hd * 64 + 8 * h;
            const bf16_t* kp = KTg + ((size_t)dir * TALL + tok0 + ti) * 256 + hd * 64 + 8 * h;
            const bf16_t* sp = ST + item[dir] * 8192 + (size_t)(32 * dvq + r32) * 64 + 8 * h;
#pragma unroll
            for (int ks = 0; ks < 4; ++ks) { qw[dir][ks] = *(const u32x4*)(qp + 16 * ks); kd[dir][ks] = *(const u32x4*)(kp + 16 * ks); sw[dir][ks] = *(const u32x4*)(sp + 16 * ks); }
        }
        { const bf16_t* kp = KTg + ((size_t)odir * TALL + tok0 + 32 * ojb + r32) * 256 + hd * 64 + 8 * h;
#pragma unroll
          for (int ks = 0; ks < 4; ++ks) ko[ks] = *(const u32x4*)(kp + 16 * ks); }
#pragma unroll
        for (int e = 0; e < 8; e += 2) { *(LAS unsigned*)(VT + lane * GT_STRIDE + (8 * F.wave + e) * 2) = (unsigned)v0[e] | ((unsigned)v0[e + 1] << 16);
            *(LAS unsigned*)(VT + (lane + 64) * GT_STRIDE + (8 * F.wave + e) * 2) = (unsigned)v1[e] | ((unsigned)v1[e + 1] << 16); }
        __syncthreads();
        f32x16 o;
#pragma unroll
        for (int i = 0; i < 16; ++i) o[i] = 0.f;
#pragma unroll
        for (int dir = 0; dir < 2; ++dir) {
#pragma unroll
            for (int blkk = 0; blkk < 2; ++blkk) {
                if (blkk == 1 && dir != odir) continue;
                const int jb = blkk ? ojb : iblk;
                f32x16 sacc;
#pragma unroll
                for (int i = 0; i < 16; ++i) sacc[i] = 0.f;
#pragma unroll
                for (int ks = 0; ks < 4; ++ks) sacc = MFMA32(__builtin_bit_cast(bf16x8, blkk ? ko[ks] : kd[dir][ks]), __builtin_bit_cast(bf16x8, qw[dir][ks]), sacc);
                if (blkk == 0) {
#pragma unroll
                    for (int r = 0; r < 16; ++r) { const int j = 32 * jb + crow(r, h); const bool keep = dir == 0 ? (j <= ti) : (j >= ti); sacc[r] = keep ? sacc[r] : 0.f; }
                }
#pragma unroll
                for (int st = 0; st < 2; ++st) {
                    u32x4 pw; pw.x = pk2(sacc[8 * st], sacc[8 * st + 1]); pw.y = pk2(sacc[8 * st + 2], sacc[8 * st + 3]); pw.z = pk2(sacc[8 * st + 4], sacc[8 * st + 5]); pw.w = pk2(sacc[8 * st + 6], sacc[8 * st + 7]);
                    const LAS unsigned char* vp = VT + (32 * dvq + r32) * GT_STRIDE + (32 * jb + 16 * st + 4 * h) * 2;
                    const u32x2 lo = *(const LAS u32x2*)vp, hi = *(const LAS u32x2*)(vp + 16);
                    u32x4 vw; vw.x = lo.x; vw.y = lo.y; vw.z = hi.x; vw.w = hi.y;
                    o = MFMA32(__builtin_bit_cast(bf16x8, vw), __builtin_bit_cast(bf16x8, pw), o);
                }
            }
#pragma unroll
            for (int ks = 0; ks < 4; ++ks) o = MFMA32(__builtin_bit_cast(bf16x8, sw[dir][ks]), __builtin_bit_cast(bf16x8, qw[dir][ks]), o);
        }
        float ss = 0.f;
#pragma unroll
        for (int i = 0; i < 16; ++i) ss += o[i] * o[i];
        ss = xhalf_sum(ss);
        if (h == 0) SS[dvq * 64 + ti] = ss;
        const bf16_t* gp = PRJ + pidx(tok0 + ti, C_G + hd * 128 + 32 * dvq);
        u32x2 gw[4]; f32x4 gv[4];
#pragma unroll
        for (int g = 0; g < 4; ++g) { gw[g] = *(const u32x2*)(gp + 8 * g + 4 * h); gv[g] = *(const f32x4*)(gn + 8 * g + 4 * h); }
        __syncthreads();
        const float tot = SS[ti] + SS[64 + ti] + SS[128 + ti] + SS[192 + ti];
        const float rs = 1.0f / sqrtf(tot * (1.f / 128.f) + EPS);
        bf16_t* op = OM + (size_t)(tok0 + ti) * D + hd * 128 + 32 * dvq;
#pragma unroll
        for (int g = 0; g < 4; ++g) {
            const float g0 = bflo(gw[g].x), g1 = bfhi(gw[g].x), g2 = bflo(gw[g].y), g3 = bfhi(gw[g].y);
            u32x2 ow; ow.x = pk2(o[4 * g] * rs * gv[g][0] * silu_f(g0), o[4 * g + 1] * rs * gv[g][1] * silu_f(g1)); ow.y = pk2(o[4 * g + 2] * rs * gv[g][2] * silu_f(g2), o[4 * g + 3] * rs * gv[g][3] * silu_f(g3));
            *(u32x2*)(op + 8 * g + 4 * h) = ow;
        }
        __syncthreads();
    }
}

constexpr int N_PHASES = 2 + 10 * DEPTH;
#ifndef NB_CONV
#define NB_CONV 48
#endif
#ifndef NB_CONV_ODD
#define NB_CONV_ODD 64
#endif
struct Args { const float* in[27]; float* out; unsigned char* ws; int ph_lo, ph_hi; };
#define PH_IN(k) (lo <= (k) && (k) < hi)
#define PH_BAR(k) do { if (PH_IN(k) && PH_IN((k) + 1)) xcd_barrier(bar); } while (0)
template <int l> DI void layer_program(Frame& F, const XcdBarrier& bar, const int lo, const int hi) {
    constexpr int pb = 2 + 10 * l;
    constexpr bool odd = (l & 1) != 0, with_ctx = l < DEPTH - 1;
    if (PH_IN(pb)) {
        DenseSched S; S.ord.init(TALL / 256, odd ? 5 : 13, F.G, F.blk); S.A = (const char*)(F.ws + WS_H);
        S.B = (const char*)(F.ws + (odd ? WS_WINO + (size_t)(l >> 1) * ODD_IN * 2048 : WS_WINE + (size_t)(l >> 1) * EVEN_LD * 2048));
        EpiPrj E{(bf16_t*)(F.ws + WS_PRJ), odd ? ODD_IN : EVEN_LD};
        pg8::gemm_phase<EpiPrj, DenseSched, false>(F.lds, S, E, F.wave, (LAS unsigned*)(F.lds + MISC_OFF + 1024));
    }
    PH_BAR(pb);
    if (PH_IN(pb + 1)) {
        constexpr int NBC = (l < DEPTH - 1) ? (odd ? NB_CONV_ODD : NB_CONV) : 0;
        if (NBC > 0 && F.blk >= F.G - NBC) convert_moe_layer(F, l + 1, F.blk - (F.G - NBC), NBC);
        else { Frame Fm = F; Fm.G = F.G - NBC; if (odd) phase_swa(Fm, l); else phase_even_a(Fm, l); }
    }
    PH_BAR(pb + 1);
    if (!odd) {
        if (PH_IN(pb + 2)) phase_gla_scan(F, l);
        PH_BAR(pb + 2);
        if (PH_IN(pb + 3)) phase_gla_out(F, l);
        PH_BAR(pb + 3);
    }
    if (PH_IN(pb + 4)) {
        DenseSched S; S.ord.init(TLAT / 256, 4, F.G, F.blk); S.A = (const char*)(F.ws + WS_OMIX); S.B = (const char*)(F.ws + WS_WOUT + (size_t)l * 1024 * 2048);
        float* X = (float*)(F.ws + WS_X);
        EpiRes E{l == 0 ? inp(F, 0) : X, l == 0 ? inp(F, 2) : X + (size_t)TLAT * D, X, modv(F, l, 0) + 2048};
        pg8::gemm_phase<EpiRes, DenseSched, false>(F.lds, S, E, F.wave, (LAS unsigned*)(F.lds + MISC_OFF + 1024));
    }
    PH_BAR(pb + 4);
    if (PH_IN(pb + 5)) {
        constexpr int NCX = with_ctx ? (TCTX / 256) * 4 : 0;
        if (with_ctx && F.G > 2 * NCX) {
            if (F.blk < NCX) {
                DenseSched S; S.ord.init(TCTX / 256, 4, NCX, F.blk); S.pm0 = TLAT / 256; S.A = (const char*)(F.ws + WS_OMIX); S.B = (const char*)(F.ws + WS_WOUT + (size_t)l * 1024 * 2048);
                float* X = (float*)(F.ws + WS_X);
                EpiRes E{l == 0 ? inp(F, 0) : X, l == 0 ? inp(F, 2) : X + (size_t)TLAT * D, X, modv(F, l, 0) + 2048};
                pg8::gemm_phase<EpiRes, DenseSched, false>(F.lds, S, E, F.wave, (LAS unsigned*)(F.lds + MISC_OFF + 1024));
            } else { Frame Fr = F; Fr.blk = F.blk - NCX; Fr.G = F.G - NCX; phase_router(Fr, l, 0, TLAT / 32); }
        } else {
            if (with_ctx) {
                DenseSched S; S.ord.init(TCTX / 256, 4, F.G, F.blk); S.pm0 = TLAT / 256; S.A = (const char*)(F.ws + WS_OMIX); S.B = (const char*)(F.ws + WS_WOUT + (size_t)l * 1024 * 2048);
                float* X = (float*)(F.ws + WS_X);
                EpiRes E{l == 0 ? inp(F, 0) : X, l == 0 ? inp(F, 2) : X + (size_t)TLAT * D, X, modv(F, l, 0) + 2048};
                pg8::gemm_phase<EpiRes, DenseSched, false>(F.lds, S, E, F.wave, (LAS unsigned*)(F.lds + MISC_OFF + 1024));
                xcd_barrier(bar);
            }
            phase_router(F, l, 0, TLAT / 32);
        }
    }
    PH_BAR(pb + 5);
    if (with_ctx) {
        if (PH_IN(pb + 6)) phase_router(F, l, TLAT / 32, TALL / 32);
        PH_BAR(pb + 6);
    }
    if (PH_IN(pb + 7)) {
        LAS int* ts = (LAS int*)(F.lds + MISC_OFF); LAS int* cn = ts + 64;
        moe_tables_build(F, l, ts, cn);
        MoeSched<true> S; S.T.tstart = ts; S.T.cnt = cn; S.ord.init(ts[NEXP], 8, F.G, F.blk); S.A = (const char*)(F.ws + WS_H); S.W = (const char*)(F.ws + WS_WGU + (size_t)l * 32 * 2048 * 2048); S.list = (const int*)(F.ws + WS_LIST); S.wlist = (const float*)(F.ws + WS_WTOK);
        EpiSwiglu E{(bf16_t*)(F.ws + WS_ACT), inp(F, 24) + (size_t)l * 32 * 2048};
        pg8::gemm_phase<EpiSwiglu, MoeSched<true>, true>(F.lds, S, E, F.wave, (LAS unsigned*)(F.lds + MISC_OFF + 1024));
    }
    PH_BAR(pb + 7);
    if (PH_IN(pb + 8)) {
        LAS int* ts = (LAS int*)(F.lds + MISC_OFF); LAS int* cn = ts + 64;
        moe_tables_build(F, l, ts, cn);
        MoeSched<false> S; S.T.tstart = ts; S.T.cnt = cn; S.ord.init(ts[NEXP], 4, F.G, F.blk); S.A = (const char*)(F.ws + WS_ACT); S.W = (const char*)(F.ws + WS_WDN + (size_t)l * 32 * 1024 * 2048); S.list = (const int*)(F.ws + WS_LIST); S.wlist = (const float*)(F.ws + WS_WTOK);
        EpiDown E{(bf16_t*)(F.ws + WS_Y), inp(F, 26) + (size_t)l * 32 * 1024};
        pg8::gemm_phase<EpiDown, MoeSched<false>, false>(F.lds, S, E, F.wave, (LAS unsigned*)(F.lds + MISC_OFF + 1024));
    }
    PH_BAR(pb + 8);
    if (PH_IN(pb + 9)) phase_combine(F, l);
    if (l < DEPTH - 1) PH_BAR(pb + 9);
}
__global__ void __launch_bounds__(512, 2) fwd_kernel(Args args) {
    extern __shared__ __attribute__((aligned(16))) unsigned char lds_raw[];
    Frame F; F.lds = (LAS unsigned char*)lds_raw; F.ws = args.ws; F.ctl = (unsigned*)(args.ws + WS_CTL); F.out = args.out;
    {
        const unsigned long long kp = (unsigned long long)__builtin_amdgcn_kernarg_segment_ptr(); unsigned klo = (unsigned)kp, khi = (unsigned)(kp >> 32);
        asm volatile("" : "+v"(klo), "+v"(khi)); klo = __builtin_amdgcn_readfirstlane(klo); khi = __builtin_amdgcn_readfirstlane(khi);
        F.in = (const float* const*)(((unsigned long long)khi << 32) | klo); }
    F.wave = __builtin_amdgcn_readfirstlane((int)(threadIdx.x >> 6)); F.G = gridDim.x; F.blk = blockIdx.x;
    const int lo = args.ph_lo, hi = args.ph_hi;
    if (threadIdx.x < 4) ((LAS unsigned*)(F.lds + XB_OFF))[threadIdx.x] = 0u;
    __syncthreads();
    XcdBarrier bar; bar.bar = F.ctl + CW_BAR; bar.x = 0; bar.st = (volatile LAS unsigned*)(F.lds + XB_OFF); bar.wave = F.wave;
    if (hi - lo > 1) bar = xcd_barrier_post(F.ctl + CW_BAR, (volatile LAS unsigned*)(F.lds + XB_OFF), F.wave);
    if (PH_IN(0)) phase_p0(F);
    PH_BAR(0);
    if (PH_IN(1)) phase_norm1_l0(F);
    PH_BAR(1);
    layer_program<0>(F, bar, lo, hi);
    layer_program<1>(F, bar, lo, hi);
    layer_program<2>(F, bar, lo, hi);
    layer_program<3>(F, bar, lo, hi);
}

#ifndef MK_PER_PHASE
#define MK_PER_PHASE 0
#endif
extern "C" void kernel_launch(void* const* d_in, const int* in_sizes, int n_in, void* d_out, int out_size, void* d_ws, size_t ws_size, hipStream_t stream) {
    static int grid = 0;
    if (grid == 0) {
        if (n_in != 27 || out_size != TLAT * D || ws_size < WS_END) { fprintf(stderr, "kernel_launch: unexpected problem shape (n_in %d, out %d, ws %zu < %zu)\n", n_in, out_size, ws_size, (size_t)WS_END); grid = -1; return; }
        int dev = 0, cus = 0, per_cu = 0;
        if (hipGetDevice(&dev) != hipSuccess || hipDeviceGetAttribute(&cus, hipDeviceAttributeMultiprocessorCount, dev) != hipSuccess) { grid = -1; return; }
        if (hipFuncSetAttribute((const void*)fwd_kernel, hipFuncAttributeMaxDynamicSharedMemorySize, LDS_BYTES) != hipSuccess) { fprintf(stderr, "kernel_launch: hipFuncSetAttribute failed\n"); grid = -1; return; }
        if (hipOccupancyMaxActiveBlocksPerMultiprocessor(&per_cu, (const void*)fwd_kernel, 512, LDS_BYTES) != hipSuccess || per_cu < 1) fprintf(stderr, "kernel_launch: occupancy query reports %d\n", per_cu);
        (void)hipGetLastError();
        grid = cus;
    }
    if (grid < 0) return;
    (void)hipMemsetAsync((char*)d_ws + WS_CTL, 0, CTL_ZERO_BYTES, stream);
    Args a{};
    for (int i = 0; i < 27; ++i) a.in[i] = (const float*)d_in[i];
    a.out = (float*)d_out; a.ws = (unsigned char*)d_ws;
#if MK_PER_PHASE
    for (int p = 0; p < N_PHASES; ++p) {
        const int l = (p - 2) / 10, q = (p - 2) % 10;
        if (p >= 2 && (((l & 1) && (q == 2 || q == 3)) || (l == DEPTH - 1 && q == 6))) continue;
        a.ph_lo = p; a.ph_hi = p + 1;
        hipLaunchKernelGGL(fwd_kernel, dim3(grid), dim3(512), LDS_BYTES, stream, a);
    }
#else
    a.ph_lo = 0; a.ph_hi = N_PHASES;
    hipLaunchKernelGGL(fwd_kernel, dim3(grid), dim3(512), LDS_BYTES, stream, a);
#endif
}
```

```cpp
#include <hip/hip_runtime.h>
#include <cstdio>
#include <cstdint>

#define LAS __attribute__((address_space(3)))
#define GAS __attribute__((address_space(1)))
#define DI __device__ __forceinline__
typedef unsigned short bf16_t;
typedef short bf16x8 __attribute__((ext_vector_type(8)));
typedef short s16x4 __attribute__((ext_vector_type(4)));
typedef float f32x2 __attribute__((ext_vector_type(2)));
typedef float f32x4 __attribute__((ext_vector_type(4)));
typedef float f32x16 __attribute__((ext_vector_type(16)));
typedef unsigned u32x2 __attribute__((ext_vector_type(2)));
typedef unsigned u32x4 __attribute__((ext_vector_type(4)));
typedef __bf16 bf16x2_t __attribute__((ext_vector_type(2)));

constexpr int D = 1024, NBATCH = 8, SEQ = 4096, CTXL = 256, DEPTH = 4;
constexpr int TLAT = NBATCH * SEQ, TCTX = NBATCH * CTXL, TALL = TLAT + TCTX;
constexpr int EVEN_IN = 3104, EVEN_LD = 3328, ODD_IN = 1280;
constexpr int NEXP = 32, TOPK = 4, DEXP = 1024;
constexpr int C_Q = 0, C_K = 256, C_V = 512, C_G = 1024, C_NQ = 1536, C_NK = 2048, C_NV = 2560, C_AF = 3072, C_AB = 3088;
DI size_t pidx(int tok, int col) { return ((size_t)(col >> 6) * TALL + tok) * 64 + (col & 63); }
constexpr int O_Q = 0, O_K = 1024, O_V = 1152;
constexpr float EPS = 1e-6f;
constexpr float LOG2E = 1.4426950408889634f;

constexpr size_t MiB = 1u << 20;
constexpr size_t WS_CTL = 0, CTL_ZERO_BYTES = 1 * MiB;
constexpr size_t WS_MODV = 1 * MiB;
constexpr size_t WS_WGU = 2 * MiB;
constexpr size_t WS_WDN = WS_WGU + 512 * MiB;
constexpr size_t WS_WINE = WS_WDN + 256 * MiB;
constexpr size_t WS_WINO = WS_WINE + 13 * MiB;
constexpr size_t WS_WOUT = WS_WINO + 5 * MiB;
constexpr size_t WS_X = WS_WOUT + 8 * MiB;
constexpr size_t WS_H = WS_X + 136 * MiB;
constexpr size_t WS_PRJ = WS_H + 68 * MiB;
constexpr size_t WS_OMIX = WS_PRJ + 221 * MiB;
constexpr size_t WS_ACT = WS_OMIX + 68 * MiB;
constexpr size_t WS_Y = WS_ACT + 288 * MiB;
constexpr size_t WS_LIST = WS_Y + 272 * MiB;
constexpr size_t WS_WTOK = WS_LIST + 5 * MiB;
constexpr size_t WS_GU = WS_WTOK + 5 * MiB;
constexpr size_t WS_GD = WS_GU + 136 * MiB;
constexpr size_t WS_GS = WS_GD + 2 * MiB;
constexpr size_t WS_GQ = WS_GS + 68 * MiB;
constexpr size_t WS_GK = WS_GQ + 34 * MiB;
constexpr size_t WS_RTB = WS_GK + 34 * MiB;
constexpr size_t WS_RTBIAS = WS_MODV + 917504;
constexpr size_t WS_END = WS_RTB + 5 * MiB;
static_assert(TALL * (size_t)D * 4 <= 136 * MiB && TALL * (size_t)EVEN_LD * 2 <= 221 * MiB && (size_t)TALL * 4 * D * 2 <= 272 * MiB, "ws map");
constexpr int CW_BAR = 4096;
constexpr int CW_CNT = 8192;

constexpr int RING_BYTES = 131072;
constexpr int MISC_OFF = RING_BYTES;
constexpr int MISC_BYTES = 12288;
constexpr int LDS_BYTES = 9 * 16896 + 8192 + 1264 + 16;
constexpr int XB_OFF = LDS_BYTES - 16;
static_assert(MISC_OFF + MISC_BYTES <= XB_OFF && 9 * 16896 + 8192 <= XB_OFF && XB_OFF + 16 <= LDS_BYTES && LDS_BYTES <= 163840 && XB_OFF % 16 == 0, "LDS map");

DI unsigned f2bf(float f) { unsigned u = __builtin_bit_cast(unsigned, f); return (u + 0x7fffu + ((u >> 16) & 1u)) >> 16; }
DI unsigned pk2(float lo, float hi) { f32x2 v = {lo, hi}; bf16x2_t b = __builtin_convertvector(v, bf16x2_t); return __builtin_bit_cast(unsigned, b); }
DI float bflo(unsigned u) { return __builtin_bit_cast(float, u << 16); }
DI float bfhi(unsigned u) { return __builtin_bit_cast(float, u & 0xffff0000u); }
DI float bf2f(bf16_t b) { return __builtin_bit_cast(float, ((unsigned)b) << 16); }
DI float wave_sum(float v) {
#pragma unroll
    for (int o = 1; o < 64; o <<= 1) v += __shfl_xor(v, o);
    return v;
}
DI float xhalf_max(float x) { const auto rr = __builtin_amdgcn_permlane32_swap(__builtin_bit_cast(unsigned, x), __builtin_bit_cast(unsigned, x), false, false); return fmaxf(__builtin_bit_cast(float, rr[0]), __builtin_bit_cast(float, rr[1])); }
DI float xhalf_sum(float x) { const auto rr = __builtin_amdgcn_permlane32_swap(__builtin_bit_cast(unsigned, x), __builtin_bit_cast(unsigned, x), false, false); return __builtin_bit_cast(float, rr[0]) + __builtin_bit_cast(float, rr[1]); }
DI float dpp_xor1(float x) { return __builtin_bit_cast(float, __builtin_amdgcn_update_dpp(0, __builtin_bit_cast(int, x), 0xB1, 0xF, 0xF, true)); }
DI float dpp_xor2(float x) { return __builtin_bit_cast(float, __builtin_amdgcn_update_dpp(0, __builtin_bit_cast(int, x), 0x4E, 0xF, 0xF, true)); }
DI float dpp_hmirror(float x) { return __builtin_bit_cast(float, __builtin_amdgcn_update_dpp(0, __builtin_bit_cast(int, x), 0x141, 0xF, 0xF, true)); }
#define LDS_WAIT() asm volatile("s_waitcnt lgkmcnt(0)" ::: "memory")
#define VM_WAIT() asm volatile("s_waitcnt vmcnt(0)" ::: "memory")

#define XB_TMO      128
#define XB_XCNT(j)  (256  + 64 * (j))
#define XB_XSUB(j)  (1280 + 64 * (j))
#define XB_XGEN(j)  (2304 + 64 * (j))
#define XB_TOP      3328
#define XB_TOPGEN   3392
#define XCD_BAR_WORDS 3456
#define XB_SPIN_CAP (1u << 22)
DI unsigned xb_ld(unsigned* p)              { return __hip_atomic_load(p, __ATOMIC_RELAXED, __HIP_MEMORY_SCOPE_AGENT); }
DI unsigned xb_add(unsigned* p, unsigned v) { return __hip_atomic_fetch_add(p, v, __ATOMIC_RELAXED, __HIP_MEMORY_SCOPE_AGENT); }
DI unsigned xb_xcc_id() { return (unsigned)__builtin_amdgcn_s_getreg((3 << 11) | 20) & 0xFu; }
#define XB_SPIN(cond, bar) do { unsigned _sp = 0; while (cond) { __builtin_amdgcn_s_sleep(1); \
    if ((++_sp & 255u) == 0u) { if (xb_ld(&(bar)[XB_TMO])) break; if (_sp > XB_SPIN_CAP) { atomicAdd(&(bar)[XB_TMO], 1u); break; } } } } while (0)
struct XcdBarrier { unsigned* bar; unsigned x; volatile LAS unsigned* st; int wave; };
DI bool xb_first(int wave) { return wave == 0 && __builtin_amdgcn_mbcnt_hi(~0u, __builtin_amdgcn_mbcnt_lo(~0u, 0u)) == 0u; }
DI XcdBarrier xcd_barrier_post(unsigned* bar, volatile LAS unsigned* st, int wave) {
    XcdBarrier b; b.bar = bar; b.x = xb_xcc_id(); b.st = st; b.wave = wave;
    if (xb_first(wave)) (void)xb_add(&bar[XB_XCNT(b.x)], 1u);
    return b;
}
DI void xcd_barrier_complete(unsigned* bar, unsigned x, unsigned& nloc, unsigned& nx) {
    const unsigned G = gridDim.x * gridDim.y * gridDim.z;
    unsigned sum, cnt, mine, sp = 0u;
    for (;;) {
        sum = 0u; cnt = 0u; mine = 0u;
#pragma unroll
        for (unsigned j = 0; j < 16; ++j) { const unsigned c = xb_ld(&bar[XB_XCNT(j)]); sum += c; cnt += (c > 0u) ? 1u : 0u; mine = (j == x) ? c : mine; }
        if (sum == G) break;
        __builtin_amdgcn_s_sleep(1);
        if ((++sp & 255u) == 0u) { if (xb_ld(&bar[XB_TMO])) break; if (sp > XB_SPIN_CAP) { atomicAdd(&bar[XB_TMO], 1u); break; } }
    }
    nloc = mine > 0u ? mine : 1u; nx = cnt > 0u ? cnt : 1u;
}
DI void xcd_barrier(const XcdBarrier& b) {
    asm volatile("s_waitcnt vmcnt(0)" ::: "memory");
    __syncthreads();
    if (xb_first(b.wave)) {
        unsigned* bar = b.bar;
        __builtin_amdgcn_s_waitcnt(0);
        unsigned nloc = b.st[0], nx = b.st[1];
        if (nloc == 0u) { xcd_barrier_complete(bar, b.x, nloc, nx); b.st[0] = nloc; b.st[1] = nx; }
        const unsigned old = xb_add(&bar[XB_XSUB(b.x)], 1u);
        const unsigned gen = old / nloc;
        if (old + 1u == (gen + 1u) * nloc) {
            __builtin_amdgcn_fence(__ATOMIC_RELEASE, "agent");
            asm volatile("s_waitcnt vmcnt(0)" ::: "memory");
            const unsigned og = xb_add(&bar[XB_TOP], 1u);
            const unsigned tg = og / nx;
            if (og + 1u == (tg + 1u) * nx) xb_add(&bar[XB_TOPGEN], 1u);
            else XB_SPIN(xb_ld(&bar[XB_TOPGEN]) == tg, bar);
            __builtin_amdgcn_fence(__ATOMIC_ACQUIRE, "agent");
            xb_add(&bar[XB_XGEN(b.x)], 1u);
            asm volatile("s_waitcnt vmcnt(0)" ::: "memory");
        } else {
            XB_SPIN(xb_ld(&bar[XB_XGEN(b.x)]) == gen, bar);
            __builtin_amdgcn_fence(__ATOMIC_ACQUIRE, "agent");
            asm volatile("s_waitcnt vmcnt(0)" ::: "memory");
        }
    }
    __syncthreads();
}

namespace pg8 {
constexpr int BM = 256, BK = 64, HALF = 128, HTB = HALF * BK * 2, STAGE_BYTES = 8 * HTB, NXCD = 8, WGM = 8, KDIM = 1024, NT = KDIM / BK;
DI int lds_byte(int r, int c) { const int st = (r >> 4) * 2 + (c >> 5), rr = r & 15, cc = c & 31, ob = rr * 64 + cc * 2; return st * 1024 + (ob ^ (((ob >> 9) & 1) << 5)); }
DI void stage_rc(int b, int& R, int& C) { const int st = b / 1024, sb = b % 1024, swz = sb ^ (((sb >> 9) & 1) << 5); R = (st >> 1) * 16 + swz / 64; C = (st & 1) * 32 + (swz % 64) / 2; }
DI int perm32(int rho) { const int n = rho >> 4, i = rho & 15; return 8 * (i >> 2) + 4 * n + (i & 3); }

struct Unit { const char* A; const char* B; int r0, c0, e, nvalid; const int* gl; const float* wl; };
struct TileOrder {
    int nM, nN, nwg, G, c;
    DI void init(int nM_, int nN_, int G_, int c_) { nM = nM_; nN = nN_; nwg = nM * nN; G = G_; c = c_; }
    DI bool tile(int i, int& pm, int& pn) const {
        const long L = (long)i * G + c; if (L >= nwg) return false;
        int wgid = (int)L; { const int q = nwg / NXCD, r = nwg % NXCD, xcd = wgid % NXCD, off = wgid / NXCD; wgid = (xcd < r ? xcd * (q + 1) : r * (q + 1) + (xcd - r) * q) + off; }
        const int nig = WGM * nN, gid = wgid / nig, fm = gid * WGM, gsz = (nM - fm) < WGM ? (nM - fm) : WGM;
        pm = fm + ((wgid % nig) % gsz); pn = (wgid % nig) / gsz; return true;
    }
};

template <class Epi, class Sched, bool GATHER>
DI void gemm_phase(LAS unsigned char* lds, const Sched& S, const Epi& E, const int wave_sgpr, LAS unsigned* side) {
    int tid = wave_sgpr * 64 + (int)__builtin_amdgcn_mbcnt_hi(~0u, __builtin_amdgcn_mbcnt_lo(~0u, 0u)); asm volatile("" : "+v"(tid));
    const int wid = __builtin_amdgcn_readfirstlane(tid >> 6), lane = tid & 63, wr = wid >> 2, wc = wid & 3, fr = lane & 15, fq = lane >> 4;
    constexpr int K = KDIM, nt = NT;
    unsigned voffA, voffB;
    { int R, C; stage_rc(tid * 16, R, C); const int Rb = Epi::PERM ? ((R & ~31) + perm32(R & 31)) : R;
      voffA = GATHER ? (unsigned)(C * 2) : (unsigned)(R * K + C) * 2u; voffB = (unsigned)(Rb * K + C) * 2u; }
    constexpr size_t pstep = (size_t)64 * K * 2;
    constexpr size_t kstep = (size_t)(BK * 2);
    constexpr size_t hstep = (size_t)HALF * K * 2;
    const unsigned ldsw = (unsigned)wid * 1024u;
    const int aoff = lds_byte(wr * 64 + fr, fq * 8), boff = lds_byte(wc * 32 + fr, fq * 8);
#define PG8_SA(b, h) (((b) * 2 + (h)) * HTB)
#define PG8_SB(b, h) ((4 + (b) * 2 + (h)) * HTB)
#define PG8_STAGE(bufoff, gbase, voff) do { _Pragma("unroll") for (int _i = 0; _i < 2; ++_i) \
        __builtin_amdgcn_global_load_lds((const unsigned*)((const char*)(gbase) + (size_t)_i * pstep + (voff)), (LAS unsigned*)(lds + (bufoff) + ldsw + _i * 8192), 16, 0, 0); } while (0)
#define PG8_STAGE_A(bufoff, gbase, ko, h, go) do { _Pragma("unroll") for (int _i = 0; _i < 2; ++_i) \
        __builtin_amdgcn_global_load_lds((const unsigned*)((const char*)(gbase) + (ko) + (GATHER ? (size_t)(go)[h][_i] : (size_t)(h) * hstep + (size_t)_i * pstep) + voffA), (LAS unsigned*)(lds + (bufoff) + ldsw + _i * 8192), 16, 0, 0); } while (0)
#define PG8_LDA(dst, b, h) do { _Pragma("unroll") for (int m = 0; m < 4; ++m) _Pragma("unroll") for (int k = 0; k < 2; ++k) dst[m][k] = *(const LAS bf16x8*)(lds + PG8_SA(b, h) + aoff + m * 2048 + k * 1024); } while (0)
#define PG8_LDB(dst, b, h) do { _Pragma("unroll") for (int n = 0; n < 2; ++n) _Pragma("unroll") for (int k = 0; k < 2; ++k) dst[n][k] = *(const LAS bf16x8*)(lds + PG8_SB(b, h) + boff + n * 2048 + k * 1024); } while (0)
#define PG8_MMA(ai, bj, At, Bt) do { __builtin_amdgcn_s_setprio(1); _Pragma("unroll") for (int m = 0; m < 4; ++m) _Pragma("unroll") for (int n = 0; n < 2; ++n) _Pragma("unroll") for (int k = 0; k < 2; ++k) \
        acc[ai][bj][m][n] = __builtin_amdgcn_mfma_f32_16x16x32_bf16(Bt[n][k], At[m][k], acc[ai][bj][m][n], 0, 0, 0); __builtin_amdgcn_s_setprio(0); } while (0)
#define PG8_WAIT_V(n) asm volatile("s_waitcnt vmcnt(" #n ")" ::: "memory")
#define PG8_WAIT_L(n) asm volatile("s_waitcnt lgkmcnt(" #n ")" ::: "memory")
#define PG8_BAR __builtin_amdgcn_s_barrier()
#define PG8_SCHED __builtin_amdgcn_sched_barrier(0)
    Unit cur, nxt; int ui = 0;
    if (!S.next(0, cur)) return;
    f32x4 acc[2][2][4][2];
#pragma unroll
    for (int a = 0; a < 2; ++a)
#pragma unroll
        for (int b = 0; b < 2; ++b)
#pragma unroll
            for (int m = 0; m < 4; ++m)
#pragma unroll
                for (int n = 0; n < 2; ++n) acc[a][b][m][n] = (f32x4){0.f, 0.f, 0.f, 0.f};
    bf16x8 At[4][2], B0[2][2], B1[2][2];
    unsigned gc[2][2] = {{0u, 0u}, {0u, 0u}}, gn[2][2] = {{0u, 0u}, {0u, 0u}};
    if (GATHER) {
#pragma unroll
        for (int i = 0; i < 2; ++i) { int R, C; stage_rc(tid * 16 + i * 8192, R, C);
#pragma unroll
            for (int h = 0; h < 2; ++h) gc[h][i] = S.goff(cur, h * HALF + R); }
#pragma unroll
        for (int i = 0; i < 2; ++i)
#pragma unroll
            for (int h = 0; h < 2; ++h) gc[h][i] = Sched::gbytes(gc[h][i]);
    }
    const char* cA = cur.A; const char* cB = cur.B;
    PG8_STAGE(PG8_SB(0, 0), cB, voffB); PG8_STAGE(PG8_SB(0, 1), cB + hstep, voffB); PG8_STAGE_A(PG8_SA(0, 0), cA, 0, 0, gc); PG8_STAGE_A(PG8_SA(0, 1), cA, 0, 1, gc);
    if (wr == 1) PG8_BAR;
    PG8_WAIT_V(2); PG8_BAR;
    PG8_STAGE(PG8_SB(1, 0), cB + kstep, voffB); PG8_STAGE_A(PG8_SA(1, 0), cA, kstep, 0, gc); PG8_STAGE(PG8_SB(1, 1), cB + hstep + kstep, voffB);
    PG8_WAIT_V(6); PG8_BAR;
    for (;;) {
        LAS unsigned* side_u = side + (ui & 1) * 768;
        if (Epi::NSIDE > 0 && wid < 4) E.side_issue(cur, tid, side_u);
        const bool has_next = S.next(ui + 1, nxt);
        const char* nA = has_next ? nxt.A : cA; const char* nB = has_next ? nxt.B : cB;
        for (int t = 0; t < nt; t += 2) {
            const bool last = (t == nt - 2);
            if (GATHER && t == nt - 6) {
                int t2 = tid; asm volatile("" : "+v"(t2));
#pragma unroll
                for (int i = 0; i < 2; ++i) { int R, C; stage_rc(t2 * 16 + i * 8192, R, C);
#pragma unroll
                    for (int h = 0; h < 2; ++h) gn[h][i] = S.goff(has_next ? nxt : cur, h * HALF + R); }
            }
            const size_t k1 = (size_t)(t + 1) * kstep;
            const char* a2 = last ? nA : cA; const size_t ka2 = last ? 0 : (size_t)(t + 2) * kstep;
            const char* b2 = last ? nB : cB + (size_t)(t + 2) * kstep;
            const char* b3 = b2 + kstep;
            PG8_LDB(B0, 0, 0); PG8_LDB(B1, 0, 1); PG8_SCHED; PG8_LDA(At, 0, 0); PG8_STAGE_A(PG8_SA(1, 1), cA, k1, 1, gc);
            if (GATHER && last) {
#pragma unroll
                for (int h = 0; h < 2; ++h)
#pragma unroll
                    for (int i = 0; i < 2; ++i) gc[h][i] = Sched::gbytes(gn[h][i]);
            }
            PG8_WAIT_V(8); PG8_WAIT_L(0); PG8_BAR; PG8_MMA(0, 0, At, B0); PG8_MMA(0, 1, At, B1); PG8_BAR; PG8_SCHED;
            PG8_LDA(At, 0, 1); PG8_STAGE(PG8_SB(0, 0), b2, voffB); PG8_STAGE(PG8_SB(0, 1), b2 + hstep, voffB); PG8_STAGE_A(PG8_SA(0, 0), a2, ka2, 0, gc);
            PG8_WAIT_V(8); PG8_WAIT_L(0); PG8_BAR; PG8_MMA(1, 0, At, B0); PG8_MMA(1, 1, At, B1); PG8_BAR; PG8_SCHED;
            PG8_LDB(B0, 1, 0); PG8_LDB(B1, 1, 1); PG8_SCHED; PG8_LDA(At, 1, 0); PG8_STAGE_A(PG8_SA(0, 1), a2, ka2, 1, gc);
            PG8_WAIT_V(8); PG8_WAIT_L(0); PG8_BAR; PG8_MMA(0, 0, At, B0); PG8_MMA(0, 1, At, B1); PG8_BAR; PG8_SCHED;
            PG8_LDA(At, 1, 1); PG8_STAGE(PG8_SB(1, 0), b3, voffB); PG8_STAGE(PG8_SB(1, 1), b3 + hstep, voffB); PG8_STAGE_A(PG8_SA(1, 0), a2, ka2 + kstep, 0, gc);
            PG8_WAIT_V(8); PG8_WAIT_L(0); PG8_BAR; PG8_MMA(1, 0, At, B0); PG8_MMA(1, 1, At, B1); PG8_BAR; PG8_SCHED;
        }
        if (wr == 0) PG8_BAR;
        E(acc, cur, wr, wc, fr, fq, side_u);
        if (!has_next) break;
#pragma unroll
        for (int a = 0; a < 2; ++a)
#pragma unroll
            for (int b = 0; b < 2; ++b)
#pragma unroll
                for (int m = 0; m < 4; ++m)
#pragma unroll
                    for (int n = 0; n < 2; ++n) acc[a][b][m][n] = (f32x4){0.f, 0.f, 0.f, 0.f};
        cur = nxt; cA = nA; cB = nB; ++ui;
        if (wr == 1) PG8_BAR;
    }
    PG8_WAIT_V(0);
    PG8_BAR;
#undef PG8_SA
#undef PG8_SB
#undef PG8_STAGE
#undef PG8_STAGE_A
#undef PG8_LDA
#undef PG8_LDB
#undef PG8_MMA
#undef PG8_WAIT_V
#undef PG8_WAIT_L
#undef PG8_BAR
#undef PG8_SCHED
}
}

struct Frame {
    LAS unsigned char* lds;
    unsigned* ctl;
    unsigned char* ws;
    const float* const* in;
    float* out;
    int wave, G, blk;
};
DI int lane_id() { return (int)__builtin_amdgcn_mbcnt_hi(~0u, __builtin_amdgcn_mbcnt_lo(~0u, 0u)); }
DI const float* inp(const Frame& F, int i) {
    const unsigned long long v = (unsigned long long)F.in[i];
    const unsigned lo = __builtin_amdgcn_readfirstlane((unsigned)v), hi = __builtin_amdgcn_readfirstlane((unsigned)(v >> 32));
    return (const float*)(((unsigned long long)hi << 32) | lo);
}
DI float* modv(const Frame& F, int l, int r) { return (float*)(F.ws + WS_MODV) + ((size_t)l * 9 + r) * 6144; }
DI int bidx_of(int row) { return row < TLAT ? (row >> 12) : 8; }

struct CvtRegs { f32x4 v[16]; };
DI void convert_load(CvtRegs& R, const float* src, int ld, int nvalid, int lane) {
    const int c4 = (lane & 15) * 4, kr = lane >> 4;
#pragma unroll
    for (int i = 0; i < 16; ++i) R.v[i] = (c4 < nvalid) ? __builtin_nontemporal_load((const f32x4*)(src + (size_t)(kr + 4 * i) * ld + c4)) : (f32x4){0.f, 0.f, 0.f, 0.f};
}
DI void convert_store(const CvtRegs& R, int nvalid, bf16_t* dst, LAS float* scr, int lane, bf16_t* dst_hi = nullptr) {
    const int c4 = (lane & 15) * 4, kr = lane >> 4;
#pragma unroll
    for (int i = 0; i < 16; ++i) { LAS float* p = scr + (kr + 4 * i) * 65 + c4; p[0] = R.v[i][0]; p[1] = R.v[i][1]; p[2] = R.v[i][2]; p[3] = R.v[i][3]; }
    LDS_WAIT(); asm volatile("" ::: "memory");
#pragma unroll
    for (int j = 0; j < 8; ++j) {
        const int q = lane + 64 * j, n = q >> 3, c8 = q & 7;
        const LAS float* s = scr + (8 * c8) * 65 + n;
        u32x4 o; o.x = pk2(s[0], s[65]); o.y = pk2(s[2 * 65], s[3 * 65]); o.z = pk2(s[4 * 65], s[5 * 65]); o.w = pk2(s[6 * 65], s[7 * 65]);
        if (n < nvalid) *(u32x4*)(((dst_hi && n >= 32) ? dst_hi : dst) + (size_t)n * 1024 + 8 * c8) = o;
    }
    LDS_WAIT(); asm volatile("" ::: "memory");
}
DI void convert_tile(const float* src, int ld, int nvalid, bf16_t* dst, LAS float* scr, int lane, bf16_t* dst_hi = nullptr) {
    CvtRegs R; convert_load(R, src, ld, nvalid, lane); convert_store(R, nvalid, dst, scr, lane, dst_hi);
}
DI float silu_f(float x) { return x / (1.f + __expf(-x)); }
DI void convert_moe_layer(const Frame& F, int l, int bidx, int nblk) {
    const int lane = lane_id();
    LAS float* scr = (LAS float*)(F.lds + F.wave * 16640);
    const int gw = bidx * 8 + F.wave, NGW = nblk * 8;
    constexpr int T_GU = 32 * 512, T_DN = 32 * 256;
    const float* gu = inp(F, 23) + (size_t)l * 32 * 1024 * 2048; const float* dn = inp(F, 25) + (size_t)l * 32 * 1024 * 1024;
    bf16_t* wgu = (bf16_t*)(F.ws + WS_WGU) + (size_t)l * 32 * 2048 * 1024; bf16_t* wdn = (bf16_t*)(F.ws + WS_WDN) + (size_t)l * 32 * 1024 * 1024;
    auto tsrc = [&](int t, int& ld) -> const float* { if (t < T_GU) { const int mat = t >> 9, kb = (t >> 5) & 15, nb = t & 31; ld = 2048; return gu + (size_t)mat * 1024 * 2048 + (size_t)(kb * 64) * 2048 + nb * 64; }
        const int r = t - T_GU, mat = r >> 8, kb = (r >> 4) & 15, nb = r & 15; ld = 1024; return dn + (size_t)mat * 1024 * 1024 + (size_t)(kb * 64) * 1024 + nb * 64; };
    auto tdst = [&](int t) -> bf16_t* { if (t < T_GU) { const int mat = t >> 9, kb = (t >> 5) & 15, nb = t & 31, n0 = nb * 64;
            const int drow = n0 < 1024 ? ((n0 >> 7) * 256 + (n0 & 127)) : ((((n0 - 1024) >> 7) * 256) + 128 + ((n0 - 1024) & 127));
            return wgu + (size_t)mat * 2048 * 1024 + (size_t)drow * 1024 + kb * 64; }
        const int r = t - T_GU, mat = r >> 8, kb = (r >> 4) & 15, nb = r & 15; return wdn + (size_t)mat * 1024 * 1024 + (size_t)(nb * 64) * 1024 + kb * 64; };
    constexpr int NT_ALL = T_GU + T_DN;
    CvtRegs RA, RB; int ld;
    if (gw < NT_ALL) { const float* sp = tsrc(gw, ld); convert_load(RA, sp, ld, 64, lane); }
    for (int t = gw; t < NT_ALL; t += 2 * NGW) {
        const int t1 = t + NGW, t2 = t + 2 * NGW;
        if (t1 < NT_ALL) { const float* sp = tsrc(t1, ld); convert_load(RB, sp, ld, 64, lane); }
        convert_store(RA, 64, tdst(t), scr, lane);
        if (t1 < NT_ALL) {
            if (t2 < NT_ALL) { const float* sp = tsrc(t2, ld); convert_load(RA, sp, ld, 64, lane); }
            convert_store(RB, 64, tdst(t1), scr, lane);
        }
    }
}
DI void convert_small(const Frame& F) {
    const int lane = lane_id();
    LAS float* scr = (LAS float*)(F.lds + F.wave * 16640);
    const int gw = F.blk * 8 + F.wave, NGW = F.G * 8;
    constexpr int T_WO = 4 * 256, T_WE = 2 * 16 * 49, T_WD = 2 * 16 * 20;
    for (int t = gw; t < T_WO + T_WE + T_WD; t += NGW) {
        int r = t;
        if (r < T_WO) { const int l = r >> 8, kb = (r >> 4) & 15, nb = r & 15; const float* src = ((l & 1) ? inp(F, 17) : inp(F, 9)) + (size_t)(l >> 1) * 1024 * 1024;
            convert_tile(src + (size_t)(kb * 64) * 1024 + nb * 64, 1024, 64, (bf16_t*)(F.ws + WS_WOUT) + (size_t)l * 1024 * 1024 + (size_t)(nb * 64) * 1024 + kb * 64, scr, lane); continue; }
        r -= T_WO;
        if (r < T_WE) { const int i = r / (16 * 49), q = r % (16 * 49), kb = q / 49, nb = q % 49; const int nv = (EVEN_IN - nb * 64) < 64 ? (EVEN_IN - nb * 64) : 64;
            const int n0 = nb * 64, d0 = n0 < 1536 ? n0 : (n0 == 1536 ? 3072 : n0 - 32), d1 = n0 == 1536 ? 1536 : d0 + 32;
            bf16_t* wb = (bf16_t*)(F.ws + WS_WINE) + (size_t)i * EVEN_LD * 1024 + kb * 64;
            convert_tile(inp(F, 8) + (size_t)i * 1024 * EVEN_IN + (size_t)(kb * 64) * EVEN_IN + n0, EVEN_IN, nv, wb + (size_t)d0 * 1024, scr, lane, wb + (size_t)(d1 - 32) * 1024); continue; }
        r -= T_WE;
        { const int i = r / (16 * 20), q = r % (16 * 20), kb = q / 20, nb = q % 20;
            convert_tile(inp(F, 16) + (size_t)i * 1024 * ODD_IN + (size_t)(kb * 64) * ODD_IN + nb * 64, ODD_IN, 64, (bf16_t*)(F.ws + WS_WINO) + (size_t)i * ODD_IN * 1024 + (size_t)(nb * 64) * 1024 + kb * 64, scr, lane); }
    }
}
DI void phase_p0(const Frame& F) {
    const int lane = lane_id(), tid = F.wave * 64 + lane; (void)tid; (void)lane;
    for (int item = F.blk; item < 96; item += F.G) {
        const int l = item / 24, cc = item % 24;
        LAS float* sil = (LAS float*)F.lds;
        LAS float* part = (LAS float*)(F.lds + 36864);
        for (int i = tid; i < 9 * 1024; i += 512) { const int r = i >> 10, k = i & 1023; const float c = r < 8 ? inp(F, 1)[r * 1024 + k] : inp(F, 3)[k]; sil[i] = silu_f(c); }
        __syncthreads();
        const float* W = inp(F, 4) + (size_t)l * 1024 * 6144 + cc * 256 + 4 * lane;
        f32x4 acc[9];
#pragma unroll
        for (int r = 0; r < 9; ++r) acc[r] = (f32x4){0.f, 0.f, 0.f, 0.f};
        for (int k = 128 * F.wave; k < 128 * F.wave + 128; ++k) {
            const f32x4 w = *(const f32x4*)(W + (size_t)k * 6144);
#pragma unroll
            for (int r = 0; r < 9; ++r) { const float s = sil[r * 1024 + k]; acc[r] += w * s; }
        }
#pragma unroll
        for (int r = 0; r < 9; ++r) *(LAS f32x4*)(part + (F.wave * 9 + r) * 256 + 4 * lane) = acc[r];
        __syncthreads();
        for (int i = tid; i < 9 * 256; i += 512) { const int r = i >> 8, c = i & 255; float s = 0.f;
#pragma unroll
            for (int w = 0; w < 8; ++w) s += part[(w * 9 + r) * 256 + c];
            modv(F, l, r)[cc * 256 + c] = s + inp(F, 5)[l * 6144 + cc * 256 + c]; }
        __syncthreads();
    }
    convert_small(F);
    convert_moe_layer(F, 0, F.blk, F.G);
}

DI void norm_mod_store(const f32x4 (&v)[4], float rs, const float* gam, const float* mv_sh, const float* mv_sc, bf16_t* orow, int lane) {
#pragma unroll
    for (int j = 0; j < 4; ++j) {
        const int c = 4 * lane + 256 * j;
        const f32x4 g = *(const f32x4*)(gam + c), sc = *(const f32x4*)(mv_sc + c), sh = *(const f32x4*)(mv_sh + c);
        const f32x4 h = v[j] * rs * g * (sc + 1.0f) + sh;
        u32x2 o; o.x = pk2(h[0], h[1]); o.y = pk2(h[2], h[3]);
        *(u32x2*)(orow + c) = o;
    }
}
DI void phase_norm1_l0(const Frame& F) {
    const int lane = lane_id(), tid = F.wave * 64 + lane; (void)tid; (void)lane;
    {
        float* rtb = (float*)(F.ws + WS_RTB); float* rtbias = (float*)(F.ws + WS_RTBIAS);
        const float* gam2 = inp(F, 7); const float* wr_all = inp(F, 21); const float* br_all = inp(F, 22);
        const int gt = F.blk * 512 + tid, NGT = F.G * 512;
        for (int i = gt; i < 4 * 9 * 1024 * 32; i += NGT) { const int e = i & 31, k = (i >> 5) & 1023, lb = i >> 15, l = lb / 9, b = lb % 9;
            rtb[i] = gam2[l * D + k] * (1.0f + modv(F, l, b)[4096 + k]) * wr_all[((size_t)l * D + k) * NEXP + e]; }
        LAS float* red = (LAS float*)F.lds;
        for (int item = F.blk; item < 36; item += F.G) {
            const int l = item / 9, b = item % 9, e = tid & 31, part = tid >> 5; const float* sh = modv(F, l, b) + 3072 + part * 64; const float* wr = wr_all + ((size_t)l * D + part * 64) * NEXP + e;
            float a0 = 0.f, a1 = 0.f, a2 = 0.f, a3 = 0.f;
#pragma unroll 4
            for (int k = 0; k < 64; k += 4) { a0 += sh[k] * wr[(size_t)k * NEXP]; a1 += sh[k + 1] * wr[(size_t)(k + 1) * NEXP]; a2 += sh[k + 2] * wr[(size_t)(k + 2) * NEXP]; a3 += sh[k + 3] * wr[(size_t)(k + 3) * NEXP]; }
            red[part * 32 + e] = (a0 + a1) + (a2 + a3);
            __syncthreads();
            if (tid < 32) { float sacc = 0.f;
#pragma unroll
                for (int q = 0; q < 16; ++q) sacc += red[q * 32 + tid];
                rtbias[(l * 9 + b) * NEXP + tid] = sacc + br_all[l * NEXP + tid]; }
            __syncthreads();
        }
    }
    const int gw = F.blk * 8 + F.wave, NGW = F.G * 8;
    bf16_t* H = (bf16_t*)(F.ws + WS_H);
    for (int row = gw; row < TALL; row += NGW) {
        const float* xr = row < TLAT ? inp(F, 0) + (size_t)row * D : inp(F, 2) + (size_t)(row - TLAT) * D;
        f32x4 v[4]; float s = 0.f;
#pragma unroll
        for (int j = 0; j < 4; ++j) { v[j] = *(const f32x4*)(xr + 4 * lane + 256 * j); s += (v[j][0] * v[j][0] + v[j][1] * v[j][1]) + (v[j][2] * v[j][2] + v[j][3] * v[j][3]); }
        const float rs = 1.0f / sqrtf(wave_sum(s) * (1.f / D) + EPS);
        const float* mv = modv(F, 0, bidx_of(row));
        norm_mod_store(v, rs, inp(F, 6), mv, mv + 1024, H + (size_t)row * D, lane);
    }
}
DI void phase_combine(const Frame& F, int l) {
    const int lane = lane_id(), tid = F.wave * 64 + lane; (void)tid; (void)lane;
    const int gw = F.blk * 8 + F.wave, NGW = F.G * 8;
    const int nrows = l < DEPTH - 1 ? TALL : TLAT;
    float* X = (float*)(F.ws + WS_X); bf16_t* H = (bf16_t*)(F.ws + WS_H); const bf16_t* Y = (const bf16_t*)(F.ws + WS_Y);
    for (int row = gw; row < nrows; row += NGW) {
        const int b = bidx_of(row);
        const float* g2 = modv(F, l, b) + 5120;
        f32x4 v[4]; float s = 0.f;
#pragma unroll
        for (int j = 0; j < 4; ++j) {
            const int c = 4 * lane + 256 * j;
            f32x4 y = (f32x4){0.f, 0.f, 0.f, 0.f};
#pragma unroll
            for (int k = 0; k < 4; ++k) { const u32x2 w = *(const u32x2*)(Y + ((size_t)row * 4 + k) * D + c); y += (f32x4){bflo(w.x), bfhi(w.x), bflo(w.y), bfhi(w.y)}; }
            v[j] = *(const f32x4*)(X + (size_t)row * D + c) + *(const f32x4*)(g2 + c) * y;
            s += (v[j][0] * v[j][0] + v[j][1] * v[j][1]) + (v[j][2] * v[j][2] + v[j][3] * v[j][3]);
        }
        if (l == DEPTH - 1) {
#pragma unroll
            for (int j = 0; j < 4; ++j) *(f32x4*)(F.out + (size_t)row * D + 4 * lane + 256 * j) = v[j];
        } else {
#pragma unroll
            for (int j = 0; j < 4; ++j) *(f32x4*)(X + (size_t)row * D + 4 * lane + 256 * j) = v[j];
            const float rs = 1.0f / sqrtf(wave_sum(s) * (1.f / D) + EPS);
            const float* mv = modv(F, l + 1, b);
            norm_mod_store(v, rs, inp(F, 6) + (l + 1) * D, mv, mv + 1024, H + (size_t)row * D, lane);
        }
    }
}

struct DenseSched {
    pg8::TileOrder ord; const char* A; const char* B; int pm0 = 0;
    DI bool next(int i, pg8::Unit& u) const { int pm, pn; if (!ord.tile(i, pm, pn)) return false; pm += pm0;
        u.A = A + (size_t)pm * 256 * 2048; u.B = B + (size_t)pn * 256 * 2048; u.r0 = pm * 256; u.c0 = pn * 256; u.e = 0; u.nvalid = 256; u.gl = nullptr; u.wl = nullptr; return true; }
    DI unsigned goff(const pg8::Unit&, int) const { return 0u; }
    static DI unsigned gbytes(unsigned e) { return e; }
};
struct MoeTables { const LAS int* tstart; const LAS int* cnt; };
DI void moe_tables_build(const Frame& F, int l, LAS int* tstart, LAS int* cnt) {
    const int lane = lane_id(), tid = F.wave * 64 + lane;
    if (tid < 64) {
        const int c = lane < NEXP ? (int)F.ctl[CW_CNT + 64 * l + lane] : 0; const int tiles = (c + 255) >> 8;
        int incl = tiles;
#pragma unroll
        for (int o = 1; o < 32; o <<= 1) { const int v = __shfl_up(incl, o); if (lane >= o) incl += v; }
        if (lane < NEXP) { cnt[lane] = c; tstart[lane] = incl - tiles; }
        if (lane == NEXP - 1) tstart[NEXP] = incl;
    }
    __syncthreads();
}
template <bool GATEUP> struct MoeSched {
    pg8::TileOrder ord; MoeTables T; const char* A; const char* W; const int* list; const float* wlist;
    DI bool next(int i, pg8::Unit& u) const { int mtg, pn; if (!ord.tile(i, mtg, pn)) return false;
        int e = 0;
#pragma unroll
        for (int s = 16; s >= 1; s >>= 1) { if (T.tstart[e + s] <= mtg) e += s; }
        const int mt = mtg - T.tstart[e];
        u.e = e; u.nvalid = T.cnt[e] - mt * 256; if (u.nvalid > 256) u.nvalid = 256; u.gl = list + (size_t)e * TALL + mt * 256; u.wl = wlist + (size_t)e * TALL + mt * 256; u.r0 = mtg * 256;
        if (GATEUP) { u.A = A; u.B = W + (size_t)e * (2048 * 2048) + (size_t)pn * 256 * 2048; u.c0 = pn * 128; }
        else { u.A = A + (size_t)mtg * 256 * 2048; u.B = W + (size_t)e * (1024 * 2048) + (size_t)pn * 256 * 2048; u.c0 = pn * 256; }
        return true; }
    DI unsigned goff(const pg8::Unit& u, int row) const { const int r = row < u.nvalid ? row : 0; return (unsigned)u.gl[r]; }
    static DI unsigned gbytes(unsigned entry) { return (entry >> 2) * 2048u; }
};

DI void dma4(const void* g, LAS unsigned* dst_wave_base) { __builtin_amdgcn_global_load_lds((const unsigned*)g, dst_wave_base, 4, 0, 0); }
struct EpiPrj {
    static constexpr bool PERM = true; static constexpr int NSIDE = 0;
    DI void side_issue(const pg8::Unit&, int, LAS unsigned*) const {}
    bf16_t* O; int ldc;
    DI void operator()(const f32x4 (&acc)[2][2][4][2], const pg8::Unit& u, int wr, int wc, int fr, int fq, const LAS unsigned*) const {
        const int row0 = u.r0 + wr * 64 + fr, col0 = u.c0 + wc * 32 + 8 * fq;
#pragma unroll
        for (int ai = 0; ai < 2; ++ai)
#pragma unroll
            for (int m = 0; m < 4; ++m) { const int row = row0 + ai * 128 + m * 16;
#pragma unroll
                for (int bj = 0; bj < 2; ++bj) { const f32x4 v0 = acc[ai][bj][m][0], v1 = acc[ai][bj][m][1];
                    u32x4 w; w.x = pk2(v0[0], v0[1]); w.y = pk2(v0[2], v0[3]); w.z = pk2(v1[0], v1[1]); w.w = pk2(v1[2], v1[3]);
                    *(u32x4*)(O + pidx(row, col0 + bj * 128)) = w; } }
    }
};
struct EpiRes {
    static constexpr bool PERM = false; static constexpr int NSIDE = 1;
    const float* xlat; const float* xctx; float* xout; const float* gate;
    DI void side_issue(const pg8::Unit& u, int t, LAS unsigned* side) const { dma4(gate + (size_t)bidx_of(u.r0) * 6144 + u.c0 + t, side + (t & ~63)); }
    DI void operator()(const f32x4 (&acc)[2][2][4][2], const pg8::Unit& u, int wr, int wc, int fr, int fq, const LAS unsigned* side) const {
        const int row0 = u.r0 + wr * 64 + fr, col0 = u.c0 + wc * 32 + 4 * fq;
        const float* xin = u.r0 < TLAT ? xlat : xctx - (size_t)TLAT * D;
        f32x4 gv[2][2];
#pragma unroll
        for (int bj = 0; bj < 2; ++bj)
#pragma unroll
            for (int n = 0; n < 2; ++n) gv[bj][n] = *(const LAS f32x4*)(side + wc * 32 + 4 * fq + bj * 128 + n * 16);
#pragma unroll
        for (int ai = 0; ai < 2; ++ai) {
            f32x4 xv[4][2][2];
#pragma unroll
            for (int m = 0; m < 4; ++m) { const size_t off = (size_t)(row0 + ai * 128 + m * 16) * D + col0;
#pragma unroll
                for (int bj = 0; bj < 2; ++bj)
#pragma unroll
                    for (int n = 0; n < 2; ++n) xv[m][bj][n] = *(const f32x4*)(xin + off + bj * 128 + n * 16); }
            asm volatile("" : "+v"(xv[0][0][0]), "+v"(xv[0][0][1]), "+v"(xv[0][1][0]), "+v"(xv[0][1][1]), "+v"(xv[1][0][0]), "+v"(xv[1][0][1]), "+v"(xv[1][1][0]), "+v"(xv[1][1][1]));
            asm volatile("" : "+v"(xv[2][0][0]), "+v"(xv[2][0][1]), "+v"(xv[2][1][0]), "+v"(xv[2][1][1]), "+v"(xv[3][0][0]), "+v"(xv[3][0][1]), "+v"(xv[3][1][0]), "+v"(xv[3][1][1]));
#pragma unroll
            for (int m = 0; m < 4; ++m) { const size_t off = (size_t)(row0 + ai * 128 + m * 16) * D + col0;
#pragma unroll
                for (int bj = 0; bj < 2; ++bj)
#pragma unroll
                    for (int n = 0; n < 2; ++n) *(f32x4*)(xout + off + bj * 128 + n * 16) = xv[m][bj][n] + gv[bj][n] * acc[ai][bj][m][n]; }
        }
    }
};
struct EpiSwiglu {
    static constexpr bool PERM = true; static constexpr int NSIDE = 1;
    bf16_t* ACT; const float* bgu;
    DI void side_issue(const pg8::Unit& u, int t, LAS unsigned* side) const { dma4(bgu + (size_t)u.e * 2048 + u.c0 + (t < 128 ? t : 1024 + t - 128), side + (t & ~63)); }
    DI void operator()(const f32x4 (&acc)[2][2][4][2], const pg8::Unit& u, int wr, int wc, int fr, int fq, const LAS unsigned* side) const {
        const int row0 = u.r0 + wr * 64 + fr, lc = wc * 32 + 8 * fq;
        f32x4 bgl[2], bli[2];
#pragma unroll
        for (int n = 0; n < 2; ++n) { bgl[n] = *(const LAS f32x4*)(side + lc + 4 * n); bli[n] = *(const LAS f32x4*)(side + 128 + lc + 4 * n); }
#pragma unroll
        for (int ai = 0; ai < 2; ++ai)
#pragma unroll
            for (int m = 0; m < 4; ++m) {
                float o[8];
#pragma unroll
                for (int n = 0; n < 2; ++n)
#pragma unroll
                    for (int j = 0; j < 4; ++j) {
                        float g = acc[ai][0][m][n][j] + bgl[n][j], li = acc[ai][1][m][n][j] + bli[n][j];
                        g = fminf(g, 7.0f); li = fminf(fmaxf(li, -7.0f), 7.0f);
                        const float sg = __builtin_amdgcn_rcpf(1.0f + __expf(-1.702f * g));
                        o[4 * n + j] = g * sg * (li + 1.0f);
                    }
                u32x4 w; w.x = pk2(o[0], o[1]); w.y = pk2(o[2], o[3]); w.z = pk2(o[4], o[5]); w.w = pk2(o[6], o[7]);
                *(u32x4*)(ACT + (size_t)(row0 + ai * 128 + m * 16) * 1024 + u.c0 + lc) = w;
            }
    }
};
struct EpiDown {
    static constexpr bool PERM = true; static constexpr int NSIDE = 3;
    bf16_t* Y; const float* bdn;
    DI void side_issue(const pg8::Unit& u, int t, LAS unsigned* side) const {
        const int r = t < u.nvalid ? t : 0;
        dma4(u.gl + r, side + (t & ~63)); dma4(u.wl + r, side + 256 + (t & ~63)); dma4(bdn + (size_t)u.e * 1024 + u.c0 + t, side + 512 + (t & ~63)); }
    DI void operator()(const f32x4 (&acc)[2][2][4][2], const pg8::Unit& u, int wr, int wc, int fr, int fq, const LAS unsigned* side) const {
        const int rl0 = wr * 64 + fr, lc = wc * 32 + 8 * fq, col0 = u.c0 + lc;
        f32x4 bv[2][2];
#pragma unroll
        for (int bj = 0; bj < 2; ++bj)
#pragma unroll
            for (int n = 0; n < 2; ++n) bv[bj][n] = *(const LAS f32x4*)(side + 512 + lc + bj * 128 + 4 * n);
#pragma unroll
        for (int ai = 0; ai < 2; ++ai)
#pragma unroll
            for (int m = 0; m < 4; ++m) {
                const int r = rl0 + ai * 128 + m * 16; const int ent = (int)side[r]; const float w = __builtin_bit_cast(float, side[256 + r]);
                if (r < u.nvalid) { bf16_t* rowp = Y + (size_t)ent * 1024 + col0;
#pragma unroll
                    for (int bj = 0; bj < 2; ++bj) { const f32x4 v0 = (acc[ai][bj][m][0] + bv[bj][0]) * w, v1 = (acc[ai][bj][m][1] + bv[bj][1]) * w;
                        u32x4 o; o.x = pk2(v0[0], v0[1]); o.y = pk2(v0[2], v0[3]); o.z = pk2(v1[0], v1[1]); o.w = pk2(v1[2], v1[3]);
                        *(u32x4*)(rowp + bj * 128) = o; } }
            }
    }
};

DI void phase_router(const Frame& F, int l, int grp_begin, int grp_end) {
    const int lane = lane_id(), tid = F.wave * 64 + lane;
    const int ngroups = grp_end - grp_begin;
    const float* __restrict__ X = (const float*)(F.ws + WS_X); bf16_t* __restrict__ Hh = (bf16_t*)(F.ws + WS_H);
    const float* gam = inp(F, 7) + l * D;
    LAS float* P = (LAS float*)F.lds;
    LAS float* SSq = (LAS float*)(F.lds + 32768);
    LAS int* cntL = (LAS int*)(F.lds + 36864 + 128);
    LAS int* baseL = (LAS int*)(F.lds + 36864 + 256);
    LAS int* entE = (LAS int*)(F.lds + 40960);
    LAS float* entW = (LAS float*)(F.lds + 40960 + 16384);
    LAS int* entT = (LAS int*)(F.lds + 40960 + 32768);
    if (tid < 32) cntL[tid] = 0;
    const int e_l = lane & 31, kk = lane >> 5;
    const int kbase = 128 * F.wave + 64 * kk;
    float Breg[64]; float bias_e = 0.f; int cur_b = -1;
#pragma unroll
    for (int s = 0; s < 64; ++s) Breg[s] = 0.f;
    __syncthreads();
    int nent = 0;
    const int g_lo = grp_begin + (int)(((long)F.blk * ngroups) / F.G), g_hi = grp_begin + (int)(((long)(F.blk + 1) * ngroups) / F.G);
    for (int g = g_lo; g < g_hi; ++g) {
        const int t0 = g * 32, b = bidx_of(t0);
        const float* mv = modv(F, l, b);
        const float* xr = X + (size_t)(t0 + e_l) * D + kbase;
        f32x4 xv[16];
#pragma unroll
        for (int q = 0; q < 16; ++q) xv[q] = *(const f32x4*)(xr + 4 * q);
        if (b != cur_b) {
            cur_b = b;
            const float* bp = (const float*)(F.ws + WS_RTB) + ((size_t)(l * 9 + b) * 1024 + kbase) * NEXP + e_l; const float* bp2 = bp + 32 * NEXP;
#pragma unroll
            for (int s = 0; s < 32; ++s) { Breg[s] = bp[s * NEXP]; Breg[32 + s] = bp2[s * NEXP]; }
            bias_e = ((const float*)(F.ws + WS_RTBIAS))[(l * 9 + b) * NEXP + e_l];
        }
        asm volatile("" : "+v"(xv[0]), "+v"(xv[1]), "+v"(xv[2]), "+v"(xv[3]), "+v"(xv[4]), "+v"(xv[5]), "+v"(xv[6]), "+v"(xv[7]));
        asm volatile("" : "+v"(xv[8]), "+v"(xv[9]), "+v"(xv[10]), "+v"(xv[11]), "+v"(xv[12]), "+v"(xv[13]), "+v"(xv[14]), "+v"(xv[15]));
        f32x16 acc;
#pragma unroll
        for (int i = 0; i < 16; ++i) acc[i] = 0.f;
        float ss = 0.f;
#pragma unroll
        for (int q = 0; q < 16; ++q) {
            ss += (xv[q][0] * xv[q][0] + xv[q][1] * xv[q][1]) + (xv[q][2] * xv[q][2] + xv[q][3] * xv[q][3]);
#pragma unroll
            for (int j = 0; j < 4; ++j) acc = __builtin_amdgcn_mfma_f32_32x32x2f32(xv[q][j], Breg[4 * q + j], acc, 0, 0, 0);
        }
        ss = xhalf_sum(ss);
        if (kk == 0) SSq[F.wave * 32 + e_l] = ss;
#pragma unroll
        for (int r = 0; r < 16; ++r) { const int i = (r & 3) + 8 * (r >> 2) + 4 * kk; P[(F.wave * 32 + i) * 32 + e_l] = acc[r]; }
        __syncthreads();
        {
            float tot = 0.f;
#pragma unroll
            for (int w = 0; w < 8; ++w) tot += SSq[w * 32 + e_l];
            const float rs = 1.0f / sqrtf(tot * (1.f / D) + EPS);
            bf16_t* hr = Hh + (size_t)(t0 + e_l) * D + kbase;
#pragma unroll
            for (int q = 0; q < 16; q += 2) {
                const f32x4 g0 = *(const f32x4*)(gam + kbase + 4 * q), c0 = *(const f32x4*)(mv + 4096 + kbase + 4 * q), h0 = *(const f32x4*)(mv + 3072 + kbase + 4 * q);
                const f32x4 g1 = *(const f32x4*)(gam + kbase + 4 * q + 4), c1 = *(const f32x4*)(mv + 4096 + kbase + 4 * q + 4), h1 = *(const f32x4*)(mv + 3072 + kbase + 4 * q + 4);
                const f32x4 f0 = xv[q] * rs * g0 * (c0 + 1.0f) + h0, f1 = xv[q + 1] * rs * g1 * (c1 + 1.0f) + h1;
                u32x4 o; o.x = pk2(f0[0], f0[1]); o.y = pk2(f0[2], f0[3]); o.z = pk2(f1[0], f1[1]); o.w = pk2(f1[2], f1[3]);
                *(u32x4*)(hr + 4 * q) = o;
            }
        }
#pragma unroll 1
        for (int pass = 0; pass < 2; ++pass) {
            const int ti = 4 * F.wave + 2 * pass + kk;
            float v = 0.f, tot = 0.f;
#pragma unroll
            for (int w = 0; w < 8; ++w) { v += P[(w * 32 + ti) * 32 + e_l]; tot += SSq[w * 32 + ti]; }
            v = (1.0f / sqrtf(tot * (1.f / D) + EPS)) * v + bias_e;
            float tv[4]; int te[4];
#pragma unroll
            for (int k = 0; k < 4; ++k) {
                float m = v;
#pragma unroll
                for (int o = 16; o >= 1; o >>= 1) m = fmaxf(m, __shfl_xor(m, o));
                const unsigned long long bal = __ballot(v == m);
                const unsigned half = (unsigned)(bal >> (32 * kk));
                const int idx = __builtin_ctz(half);
                tv[k] = m; te[k] = idx;
                if (e_l == idx) v = -3.0e38f;
            }
            const float e1 = __expf(tv[1] - tv[0]), e2 = __expf(tv[2] - tv[0]), e3 = __expf(tv[3] - tv[0]);
            const float inv = 1.0f / (1.0f + e1 + e2 + e3);
            const float wk[4] = {inv, e1 * inv, e2 * inv, e3 * inv};
            if (e_l < 4) {
                const int k = e_l; const int ex = k == 0 ? te[0] : k == 1 ? te[1] : k == 2 ? te[2] : te[3]; const float ww = k == 0 ? wk[0] : k == 1 ? wk[1] : k == 2 ? wk[2] : wk[3];
                const int rk = atomicAdd((int*)(cntL + ex), 1);
                const int n = nent + ti * 4 + k;
                entE[n] = (ex << 20) | rk; entW[n] = ww; entT[n] = (t0 + ti) * 4 + k;
            }
        }
        nent += 128;
        __syncthreads();
    }
    if (tid < 32) baseL[tid] = cntL[tid] > 0 ? (int)atomicAdd(F.ctl + CW_CNT + 64 * l + tid, (unsigned)cntL[tid]) : 0;
    __syncthreads();
    int* list = (int*)(F.ws + WS_LIST); float* wtok = (float*)(F.ws + WS_WTOK);
    for (int n = tid; n < nent; n += 512) { const int er = entE[n], ex = er >> 20, rk = er & 0xfffff, ent = entT[n];
        list[(size_t)ex * TALL + baseL[ex] + rk] = ent; wtok[(size_t)ex * TALL + baseL[ex] + rk] = entW[n]; }
    __syncthreads();
}

constexpr int KS = 128;
constexpr int VS = 136;
constexpr int K_IMG = 64 * KS, V_IMG = 64 * VS, KV_PAIR = K_IMG + V_IMG;
#define MFMA32(a, b, c) __builtin_amdgcn_mfma_f32_32x32x16_bf16((a), (b), (c), 0, 0, 0)
DI int crow(int r, int h) { return (r & 3) + 8 * (r >> 2) + 4 * h; }
struct KVRegs { u32x4 k, v; };
DI KVRegs kv_load(const bf16_t* prj, int ld, int tok, int kcol, int vcol, int part) {
    (void)ld; KVRegs x; x.k = *(const u32x4*)(prj + pidx(tok, kcol + part * 8)); x.v = *(const u32x4*)(prj + pidx(tok, vcol + part * 8)); return x;
}
template <bool ROPE> DI void kv_write(const KVRegs& x, LAS unsigned char* Kb, LAS unsigned char* VTb, int key, int part, const float* gk, const LAS f32x2* rtab, int prow, int pcol) {
    float kf[8];
    kf[0] = bflo(x.k.x); kf[1] = bfhi(x.k.x); kf[2] = bflo(x.k.y); kf[3] = bfhi(x.k.y); kf[4] = bflo(x.k.z); kf[5] = bfhi(x.k.z); kf[6] = bflo(x.k.w); kf[7] = bfhi(x.k.w);
    float ss = 0.f;
#pragma unroll
    for (int i = 0; i < 8; ++i) ss += kf[i] * kf[i];
    ss += dpp_xor1(ss); ss += dpp_xor2(ss); ss += dpp_hmirror(ss);
    const float rs = 1.0f / sqrtf(ss * (1.f / 64.f) + EPS);
    const f32x4 g0 = *(const f32x4*)(gk + part * 8), g1 = *(const f32x4*)(gk + part * 8 + 4);
#pragma unroll
    for (int i = 0; i < 8; ++i) kf[i] *= rs * (i < 4 ? g0[i] : g1[i - 4]);
    if (ROPE) {
        const int pos = (part >> 2) ? pcol : prow, i0 = (part & 1) * 8; const bool isx2 = (part >> 1) & 1;
#pragma unroll
        for (int i = 0; i < 8; ++i) { const float pk = dpp_xor2(kf[i]); const f32x2 cs = rtab[pos * 16 + i0 + i];
            kf[i] = isx2 ? (pk * cs.y + kf[i] * cs.x) : (kf[i] * cs.x - pk * cs.y); }
    }
    u32x4 o; o.x = pk2(kf[0], kf[1]); o.y = pk2(kf[2], kf[3]); o.z = pk2(kf[4], kf[5]); o.w = pk2(kf[6], kf[7]);
    *(LAS u32x4*)(Kb + key * KS + ((part ^ ((key >> 1) & 7)) << 4)) = o;
    LAS unsigned short* vt = (LAS unsigned short*)(VTb + (part * 8) * VS + (((key >> 2) ^ part) * 4 + (key & 3)) * 2);
    vt[0 * (VS / 2)] = (unsigned short)(x.v.x & 0xffffu); vt[1 * (VS / 2)] = (unsigned short)(x.v.x >> 16);
    vt[2 * (VS / 2)] = (unsigned short)(x.v.y & 0xffffu); vt[3 * (VS / 2)] = (unsigned short)(x.v.y >> 16);
    vt[4 * (VS / 2)] = (unsigned short)(x.v.z & 0xffffu); vt[5 * (VS / 2)] = (unsigned short)(x.v.z >> 16);
    vt[6 * (VS / 2)] = (unsigned short)(x.v.w & 0xffffu); vt[7 * (VS / 2)] = (unsigned short)(x.v.w >> 16);
}
template <bool ROPE> DI void q_load(bf16x8 (&qf)[4], const bf16_t* qrow, int h, const float* gq, float scale, const LAS f32x2* rtab, int prow, int pcol) {
    float x[4][8]; float ss = 0.f;
#pragma unroll
    for (int ks = 0; ks < 4; ++ks) { const u32x4 w = *(const u32x4*)(qrow + 16 * ks + 8 * h);
        x[ks][0] = bflo(w.x); x[ks][1] = bfhi(w.x); x[ks][2] = bflo(w.y); x[ks][3] = bfhi(w.y); x[ks][4] = bflo(w.z); x[ks][5] = bfhi(w.z); x[ks][6] = bflo(w.w); x[ks][7] = bfhi(w.w);
#pragma unroll
        for (int j = 0; j < 8; ++j) ss += x[ks][j] * x[ks][j]; }
    ss = xhalf_sum(ss);
    const float rs = 1.0f / sqrtf(ss * (1.f / 64.f) + EPS);
#pragma unroll
    for (int ks = 0; ks < 4; ++ks) { const f32x4 g0 = *(const f32x4*)(gq + 16 * ks + 8 * h), g1 = *(const f32x4*)(gq + 16 * ks + 8 * h + 4);
#pragma unroll
        for (int j = 0; j < 8; ++j) x[ks][j] *= rs * (j < 4 ? g0[j] : g1[j - 4]); }
    if (ROPE) {
#pragma unroll
        for (int a = 0; a < 2; ++a) { const int pos = a ? pcol : prow;
#pragma unroll
            for (int j = 0; j < 8; ++j) { const f32x2 cs = rtab[pos * 16 + 8 * h + j]; const float x1 = x[2 * a][j], x2 = x[2 * a + 1][j];
                x[2 * a][j] = x1 * cs.x - x2 * cs.y; x[2 * a + 1][j] = x1 * cs.y + x2 * cs.x; } }
    }
#pragma unroll
    for (int ks = 0; ks < 4; ++ks) { u32x4 o; o.x = pk2(x[ks][0] * scale, x[ks][1] * scale); o.y = pk2(x[ks][2] * scale, x[ks][3] * scale); o.z = pk2(x[ks][4] * scale, x[ks][5] * scale); o.w = pk2(x[ks][6] * scale, x[ks][7] * scale);
        qf[ks] = __builtin_bit_cast(bf16x8, o); }
}
template <class MaskF> DI void attn_tile(const LAS unsigned char* Kimg, const LAS unsigned char* VTt, const int vtile, const bf16x8 (&qf)[4], f32x16 (&o)[2], float& m, float& l, int r32, int h, const MaskF& mask) {
    __builtin_amdgcn_sched_barrier(0);
    f32x16 s;
#pragma unroll
    for (int i = 0; i < 16; ++i) s[i] = 0.f;
#pragma unroll
    for (int ks = 0; ks < 4; ++ks) { const int kk = 32 * vtile + r32; const bf16x8 kf = *(const LAS bf16x8*)(Kimg + kk * KS + (((2 * ks + h) ^ ((kk >> 1) & 7)) << 4)); s = MFMA32(kf, qf[ks], s); }
    float mt = -1.0e30f;
    mask(s);
#pragma unroll
    for (int r = 0; r < 16; ++r) mt = fmaxf(mt, s[r]);
    mt = xhalf_max(mt);
    const float mn = fmaxf(m, mt), alpha = __builtin_amdgcn_exp2f(m - mn);
    m = mn;
    float ps = 0.f;
#pragma unroll
    for (int r = 0; r < 16; ++r) { s[r] = __builtin_amdgcn_exp2f(s[r] - mn); ps += s[r]; }
    l = l * alpha + ps;
#pragma unroll
    for (int i = 0; i < 16; ++i) { o[0][i] *= alpha; o[1][i] *= alpha; }
    bf16x8 pa[2];
#pragma unroll
    for (int st = 0; st < 2; ++st) { u32x4 w; w.x = pk2(s[8 * st], s[8 * st + 1]); w.y = pk2(s[8 * st + 2], s[8 * st + 3]); w.z = pk2(s[8 * st + 4], s[8 * st + 5]); w.w = pk2(s[8 * st + 6], s[8 * st + 7]); pa[st] = __builtin_bit_cast(bf16x8, w); }
#pragma unroll
    for (int dvb = 0; dvb < 2; ++dvb)
#pragma unroll
        for (int st = 0; st < 2; ++st) {
            const int dv = 32 * dvb + r32, c0 = 8 * vtile + 4 * st + h;
            const LAS unsigned char* vrow = VTt + dv * VS;
            const u32x2 lo = *(const LAS u32x2*)(vrow + ((c0 ^ (dv >> 3)) << 3)), hi = *(const LAS u32x2*)(vrow + (((c0 + 2) ^ (dv >> 3)) << 3));
            u32x4 w; w.x = lo.x; w.y = lo.y; w.z = hi.x; w.w = hi.y;
            o[dvb] = MFMA32(__builtin_bit_cast(bf16x8, w), pa[st], o[dvb]);
        }
    __builtin_amdgcn_sched_barrier(0);
}
DI void attn_store(const f32x16 (&o)[2], float l, float extra, bf16_t* orow, int h) {
    const float lt = xhalf_sum(l) + extra;
    const float inv = 1.0f / lt;
#pragma unroll
    for (int dvb = 0; dvb < 2; ++dvb)
#pragma unroll
        for (int g = 0; g < 4; ++g) { u32x2 w; w.x = pk2(o[dvb][4 * g] * inv, o[dvb][4 * g + 1] * inv); w.y = pk2(o[dvb][4 * g + 2] * inv, o[dvb][4 * g + 3] * inv);
            *(u32x2*)(orow + 32 * dvb + 8 * g + 4 * h) = w; }
}

DI void phase_swa(const Frame& F, int l) {
    const int lane = lane_id(), tid = F.wave * 64 + lane, r32 = lane & 31, h = lane >> 5, key = tid >> 3, part = tid & 7;
    const bf16_t* PRJ = (const bf16_t*)(F.ws + WS_PRJ); bf16_t* OM = (bf16_t*)(F.ws + WS_OMIX);
    const int idx = l >> 1; const float* gq = inp(F, 18) + idx * 64; const float* gk = inp(F, 19) + idx * 64; const float* sinks = inp(F, 20) + idx * 16;
    LAS unsigned char* CTXI = F.lds;
    LAS unsigned char* RING = F.lds + 4 * KV_PAIR;
    LAS f32x2* rtab = (LAS f32x2*)(F.lds + 9 * KV_PAIR);
    for (int i = tid; i < 1024; i += 512) { const float ang = (float)(i >> 4) * exp2f(-(float)(i & 15) * (13.287712379549449f / 16.0f)); rtab[i] = (f32x2){cosf(ang), sinf(ang)}; }
    __syncthreads();
    const bool with_ctx = l < DEPTH - 1;
    const int nunits = 2048 + (with_ctx ? 128 : 0);
    const float qscale = 0.125f * LOG2E;
    const int u_lo = (int)(((long)F.blk * nunits) / F.G), u_hi = (int)(((long)(F.blk + 1) * nunits) / F.G);
    int cur_grp = -1, have_lo = 0, have_hi = -1;
    for (int u = u_lo; u < u_hi; ++u) {
        const bool is_ctx = u >= 2048;
        int b, kvh, qb, hh2; if (!is_ctx) { b = u >> 8; kvh = (u >> 7) & 1; qb = (u >> 1) & 63; hh2 = u & 1; } else { const int v = u - 2048; b = v >> 4; kvh = (v >> 3) & 1; qb = (v >> 1) & 3; hh2 = v & 1; }
        const int hq = kvh * 8 + hh2 * 4 + (F.wave >> 1), qs = F.wave & 1, q0 = qb * 64, a = q0 + 32 * qs, tq = a + r32;
        const int kcol = O_K + kvh * 64, vcol = O_V + kvh * 64;
        const int tokq = is_ctx ? TLAT + b * CTXL + tq : b * SEQ + tq;
        if (b * 2 + kvh != cur_grp) {
            cur_grp = b * 2 + kvh; have_lo = 0; have_hi = -1;
            KVRegs cx[4];
#pragma unroll
            for (int s = 0; s < 4; ++s) cx[s] = kv_load(PRJ, ODD_IN, TLAT + b * CTXL + 64 * s + key, kcol, vcol, part);
#pragma unroll
            for (int s = 0; s < 4; ++s) kv_write<false>(cx[s], CTXI + s * KV_PAIR, CTXI + s * KV_PAIR + K_IMG, key, part, gk, rtab, 0, 0);
        }
        const int need_lo = qb - 2 < 0 ? 0 : qb - 2, need_hi = qb + 2 > 63 ? 63 : qb + 2;
        if (!is_ctx) {
            const int first = have_hi + 1 > need_lo ? have_hi + 1 : need_lo;
#pragma unroll 1
            for (int kb = first; kb <= need_hi; ++kb) {
                const KVRegs x = kv_load(PRJ, ODD_IN, b * SEQ + 64 * kb + key, kcol, vcol, part);
                LAS unsigned char* Kn = RING + (kb % 5) * KV_PAIR; kv_write<true>(x, Kn, Kn + K_IMG, key, part, gk, rtab, kb, key);
            }
            have_lo = need_lo; have_hi = need_hi;
        }
        KVRegs pf; int pf_kb = -1;
        { const int nu = u + 1;
          if (!is_ctx && nu < u_hi && nu < 2048 && (nu >> 7) == (u >> 7)) { const int nqb = (nu >> 1) & 63; const int want = nqb + 2 > 63 ? 63 : nqb + 2;
              if (want > have_hi) { pf_kb = want; pf = kv_load(PRJ, ODD_IN, b * SEQ + 64 * want + key, kcol, vcol, part); } } }
        bf16x8 qf[4]; f32x16 o[2]; float m = -1.0e30f, lsum = 0.f;
        if (is_ctx) q_load<false>(qf, PRJ + pidx(tokq, O_Q + hq * 64), h, gq, qscale, rtab, 0, 0);
        else q_load<true>(qf, PRJ + pidx(tokq, O_Q + hq * 64), h, gq, qscale, rtab, tq >> 6, tq & 63);
#pragma unroll
        for (int i = 0; i < 16; ++i) { o[0][i] = 0.f; o[1][i] = 0.f; }
        __syncthreads();
#pragma unroll 1
        for (int s = 0; s < 4; ++s) {
            const LAS unsigned char* Kc = CTXI + s * KV_PAIR; const LAS unsigned char* Vc = Kc + K_IMG;
#pragma unroll
            for (int tt = 0; tt < 2; ++tt) attn_tile(Kc, Vc, tt, qf, o, m, lsum, r32, h, [](f32x16&) {});
        }
        if (!is_ctx) {
#pragma unroll 1
            for (int kb = need_lo; kb <= need_hi; ++kb) {
                const LAS unsigned char* Kc = RING + (kb % 5) * KV_PAIR; const LAS unsigned char* Vc = Kc + K_IMG;
#pragma unroll
                for (int tt = 0; tt < 2; ++tt) {
                    const int kt0 = 64 * kb + 32 * tt;
                    if (kt0 + 31 >= a - 128 && kt0 <= a + 31 + 128)
                        attn_tile(Kc, Vc, tt, qf, o, m, lsum, r32, h,
                                  [&](f32x16& sc) {
#pragma unroll
                                      for (int r = 0; r < 16; ++r) { const int kp = kt0 + crow(r, h); sc[r] = ((unsigned)(tq - kp + 128) <= 256u) ? sc[r] : -1.0e30f; } });
                }
            }
        }
        attn_store(o, lsum, __builtin_amdgcn_exp2f(sinks[hq] * LOG2E - m), OM + (size_t)tokq * D + hq * 64, h);
        __syncthreads();
        if (pf_kb >= 0) { LAS unsigned char* Kn = RING + (pf_kb % 5) * KV_PAIR; kv_write<true>(pf, Kn, Kn + K_IMG, key, part, gk, rtab, pf_kb, key); have_hi = pf_kb; }
    }
}

DI void na_units(const Frame& F, int l) {
    const int lane = lane_id(), tid = F.wave * 64 + lane, r32 = lane & 31, h = lane >> 5, key = tid >> 3, part = tid & 7;
    const bf16_t* PRJ = (const bf16_t*)(F.ws + WS_PRJ); bf16_t* OM = (bf16_t*)(F.ws + WS_OMIX);
    const int idx = l >> 1; const float* gq = inp(F, 13) + idx * 64; const float* gk = inp(F, 14) + idx * 64;
    LAS unsigned char* CTXI = F.lds;
    LAS unsigned char* RING = F.lds + 4 * KV_PAIR;
    LAS float* rpbL = (LAS float*)(F.lds + 6 * KV_PAIR);
    const bool with_ctx = l < DEPTH - 1;
    const int nunits = 1024 + (with_ctx ? 64 : 0);
    const float qscale = 0.125f * LOG2E;
    const float* rpb_all = inp(F, 15) + (size_t)idx * 8 * 465;
    const int u_lo = (int)(((long)F.blk * nunits) / F.G), u_hi = (int)(((long)(F.blk + 1) * nunits) / F.G);
    int cur_grp = -1;
    for (int u = u_lo; u < u_hi; ++u) {
        const bool is_ctx = u >= 1024;
        int b, hh, rg; if (!is_ctx) { b = u >> 7; hh = (u >> 4) & 7; rg = u & 15; } else { const int v = u - 1024; b = v >> 3; hh = v & 7; rg = 0; }
        const int R0 = 4 * rg, R = R0 + (F.wave >> 1), qh = F.wave & 1, c = 32 * qh + r32;
        const int kcol = C_NK + hh * 64, vcol = C_NV + hh * 64;
        const int tokq = is_ctx ? TLAT + b * CTXL + 32 * F.wave + r32 : b * SEQ + R * 64 + c;
        if (b * 8 + hh != cur_grp) {
            cur_grp = b * 8 + hh;
            KVRegs cx[4];
#pragma unroll
            for (int s = 0; s < 4; ++s) cx[s] = kv_load(PRJ, EVEN_LD, TLAT + b * CTXL + 64 * s + key, kcol, vcol, part);
            const float* rp = rpb_all + (size_t)hh * 465; for (int i = tid; i < 465; i += 512) rpbL[i] = rp[i] * LOG2E;
#pragma unroll
            for (int s = 0; s < 4; ++s) kv_write<false>(cx[s], CTXI + s * KV_PAIR, CTXI + s * KV_PAIR + K_IMG, key, part, gk, (const LAS f32x2*)nullptr, 0, 0);
        }
        bf16x8 qf[4]; f32x16 o[2]; float m = -1.0e30f, lsum = 0.f;
        q_load<false>(qf, PRJ + pidx(tokq, C_NQ + hh * 64), h, gq, qscale, (const LAS f32x2*)nullptr, 0, 0);
#pragma unroll
        for (int i = 0; i < 16; ++i) { o[0][i] = 0.f; o[1][i] = 0.f; }
        const int sR = R - 4 < 0 ? 0 : (R - 4 > 56 ? 56 : R - 4);
        const int klo = R0 - 4 < 0 ? 0 : (R0 - 4 > 56 ? 56 : R0 - 4), khi = (R0 - 1 < 0 ? 0 : (R0 - 1 > 56 ? 56 : R0 - 1)) + 7;
        const int nrow = is_ctx ? 0 : (khi - klo + 1);
        KVRegs nx;
        if (!is_ctx) nx = kv_load(PRJ, EVEN_LD, b * SEQ + klo * 64 + key, kcol, vcol, part);
        __syncthreads();
#pragma unroll 1
        for (int s = 0; s < 4; ++s) {
            const LAS unsigned char* Kc = CTXI + s * KV_PAIR; const LAS unsigned char* Vc = Kc + K_IMG;
#pragma unroll
            for (int tt = 0; tt < 2; ++tt) attn_tile(Kc, Vc, tt, qf, o, m, lsum, r32, h, [](f32x16&) {});
        }
        if (!is_ctx) {
            kv_write<false>(nx, RING, RING + K_IMG, key, part, gk, (const LAS f32x2*)nullptr, 0, 0);
            __syncthreads();
            const int w0 = c - 8 < 0 ? 0 : (c - 8 > 48 ? 48 : c - 8);
            for (int s = 0; s < nrow; ++s) {
                const bool more = s + 1 < nrow;
                if (more) nx = kv_load(PRJ, EVEN_LD, b * SEQ + (klo + s + 1) * 64 + key, kcol, vcol, part);
                const LAS unsigned char* Kc = RING + (s & 1) * KV_PAIR; const LAS unsigned char* Vc = Kc + K_IMG;
                const int kr = klo + s;
                if (kr >= sR && kr < sR + 8) {
                    const LAS float* brow = rpbL + (kr - R + 7) * 31 + 15 - c;
#pragma unroll
                    for (int tt = 0; tt < 2; ++tt)
                        attn_tile(Kc, Vc, tt, qf, o, m, lsum, r32, h,
                                  [&](f32x16& sc) { float bv[16];
#pragma unroll
                                      for (int r = 0; r < 16; ++r) { const int kc = 32 * tt + crow(r, h); const int bi = kc < w0 ? w0 : (kc > w0 + 15 ? w0 + 15 : kc); bv[r] = brow[bi]; }
#pragma unroll
                                      for (int r = 0; r < 16; ++r) { const int kc = 32 * tt + crow(r, h); const unsigned ok = (unsigned)(kc - w0) < 16u; sc[r] = ok ? sc[r] + bv[r] : -1.0e30f; } });
                }
                if (more) { LAS unsigned char* Kn = RING + ((s + 1) & 1) * KV_PAIR; kv_write<false>(nx, Kn, Kn + K_IMG, key, part, gk, (const LAS f32x2*)nullptr, 0, 0); }
                __syncthreads();
            }
        }
        attn_store(o, lsum, 0.f, OM + (size_t)tokq * D + 512 + hh * 64, h);
        __syncthreads();
    }
}

constexpr int GLA_CH = 68, GLA_ITEMS = NBATCH * 4 * 2 * GLA_CH;
DI int gla_tok0(int b, int dir, int p) { const int q = dir ? (p < 4 ? 3 - p : 67 - p) : (p < 4 ? p : p - 4); return p < 4 ? TLAT + b * CTXL + 64 * q : b * SEQ + 64 * q; }
DI float logsig16(float z) { return (fminf(z, 0.f) - __logf(1.0f + __expf(-fabsf(z)))) * (1.0f / 16.0f); }
constexpr int GT_STRIDE = 136;
DI void gla_local(const Frame& F, int l) {
    const int lane = lane_id(), r32 = lane & 31, h = lane >> 5;
    const bf16_t* PRJ = (const bf16_t*)(F.ws + WS_PRJ);
    const int idx = l >> 1;
    LAS unsigned char* KT = F.lds + F.wave * 17408;
    LAS unsigned char* VT = KT + 8704;
    bf16_t* Ug = (bf16_t*)(F.ws + WS_GU); float* Dg = (float*)(F.ws + WS_GD); bf16_t* QTg = (bf16_t*)(F.ws + WS_GQ); bf16_t* KTg = (bf16_t*)(F.ws + WS_GK);
    const float* wa2 = inp(F, 10) + (size_t)idx * 2 * 16 * 256; const float* ba2 = inp(F, 11) + idx * 2 * 256;
    for (int it = F.blk * 8 + F.wave; it < GLA_ITEMS; it += F.G * 8) {
        const int ch = it / GLA_CH, p = it % GLA_CH, dir = ch & 1, hd = (ch >> 1) & 3, b = ch >> 3;
        const int tok0 = gla_tok0(b, dir, p);
        { const bf16_t* ap = PRJ + pidx(tok0 + lane, dir ? C_AB : C_AF); const u32x4 a0 = *(const u32x4*)ap, a1 = *(const u32x4*)(ap + 8);
          *(LAS u32x4*)(VT + lane * 32) = a0; *(LAS u32x4*)(VT + lane * 32 + 16) = a1; }
        float w[16];
#pragma unroll
        for (int r = 0; r < 16; ++r) w[r] = wa2[((size_t)dir * 16 + r) * 256 + hd * 64 + lane];
        const float bb = ba2[dir * 256 + hd * 64 + lane];
        const bf16_t* kp = PRJ + pidx(tok0, C_K + hd * 64) + lane;
        const bf16_t* qp = PRJ + pidx(tok0, C_Q + hd * 64) + lane;
        LDS_WAIT();
        float g[64]; float tot = 0.f;
#pragma unroll
        for (int t = 0; t < 64; ++t) {
            const u32x4 a0 = *(const LAS u32x4*)(VT + t * 32), a1 = *(const LAS u32x4*)(VT + t * 32 + 16);
            float z = bb;
            z += bflo(a0.x) * w[0] + bfhi(a0.x) * w[1] + bflo(a0.y) * w[2] + bfhi(a0.y) * w[3] + bflo(a0.z) * w[4] + bfhi(a0.z) * w[5] + bflo(a0.w) * w[6] + bfhi(a0.w) * w[7];
            z += bflo(a1.x) * w[8] + bfhi(a1.x) * w[9] + bflo(a1.y) * w[10] + bfhi(a1.y) * w[11] + bflo(a1.z) * w[12] + bfhi(a1.z) * w[13] + bflo(a1.w) * w[14] + bfhi(a1.w) * w[15];
            g[t] = logsig16(z); tot += g[t];
        }
        Dg[(size_t)it * 64 + lane] = __expf(tot);
        float run = 0.f;
        bf16_t* qo = QTg + ((size_t)dir * TALL + tok0) * 256 + hd * 64 + lane; bf16_t* ko = KTg + ((size_t)dir * TALL + tok0) * 256 + hd * 64 + lane;
#pragma unroll
        for (int c8 = 0; c8 < 8; ++c8) {
            unsigned short kr[8], qr[8];
#pragma unroll
            for (int e = 0; e < 8; ++e) { kr[e] = kp[(size_t)(8 * c8 + e) * 64]; qr[e] = qp[(size_t)(8 * c8 + e) * 64]; }
            float kh[8];
#pragma unroll
            for (int e = 0; e < 8; ++e) {
                const int t = 8 * c8 + e;
                const float C = dir ? (tot - run) : (run + g[t]);
                run += g[t];
                const float kf = bf2f(kr[e]), qf_ = bf2f(qr[e]);
                kh[e] = kf * __expf(tot - C);
                ko[(size_t)t * 256] = (bf16_t)f2bf(kf * __expf(-C));
                qo[(size_t)t * 256] = (bf16_t)f2bf(qf_ * 0.125f * __expf(C));
            }
#pragma unroll
            for (int e = 0; e < 8; e += 2) *(LAS unsigned*)(KT + lane * GT_STRIDE + (8 * c8 + e) * 2) = pk2(kh[e], kh[e + 1]);
        }
        LDS_WAIT();
#pragma unroll 1
        for (int hv = 0; hv < 2; ++hv) {
            const bf16_t* vp = PRJ + pidx(tok0, C_V + hd * 128 + 64 * hv) + lane;
            unsigned short vv[64];
#pragma unroll
            for (int t = 0; t < 64; ++t) vv[t] = vp[(size_t)t * 64];
#pragma unroll
            for (int t = 0; t < 64; t += 2) *(LAS unsigned*)(VT + lane * GT_STRIDE + t * 2) = (unsigned)vv[t] | ((unsigned)vv[t + 1] << 16);
            LDS_WAIT();
            f32x16 acc[2][2];
#pragma unroll
            for (int mb = 0; mb < 2; ++mb)
#pragma unroll
                for (int nb = 0; nb < 2; ++nb)
#pragma unroll
                    for (int i = 0; i < 16; ++i) acc[mb][nb][i] = 0.f;
#pragma unroll
            for (int ks = 0; ks < 4; ++ks) {
                bf16x8 af[2], bfr[2];
#pragma unroll
                for (int mb = 0; mb < 2; ++mb) { const LAS unsigned char* ap = KT + (32 * mb + r32) * GT_STRIDE + (16 * ks + 8 * h) * 2; const u32x2 lo = *(const LAS u32x2*)ap, hi = *(const LAS u32x2*)(ap + 8);
                    u32x4 x; x.x = lo.x; x.y = lo.y; x.z = hi.x; x.w = hi.y; af[mb] = __builtin_bit_cast(bf16x8, x); }
#pragma unroll
                for (int nb = 0; nb < 2; ++nb) { const LAS unsigned char* bp = VT + (32 * nb + r32) * GT_STRIDE + (16 * ks + 8 * h) * 2; const u32x2 lo = *(const LAS u32x2*)bp, hi = *(const LAS u32x2*)(bp + 8);
                    u32x4 x; x.x = lo.x; x.y = lo.y; x.z = hi.x; x.w = hi.y; bfr[nb] = __builtin_bit_cast(bf16x8, x); }
#pragma unroll
                for (int mb = 0; mb < 2; ++mb)
#pragma unroll
                    for (int nb = 0; nb < 2; ++nb) acc[mb][nb] = MFMA32(af[mb], bfr[nb], acc[mb][nb]);
            }
            bf16_t* up = Ug + (size_t)it * 8192 + (size_t)(64 * hv + r32) * 64;
#pragma unroll
            for (int mb = 0; mb < 2; ++mb)
#pragma unroll
                for (int nb = 0; nb < 2; ++nb)
#pragma unroll
                    for (int g = 0; g < 4; ++g) { u32x2 w; w.x = pk2(acc[mb][nb][4 * g], acc[mb][nb][4 * g + 1]); w.y = pk2(acc[mb][nb][4 * g + 2], acc[mb][nb][4 * g + 3]);
                        *(u32x2*)(up + (size_t)(32 * nb) * 64 + 32 * mb + 8 * g + 4 * h) = w; }
            LDS_WAIT();
        }
    }
}
DI void phase_even_a(const Frame& F, int l) { gla_local(F, l); __syncthreads(); na_units(F, l); }

DI void phase_gla_scan(const Frame& F, int l) {
    const int lane = lane_id(), gt = (F.blk * 8 + F.wave) * 64 + lane, NGT = F.G * 512;
    const bf16_t* __restrict__ Ug = (const bf16_t*)(F.ws + WS_GU); const float* __restrict__ Dg = (const float*)(F.ws + WS_GD); bf16_t* __restrict__ ST = (bf16_t*)(F.ws + WS_GS);
    for (int w = gt; w < 64 * 2048; w += NGT) {
        const int ch = w >> 11, dv = (w >> 4) & 127, dkg = w & 15;
        float s[4] = {0.f, 0.f, 0.f, 0.f};
        const bf16_t* up = Ug + (size_t)ch * GLA_CH * 8192 + (size_t)dv * 64 + 4 * dkg; const float* dp = Dg + (size_t)ch * GLA_CH * 64 + 4 * dkg; bf16_t* sp = ST + (size_t)ch * GLA_CH * 8192 + (size_t)dv * 64 + 4 * dkg;
#pragma unroll 1
        for (int p0 = 0; p0 < GLA_CH; p0 += 17) {
            u32x2 uw[17]; f32x4 dk[17];
#pragma unroll
            for (int q = 0; q < 17; ++q) { uw[q] = *(const u32x2*)(up + (size_t)(p0 + q) * 8192); dk[q] = *(const f32x4*)(dp + (size_t)(p0 + q) * 64); }
#pragma unroll
            for (int q = 0; q < 17; ++q) {
                u32x2 o; o.x = pk2(s[0], s[1]); o.y = pk2(s[2], s[3]);
                *(u32x2*)(sp + (size_t)(p0 + q) * 8192) = o;
                s[0] = dk[q][0] * s[0] + bflo(uw[q].x); s[1] = dk[q][1] * s[1] + bfhi(uw[q].x); s[2] = dk[q][2] * s[2] + bflo(uw[q].y); s[3] = dk[q][3] * s[3] + bfhi(uw[q].y);
            }
        }
    }
}

DI void phase_gla_out(const Frame& F, int l) {
    const int lane = lane_id(), r32 = lane & 31, h = lane >> 5;
    const bf16_t* PRJ = (const bf16_t*)(F.ws + WS_PRJ); bf16_t* OM = (bf16_t*)(F.ws + WS_OMIX); const bf16_t* ST = (const bf16_t*)(F.ws + WS_GS);
    const bf16_t* QTg = (const bf16_t*)(F.ws + WS_GQ); const bf16_t* KTg = (const bf16_t*)(F.ws + WS_GK);
    const int idx = l >> 1; const bool with_ctx = l < DEPTH - 1;
    LAS unsigned char* VT = F.lds;
    LAS float* SS = (LAS float*)(F.lds + 128 * GT_STRIDE);
    const int iblk = F.wave & 1, dvq = F.wave >> 1;
    const float* gn = inp(F, 12) + idx * 128 + 32 * dvq;
    const int nitems = NBATCH * 4 * GLA_CH;
    for (int it = F.blk; it < nitems; it += F.G) {
        const int sc = it % GLA_CH, hd = (it / GLA_CH) & 3, b = it / (GLA_CH * 4);
        if (sc < 4 && !with_ctx) continue;
        const int tok0 = sc < 4 ? TLAT + b * CTXL + 64 * sc : b * SEQ + 64 * (sc - 4);
        const int ti = 32 * iblk + r32;
        unsigned short v0[8], v1[8];
        { const bf16_t* vp = PRJ + pidx(tok0 + 8 * F.wave, C_V + hd * 128) + lane; const bf16_t* vp1 = PRJ + pidx(tok0 + 8 * F.wave, C_V + hd * 128 + 64) + lane;
#pragma unroll
          for (int e = 0; e < 8; ++e) { v0[e] = vp[(size_t)e * 64]; v1[e] = vp1[(size_t)e * 64]; } }
        u32x4 qw[2][4], kd[2][4], ko[4], sw[2][4];
        const int odir = iblk ? 0 : 1, ojb = 1 - iblk;
        size_t item[2];
#pragma unroll
        for (int dir = 0; dir < 2; ++dir) {
            const int pp = dir ? (sc < 4 ? 3 - sc : 71 - sc) : sc;
            item[dir] = (size_t)(((b * 4 + hd) * 2 + dir) * GLA_CH + pp);
            const bf16_t* qp = QTg + ((size_t)dir * TALL + tok0 + ti) * 256 + hd * 64 + 8 * h;
            const bf16_t* kp = KTg + ((size_t)dir * TALL + tok0 + ti) * 256 + hd * 64 + 8 * h;
            const bf16_t* sp = ST + item[dir] * 8192 + (size_t)(32 * dvq + r32) * 64 + 8 * h;
#pragma unroll
            for (int ks = 0; ks < 4; ++ks) { qw[dir][ks] = *(const u32x4*)(qp + 16 * ks); kd[dir][ks] = *(const u32x4*)(kp + 16 * ks); sw[dir][ks] = *(const u32x4*)(sp + 16 * ks); }
        }
        { const bf16_t* kp = KTg + ((size_t)odir * TALL + tok0 + 32 * ojb + r32) * 256 + hd * 64 + 8 * h;
#pragma unroll
          for (int ks = 0; ks < 4; ++ks) ko[ks] = *(const u32x4*)(kp + 16 * ks); }
#pragma unroll
        for (int e = 0; e < 8; e += 2) { *(LAS unsigned*)(VT + lane * GT_STRIDE + (8 * F.wave + e) * 2) = (unsigned)v0[e] | ((unsigned)v0[e + 1] << 16);
            *(LAS unsigned*)(VT + (lane + 64) * GT_STRIDE + (8 * F.wave + e) * 2) = (unsigned)v1[e] | ((unsigned)v1[e + 1] << 16); }
        __syncthreads();
        f32x16 o;
#pragma unroll
        for (int i = 0; i < 16; ++i) o[i] = 0.f;
#pragma unroll
        for (int dir = 0; dir < 2; ++dir) {
#pragma unroll
            for (int blkk = 0; blkk < 2; ++blkk) {
                if (blkk == 1 && dir != odir) continue;
                const int jb = blkk ? ojb : iblk;
                f32x16 sacc;
#pragma unroll
                for (int i = 0; i < 16; ++i) sacc[i] = 0.f;
#pragma unroll
                for (int ks = 0; ks < 4; ++ks) sacc = MFMA32(__builtin_bit_cast(bf16x8, blkk ? ko[ks] : kd[dir][ks]), __builtin_bit_cast(bf16x8, qw[dir][ks]), sacc);
                if (blkk == 0) {
#pragma unroll
                    for (int r = 0; r < 16; ++r) { const int j = 32 * jb + crow(r, h); const bool keep = dir == 0 ? (j <= ti) : (j >= ti); sacc[r] = keep ? sacc[r] : 0.f; }
                }
#pragma unroll
                for (int st = 0; st < 2; ++st) {
                    u32x4 pw; pw.x = pk2(sacc[8 * st], sacc[8 * st + 1]); pw.y = pk2(sacc[8 * st + 2], sacc[8 * st + 3]); pw.z = pk2(sacc[8 * st + 4], sacc[8 * st + 5]); pw.w = pk2(sacc[8 * st + 6], sacc[8 * st + 7]);
                    const LAS unsigned char* vp = VT + (32 * dvq + r32) * GT_STRIDE + (32 * jb + 16 * st + 4 * h) * 2;
                    const u32x2 lo = *(const LAS u32x2*)vp, hi = *(const LAS u32x2*)(vp + 16);
                    u32x4 vw; vw.x = lo.x; vw.y = lo.y; vw.z = hi.x; vw.w = hi.y;
                    o = MFMA32(__builtin_bit_cast(bf16x8, vw), __builtin_bit_cast(bf16x8, pw), o);
                }
            }
#pragma unroll
            for (int ks = 0; ks < 4; ++ks) o = MFMA32(__builtin_bit_cast(bf16x8, sw[dir][ks]), __builtin_bit_cast(bf16x8, qw[dir][ks]), o);
        }
        float ss = 0.f;
#pragma unroll
        for (int i = 0; i < 16; ++i) ss += o[i] * o[i];
        ss = xhalf_sum(ss);
        if (h == 0) SS[dvq * 64 + ti] = ss;
        const bf16_t* gp = PRJ + pidx(tok0 + ti, C_G + hd * 128 + 32 * dvq);
        u32x2 gw[4]; f32x4 gv[4];
#pragma unroll
        for (int g = 0; g < 4; ++g) { gw[g] = *(const u32x2*)(gp + 8 * g + 4 * h); gv[g] = *(const f32x4*)(gn + 8 * g + 4 * h); }
        __syncthreads();
        const float tot = SS[ti] + SS[64 + ti] + SS[128 + ti] + SS[192 + ti];
        const float rs = 1.0f / sqrtf(tot * (1.f / 128.f) + EPS);
        bf16_t* op = OM + (size_t)(tok0 + ti) * D + hd * 128 + 32 * dvq;
#pragma unroll
        for (int g = 0; g < 4; ++g) {
            const float g0 = bflo(gw[g].x), g1 = bfhi(gw[g].x), g2 = bflo(gw[g].y), g3 = bfhi(gw[g].y);
            u32x2 ow; ow.x = pk2(o[4 * g] * rs * gv[g][0] * silu_f(g0), o[4 * g + 1] * rs * gv[g][1] * silu_f(g1)); ow.y = pk2(o[4 * g + 2] * rs * gv[g][2] * silu_f(g2), o[4 * g + 3] * rs * gv[g][3] * silu_f(g3));
            *(u32x2*)(op + 8 * g + 4 * h) = ow;
        }
        __syncthreads();
    }
}

constexpr int N_PHASES = 2 + 10 * DEPTH;
#ifndef NB_CONV
#define NB_CONV 48
#endif
#ifndef NB_CONV_ODD
#define NB_CONV_ODD 64
#endif
struct Args { const float* in[27]; float* out; unsigned char* ws; int ph_lo, ph_hi; };
#define PH_IN(k) (lo <= (k) && (k) < hi)
#define PH_BAR(k) do { if (PH_IN(k) && PH_IN((k) + 1)) xcd_barrier(bar); } while (0)
template <int l> DI void layer_program(Frame& F, const XcdBarrier& bar, const int lo, const int hi) {
    constexpr int pb = 2 + 10 * l;
    constexpr bool odd = (l & 1) != 0, with_ctx = l < DEPTH - 1;
    if (PH_IN(pb)) {
        DenseSched S; S.ord.init(TALL / 256, odd ? 5 : 13, F.G, F.blk); S.A = (const char*)(F.ws + WS_H);
        S.B = (const char*)(F.ws + (odd ? WS_WINO + (size_t)(l >> 1) * ODD_IN * 2048 : WS_WINE + (size_t)(l >> 1) * EVEN_LD * 2048));
        EpiPrj E{(bf16_t*)(F.ws + WS_PRJ), odd ? ODD_IN : EVEN_LD};
        pg8::gemm_phase<EpiPrj, DenseSched, false>(F.lds, S, E, F.wave, (LAS unsigned*)(F.lds + MISC_OFF + 1024));
    }
    PH_BAR(pb);
    if (PH_IN(pb + 1)) {
        constexpr int NBC = (l < DEPTH - 1) ? (odd ? NB_CONV_ODD : NB_CONV) : 0;
        if (NBC > 0 && F.blk >= F.G - NBC) convert_moe_layer(F, l + 1, F.blk - (F.G - NBC), NBC);
        else { Frame Fm = F; Fm.G = F.G - NBC; if (odd) phase_swa(Fm, l); else phase_even_a(Fm, l); }
    }
    PH_BAR(pb + 1);
    if (!odd) {
        if (PH_IN(pb + 2)) phase_gla_scan(F, l);
        PH_BAR(pb + 2);
        if (PH_IN(pb + 3)) phase_gla_out(F, l);
        PH_BAR(pb + 3);
    }
    if (PH_IN(pb + 4)) {
        DenseSched S; S.ord.init(TLAT / 256, 4, F.G, F.blk); S.A = (const char*)(F.ws + WS_OMIX); S.B = (const char*)(F.ws + WS_WOUT + (size_t)l * 1024 * 2048);
        float* X = (float*)(F.ws + WS_X);
        EpiRes E{l == 0 ? inp(F, 0) : X, l == 0 ? inp(F, 2) : X + (size_t)TLAT * D, X, modv(F, l, 0) + 2048};
        pg8::gemm_phase<EpiRes, DenseSched, false>(F.lds, S, E, F.wave, (LAS unsigned*)(F.lds + MISC_OFF + 1024));
    }
    PH_BAR(pb + 4);
    if (PH_IN(pb + 5)) {
        constexpr int NCX = with_ctx ? (TCTX / 256) * 4 : 0;
        if (with_ctx && F.G > 2 * NCX) {
            if (F.blk < NCX) {
                DenseSched S; S.ord.init(TCTX / 256, 4, NCX, F.blk); S.pm0 = TLAT / 256; S.A = (const char*)(F.ws + WS_OMIX); S.B = (const char*)(F.ws + WS_WOUT + (size_t)l * 1024 * 2048);
                float* X = (float*)(F.ws + WS_X);
                EpiRes E{l == 0 ? inp(F, 0) : X, l == 0 ? inp(F, 2) : X + (size_t)TLAT * D, X, modv(F, l, 0) + 2048};
                pg8::gemm_phase<EpiRes, DenseSched, false>(F.lds, S, E, F.wave, (LAS unsigned*)(F.lds + MISC_OFF + 1024));
            } else { Frame Fr = F; Fr.blk = F.blk - NCX; Fr.G = F.G - NCX; phase_router(Fr, l, 0, TLAT / 32); }
        } else {
            if (with_ctx) {
                DenseSched S; S.ord.init(TCTX / 256, 4, F.G, F.blk); S.pm0 = TLAT / 256; S.A = (const char*)(F.ws + WS_OMIX); S.B = (const char*)(F.ws + WS_WOUT + (size_t)l * 1024 * 2048);
                float* X = (float*)(F.ws + WS_X);
                EpiRes E{l == 0 ? inp(F, 0) : X, l == 0 ? inp(F, 2) : X + (size_t)TLAT * D, X, modv(F, l, 0) + 2048};
                pg8::gemm_phase<EpiRes, DenseSched, false>(F.lds, S, E, F.wave, (LAS unsigned*)(F.lds + MISC_OFF + 1024));
                xcd_barrier(bar);
            }
            phase_router(F, l, 0, TLAT / 32);
        }
    }
    PH_BAR(pb + 5);
    if (with_ctx) {
        if (PH_IN(pb + 6)) phase_router(F, l, TLAT / 32, TALL / 32);
        PH_BAR(pb + 6);
    }
    if (PH_IN(pb + 7)) {
        LAS int* ts = (LAS int*)(F.lds + MISC_OFF); LAS int* cn = ts + 64;
        moe_tables_build(F, l, ts, cn);
        MoeSched<true> S; S.T.tstart = ts; S.T.cnt = cn; S.ord.init(ts[NEXP], 8, F.G, F.blk); S.A = (const char*)(F.ws + WS_H); S.W = (const char*)(F.ws + WS_WGU + (size_t)l * 32 * 2048 * 2048); S.list = (const int*)(F.ws + WS_LIST); S.wlist = (const float*)(F.ws + WS_WTOK);
        EpiSwiglu E{(bf16_t*)(F.ws + WS_ACT), inp(F, 24) + (size_t)l * 32 * 2048};
        pg8::gemm_phase<EpiSwiglu, MoeSched<true>, true>(F.lds, S, E, F.wave, (LAS unsigned*)(F.lds + MISC_OFF + 1024));
    }
    PH_BAR(pb + 7);
    if (PH_IN(pb + 8)) {
        LAS int* ts = (LAS int*)(F.lds + MISC_OFF); LAS int* cn = ts + 64;
        moe_tables_build(F, l, ts, cn);
        MoeSched<false> S; S.T.tstart = ts; S.T.cnt = cn; S.ord.init(ts[NEXP], 4, F.G, F.blk); S.A = (const char*)(F.ws + WS_ACT); S.W = (const char*)(F.ws + WS_WDN + (size_t)l * 32 * 1024 * 2048); S.list = (const int*)(F.ws + WS_LIST); S.wlist = (const float*)(F.ws + WS_WTOK);
        EpiDown E{(bf16_t*)(F.ws + WS_Y), inp(F, 26) + (size_t)l * 32 * 1024};
        pg8::gemm_phase<EpiDown, MoeSched<false>, false>(F.lds, S, E, F.wave, (LAS unsigned*)(F.lds + MISC_OFF + 1024));
    }
    PH_BAR(pb + 8);
    if (PH_IN(pb + 9)) phase_combine(F, l);
    if (l < DEPTH - 1) PH_BAR(pb + 9);
}
__global__ void __launch_bounds__(512, 2) fwd_kernel(Args args) {
    extern __shared__ __attribute__((aligned(16))) unsigned char lds_raw[];
    Frame F; F.lds = (LAS unsigned char*)lds_raw; F.ws = args.ws; F.ctl = (unsigned*)(args.ws + WS_CTL); F.out = args.out;
    {
        const unsigned long long kp = (unsigned long long)__builtin_amdgcn_kernarg_segment_ptr(); unsigned klo = (unsigned)kp, khi = (unsigned)(kp >> 32);
        asm volatile("" : "+v"(klo), "+v"(khi)); klo = __builtin_amdgcn_readfirstlane(klo); khi = __builtin_amdgcn_readfirstlane(khi);
        F.in = (const float* const*)(((unsigned long long)khi << 32) | klo); }
    F.wave = __builtin_amdgcn_readfirstlane((int)(threadIdx.x >> 6)); F.G = gridDim.x; F.blk = blockIdx.x;
    const int lo = args.ph_lo, hi = args.ph_hi;
    if (threadIdx.x < 4) ((LAS unsigned*)(F.lds + XB_OFF))[threadIdx.x] = 0u;
    __syncthreads();
    XcdBarrier bar; bar.bar = F.ctl + CW_BAR; bar.x = 0; bar.st = (volatile LAS unsigned*)(F.lds + XB_OFF); bar.wave = F.wave;
    if (hi - lo > 1) bar = xcd_barrier_post(F.ctl + CW_BAR, (volatile LAS unsigned*)(F.lds + XB_OFF), F.wave);
    if (PH_IN(0)) phase_p0(F);
    PH_BAR(0);
    if (PH_IN(1)) phase_norm1_l0(F);
    PH_BAR(1);
    layer_program<0>(F, bar, lo, hi);
    layer_program<1>(F, bar, lo, hi);
    layer_program<2>(F, bar, lo, hi);
    layer_program<3>(F, bar, lo, hi);
}

#ifndef MK_PER_PHASE
#define MK_PER_PHASE 0
#endif
extern "C" void kernel_launch(void* const* d_in, const int* in_sizes, int n_in, void* d_out, int out_size, void* d_ws, size_t ws_size, hipStream_t stream) {
    static int grid = 0;
    if (grid == 0) {
        if (n_in != 27 || out_size != TLAT * D || ws_size < WS_END) { fprintf(stderr, "kernel_launch: unexpected problem shape (n_in %d, out %d, ws %zu < %zu)\n", n_in, out_size, ws_size, (size_t)WS_END); grid = -1; return; }
        int dev = 0, cus = 0, per_cu = 0;
        if (hipGetDevice(&dev) != hipSuccess || hipDeviceGetAttribute(&cus, hipDeviceAttributeMultiprocessorCount, dev) != hipSuccess) { grid = -1; return; }
        if (hipFuncSetAttribute((const void*)fwd_kernel, hipFuncAttributeMaxDynamicSharedMemorySize, LDS_BYTES) != hipSuccess) { fprintf(stderr, "kernel_launch: hipFuncSetAttribute failed\n"); grid = -1; return; }
        if (hipOccupancyMaxActiveBlocksPerMultiprocessor(&per_cu, (const void*)fwd_kernel, 512, LDS_BYTES) != hipSuccess || per_cu < 1) fprintf(stderr, "kernel_launch: occupancy query reports %d\n", per_cu);
        (void)hipGetLastError();
        grid = cus;
    }
    if (grid < 0) return;
    (void)hipMemsetAsync((char*)d_ws + WS_CTL, 0, CTL_ZERO_BYTES, stream);
    Args a{};
    for (int i = 0; i < 27; ++i) a.in[i] = (const float*)d_in[i];
    a.out = (float*)d_out; a.ws = (unsigned char*)d_ws;
#if MK_PER_PHASE
    for (int p = 0; p < N_PHASES; ++p) {
        const int l = (p - 2) / 10, q = (p - 2) % 10;
        if (p >= 2 && (((l & 1) && (q == 2 || q == 3)) || (l == DEPTH - 1 && q == 6))) continue;
        a.ph_lo = p; a.ph_hi = p + 1;
        hipLaunchKernelGGL(fwd_kernel, dim3(grid), dim3(512), LDS_BYTES, stream, a);
    }
#else
    a.ph_lo = 0; a.ph_hi = N_PHASES;
    hipLaunchKernelGGL(fwd_kernel, dim3(grid), dim3(512), LDS_BYTES, stream, a);
#endif
}
```

```cpp
#include <hip/hip_runtime.h>
#include <cstdio>
#include <cstdint>

#define LAS __attribute__((address_space(3)))
#define GAS __attribute__((address_space(1)))
#define DI __device__ __forceinline__
typedef unsigned short bf16_t;
typedef short bf16x8 __attribute__((ext_vector_type(8)));
typedef short s16x4 __attribute__((ext_vector_type(4)));
typedef float f32x2 __attribute__((ext_vector_type(2)));
typedef float f32x4 __attribute__((ext_vector_type(4)));
typedef float f32x16 __attribute__((ext_vector_type(16)));
typedef unsigned u32x2 __attribute__((ext_vector_type(2)));
typedef unsigned u32x4 __attribute__((ext_vector_type(4)));
typedef __bf16 bf16x2_t __attribute__((ext_vector_type(2)));

constexpr int D = 1024, NBATCH = 8, SEQ = 4096, CTXL = 256, DEPTH = 4;
constexpr int TLAT = NBATCH * SEQ, TCTX = NBATCH * CTXL, TALL = TLAT + TCTX;
constexpr int EVEN_IN = 3104, EVEN_LD = 3328, ODD_IN = 1280;
constexpr int NEXP = 32, TOPK = 4, DEXP = 1024;
constexpr int C_Q = 0, C_K = 256, C_V = 512, C_G = 1024, C_NQ = 1536, C_NK = 2048, C_NV = 2560, C_AF = 3072, C_AB = 3088;
DI size_t pidx(int tok, int col) { return ((size_t)(col >> 6) * TALL + tok) * 64 + (col & 63); }
constexpr int O_Q = 0, O_K = 1024, O_V = 1152;
constexpr float EPS = 1e-6f;
constexpr float LOG2E = 1.4426950408889634f;

constexpr size_t MiB = 1u << 20;
constexpr size_t WS_CTL = 0, CTL_ZERO_BYTES = 1 * MiB;
constexpr size_t WS_MODV = 1 * MiB;
constexpr size_t WS_WGU = 2 * MiB;
constexpr size_t WS_WDN = WS_WGU + 512 * MiB;
constexpr size_t WS_WINE = WS_WDN + 256 * MiB;
constexpr size_t WS_WINO = WS_WINE + 13 * MiB;
constexpr size_t WS_WOUT = WS_WINO + 5 * MiB;
constexpr size_t WS_X = WS_WOUT + 8 * MiB;
constexpr size_t WS_H = WS_X + 136 * MiB;
constexpr size_t WS_PRJ = WS_H + 68 * MiB;
constexpr size_t WS_OMIX = WS_PRJ + 221 * MiB;
constexpr size_t WS_ACT = WS_OMIX + 68 * MiB;
constexpr size_t WS_Y = WS_ACT + 288 * MiB;
constexpr size_t WS_LIST = WS_Y + 272 * MiB;
constexpr size_t WS_WTOK = WS_LIST + 5 * MiB;
constexpr size_t WS_GU = WS_WTOK + 5 * MiB;
constexpr size_t WS_GD = WS_GU + 136 * MiB;
constexpr size_t WS_GS = WS_GD + 2 * MiB;
constexpr size_t WS_GQ = WS_GS + 68 * MiB;
constexpr size_t WS_GK = WS_GQ + 34 * MiB;
constexpr size_t WS_RTB = WS_GK + 34 * MiB;
constexpr size_t WS_RTBIAS = WS_MODV + 917504;
constexpr size_t WS_END = WS_RTB + 5 * MiB;
static_assert(TALL * (size_t)D * 4 <= 136 * MiB && TALL * (size_t)EVEN_LD * 2 <= 221 * MiB && (size_t)TALL * 4 * D * 2 <= 272 * MiB, "ws map");
constexpr int CW_BAR = 4096;
constexpr int CW_CNT = 8192;

constexpr int RING_BYTES = 131072;
constexpr int MISC_OFF = RING_BYTES;
constexpr int MISC_BYTES = 12288;
constexpr int LDS_BYTES = 9 * 16896 + 8192 + 1264 + 16;
constexpr int XB_OFF = LDS_BYTES - 16;
static_assert(MISC_OFF + MISC_BYTES <= XB_OFF && 9 * 16896 + 8192 <= XB_OFF && XB_OFF + 16 <= LDS_BYTES && LDS_BYTES <= 163840 && XB_OFF % 16 == 0, "LDS map");

DI unsigned f2bf(float f) { unsigned u = __builtin_bit_cast(unsigned, f); return (u + 0x7fffu + ((u >> 16) & 1u)) >> 16; }
DI unsigned pk2(float lo, float hi) { f32x2 v = {lo, hi}; bf16x2_t b = __builtin_convertvector(v, bf16x2_t); return __builtin_bit_cast(unsigned, b); }
DI float bflo(unsigned u) { return __builtin_bit_cast(float, u << 16); }
DI float bfhi(unsigned u) { return __builtin_bit_cast(float, u & 0xffff0000u); }
DI float bf2f(bf16_t b) { return __builtin_bit_cast(float, ((unsigned)b) << 16); }
DI float wave_sum(float v) {
#pragma unroll
    for (int o = 1; o < 64; o <<= 1) v += __shfl_xor(v, o);
    return v;
}
DI float xhalf_max(float x) { const auto rr = __builtin_amdgcn_permlane32_swap(__builtin_bit_cast(unsigned, x), __builtin_bit_cast(unsigned, x), false, false); return fmaxf(__builtin_bit_cast(float, rr[0]), __builtin_bit_cast(float, rr[1])); }
DI float xhalf_sum(float x) { const auto rr = __builtin_amdgcn_permlane32_swap(__builtin_bit_cast(unsigned, x), __builtin_bit_cast(unsigned, x), false, false); return __builtin_bit_cast(float, rr[0]) + __builtin_bit_cast(float, rr[1]); }
DI float dpp_xor1(float x) { return __builtin_bit_cast(float, __builtin_amdgcn_update_dpp(0, __builtin_bit_cast(int, x), 0xB1, 0xF, 0xF, true)); }
DI float dpp_xor2(float x) { return __builtin_bit_cast(float, __builtin_amdgcn_update_dpp(0, __builtin_bit_cast(int, x), 0x4E, 0xF, 0xF, true)); }
DI float dpp_hmirror(float x) { return __builtin_bit_cast(float, __builtin_amdgcn_update_dpp(0, __builtin_bit_cast(int, x), 0x141, 0xF, 0xF, true)); }
#define LDS_WAIT() asm volatile("s_waitcnt lgkmcnt(0)" ::: "memory")
#define VM_WAIT() asm volatile("s_waitcnt vmcnt(0)" ::: "memory")

#define XB_TMO      128
#define XB_XCNT(j)  (256  + 64 * (j))
#define XB_XSUB(j)  (1280 + 64 * (j))
#define XB_XGEN(j)  (2304 + 64 * (j))
#define XB_TOP      3328
#define XB_TOPGEN   3392
#define XCD_BAR_WORDS 3456
#define XB_SPIN_CAP (1u << 22)
DI unsigned xb_ld(unsigned* p)              { return __hip_atomic_load(p, __ATOMIC_RELAXED, __HIP_MEMORY_SCOPE_AGENT); }
DI unsigned xb_add(unsigned* p, unsigned v) { return __hip_atomic_fetch_add(p, v, __ATOMIC_RELAXED, __HIP_MEMORY_SCOPE_AGENT); }
DI unsigned xb_xcc_id() { return (unsigned)__builtin_amdgcn_s_getreg((3 << 11) | 20) & 0xFu; }
#define XB_SPIN(cond, bar) do { unsigned _sp = 0; while (cond) { __builtin_amdgcn_s_sleep(1); \
    if ((++_sp & 255u) == 0u) { if (xb_ld(&(bar)[XB_TMO])) break; if (_sp > XB_SPIN_CAP) { atomicAdd(&(bar)[XB_TMO], 1u); break; } } } } while (0)
struct XcdBarrier { unsigned* bar; unsigned x; volatile LAS unsigned* st; int wave; };
DI bool xb_first(int wave) { return wave == 0 && __builtin_amdgcn_mbcnt_hi(~0u, __builtin_amdgcn_mbcnt_lo(~0u, 0u)) == 0u; }
DI XcdBarrier xcd_barrier_post(unsigned* bar, volatile LAS unsigned* st, int wave) {
    XcdBarrier b; b.bar = bar; b.x = xb_xcc_id(); b.st = st; b.wave = wave;
    if (xb_first(wave)) (void)xb_add(&bar[XB_XCNT(b.x)], 1u);
    return b;
}
DI void xcd_barrier_complete(unsigned* bar, unsigned x, unsigned& nloc, unsigned& nx) {
    const unsigned G = gridDim.x * gridDim.y * gridDim.z;
    unsigned sum, cnt, mine, sp = 0u;
    for (;;) {
        sum = 0u; cnt = 0u; mine = 0u;
#pragma unroll
        for (unsigned j = 0; j < 16; ++j) { const unsigned c = xb_ld(&bar[XB_XCNT(j)]); sum += c; cnt += (c > 0u) ? 1u : 0u; mine = (j == x) ? c : mine; }
        if (sum == G) break;
        __builtin_amdgcn_s_sleep(1);
        if ((++sp & 255u) == 0u) { if (xb_ld(&bar[XB_TMO])) break; if (sp > XB_SPIN_CAP) { atomicAdd(&bar[XB_TMO], 1u); break; } }
    }
    nloc = mine > 0u ? mine : 1u; nx = cnt > 0u ? cnt : 1u;
}
DI void xcd_barrier(const XcdBarrier& b) {
    asm volatile("s_waitcnt vmcnt(0)" ::: "memory");
    __syncthreads();
    if (xb_first(b.wave)) {
        unsigned* bar = b.bar;
        __builtin_amdgcn_s_waitcnt(0);
        unsigned nloc = b.st[0], nx = b.st[1];
        if (nloc == 0u) { xcd_barrier_complete(bar, b.x, nloc, nx); b.st[0] = nloc; b.st[1] = nx; }
        const unsigned old = xb_add(&bar[XB_XSUB(b.x)], 1u);
        const unsigned gen = old / nloc;
        if (old + 1u == (gen + 1u) * nloc) {
            __builtin_amdgcn_fence(__ATOMIC_RELEASE, "agent");
            asm volatile("s_waitcnt vmcnt(0)" ::: "memory");
            const unsigned og = xb_add(&bar[XB_TOP], 1u);
            const unsigned tg = og / nx;
            if (og + 1u == (tg + 1u) * nx) xb_add(&bar[XB_TOPGEN], 1u);
            else XB_SPIN(xb_ld(&bar[XB_TOPGEN]) == tg, bar);
            __builtin_amdgcn_fence(__ATOMIC_ACQUIRE, "agent");
            xb_add(&bar[XB_XGEN(b.x)], 1u);
            asm volatile("s_waitcnt vmcnt(0)" ::: "memory");
        } else {
            XB_SPIN(xb_ld(&bar[XB_XGEN(b.x)]) == gen, bar);
            __builtin_amdgcn_fence(__ATOMIC_ACQUIRE, "agent");
            asm volatile("s_waitcnt vmcnt(0)" ::: "memory");
        }
    }
    __syncthreads();
}

namespace pg8 {
constexpr int BM = 256, BK = 64, HALF = 128, HTB = HALF * BK * 2, STAGE_BYTES = 8 * HTB, NXCD = 8, WGM = 8, KDIM = 1024, NT = KDIM / BK;
DI int lds_byte(int r, int c) { const int st = (r >> 4) * 2 + (c >> 5), rr = r & 15, cc = c & 31, ob = rr * 64 + cc * 2; return st * 1024 + (ob ^ (((ob >> 9) & 1) << 5)); }
DI void stage_rc(int b, int& R, int& C) { const int st = b / 1024, sb = b % 1024, swz = sb ^ (((sb >> 9) & 1) << 5); R = (st >> 1) * 16 + swz / 64; C = (st & 1) * 32 + (swz % 64) / 2; }
DI int perm32(int rho) { const int n = rho >> 4, i = rho & 15; return 8 * (i >> 2) + 4 * n + (i & 3); }

struct Unit { const char* A; const char* B; int r0, c0, e, nvalid; const int* gl; const float* wl; };
struct TileOrder {
    int nM, nN, nwg, G, c;
    DI void init(int nM_, int nN_, int G_, int c_) { nM = nM_; nN = nN_; nwg = nM * nN; G = G_; c = c_; }
    DI bool tile(int i, int& pm, int& pn) const {
        const long L = (long)i * G + c; if (L >= nwg) return false;
        int wgid = (int)L; { const int q = nwg / NXCD, r = nwg % NXCD, xcd = wgid % NXCD, off = wgid / NXCD; wgid = (xcd < r ? xcd * (q + 1) : r * (q + 1) + (xcd - r) * q) + off; }
        const int nig = WGM * nN, gid = wgid / nig, fm = gid * WGM, gsz = (nM - fm) < WGM ? (nM - fm) : WGM;
        pm = fm + ((wgid % nig) % gsz); pn = (wgid % nig) / gsz; return true;
    }
};

template <class Epi, class Sched, bool GATHER>
DI void gemm_phase(LAS unsigned char* lds, const Sched& S, const Epi& E, const int wave_sgpr, LAS unsigned* side) {
    int tid = wave_sgpr * 64 + (int)__builtin_amdgcn_mbcnt_hi(~0u, __builtin_amdgcn_mbcnt_lo(~0u, 0u)); asm volatile("" : "+v"(tid));
    const int wid = __builtin_amdgcn_readfirstlane(tid >> 6), lane = tid & 63, wr = wid >> 2, wc = wid & 3, fr = lane & 15, fq = lane >> 4;
    constexpr int K = KDIM, nt = NT;
    unsigned voffA, voffB;
    { int R, C; stage_rc(tid * 16, R, C); const int Rb = Epi::PERM ? ((R & ~31) + perm32(R & 31)) : R;
      voffA = GATHER ? (unsigned)(C * 2) : (unsigned)(R * K + C) * 2u; voffB = (unsigned)(Rb * K + C) * 2u; }
    constexpr size_t pstep = (size_t)64 * K * 2;
    constexpr size_t kstep = (size_t)(BK * 2);
    constexpr size_t hstep = (size_t)HALF * K * 2;
    const unsigned ldsw = (unsigned)wid * 1024u;
    const int aoff = lds_byte(wr * 64 + fr, fq * 8), boff = lds_byte(wc * 32 + fr, fq * 8);
#define PG8_SA(b, h) (((b) * 2 + (h)) * HTB)
#define PG8_SB(b, h) ((4 + (b) * 2 + (h)) * HTB)
#define PG8_STAGE(bufoff, gbase, voff) do { _Pragma("unroll") for (int _i = 0; _i < 2; ++_i) \
        __builtin_amdgcn_global_load_lds((const unsigned*)((const char*)(gbase) + (size_t)_i * pstep + (voff)), (LAS unsigned*)(lds + (bufoff) + ldsw + _i * 8192), 16, 0, 0); } while (0)
#define PG8_STAGE_A(bufoff, gbase, ko, h, go) do { _Pragma("unroll") for (int _i = 0; _i < 2; ++_i) \
        __builtin_amdgcn_global_load_lds((const unsigned*)((const char*)(gbase) + (ko) + (GATHER ? (size_t)(go)[h][_i] : (size_t)(h) * hstep + (size_t)_i * pstep) + voffA), (LAS unsigned*)(lds + (bufoff) + ldsw + _i * 8192), 16, 0, 0); } while (0)
#define PG8_LDA(dst, b, h) do { _Pragma("unroll") for (int m = 0; m < 4; ++m) _Pragma("unroll") for (int k = 0; k < 2; ++k) dst[m][k] = *(const LAS bf16x8*)(lds + PG8_SA(b, h) + aoff + m * 2048 + k * 1024); } while (0)
#define PG8_LDB(dst, b, h) do { _Pragma("unroll") for (int n = 0; n < 2; ++n) _Pragma("unroll") for (int k = 0; k < 2; ++k) dst[n][k] = *(const LAS bf16x8*)(lds + PG8_SB(b, h) + boff + n * 2048 + k * 1024); } while (0)
#define PG8_MMA(ai, bj, At, Bt) do { __builtin_amdgcn_s_setprio(1); _Pragma("unroll") for (int m = 0; m < 4; ++m) _Pragma("unroll") for (int n = 0; n < 2; ++n) _Pragma("unroll") for (int k = 0; k < 2; ++k) \
        acc[ai][bj][m][n] = __builtin_amdgcn_mfma_f32_16x16x32_bf16(Bt[n][k], At[m][k], acc[ai][bj][m][n], 0, 0, 0); __builtin_amdgcn_s_setprio(0); } while (0)
#define PG8_WAIT_V(n) asm volatile("s_waitcnt vmcnt(" #n ")" ::: "memory")
#define PG8_WAIT_L(n) asm volatile("s_waitcnt lgkmcnt(" #n ")" ::: "memory")
#define PG8_BAR __builtin_amdgcn_s_barrier()
#define PG8_SCHED __builtin_amdgcn_sched_barrier(0)
    Unit cur, nxt; int ui = 0;
    if (!S.next(0, cur)) return;
    f32x4 acc[2][2][4][2];
#pragma unroll
    for (int a = 0; a < 2; ++a)
#pragma unroll
        for (int b = 0; b < 2; ++b)
#pragma unroll
            for (int m = 0; m < 4; ++m)
#pragma unroll
                for (int n = 0; n < 2; ++n) acc[a][b][m][n] = (f32x4){0.f, 0.f, 0.f, 0.f};
    bf16x8 At[4][2], B0[2][2], B1[2][2];
    unsigned gc[2][2] = {{0u, 0u}, {0u, 0u}}, gn[2][2] = {{0u, 0u}, {0u, 0u}};
    if (GATHER) {
#pragma unroll
        for (int i = 0; i < 2; ++i) { int R, C; stage_rc(tid * 16 + i * 8192, R, C);
#pragma unroll
            for (int h = 0; h < 2; ++h) gc[h][i] = S.goff(cur, h * HALF + R); }
#pragma unroll
        for (int i = 0; i < 2; ++i)
#pragma unroll
            for (int h = 0; h < 2; ++h) gc[h][i] = Sched::gbytes(gc[h][i]);
    }
    const char* cA = cur.A; const char* cB = cur.B;
    PG8_STAGE(PG8_SB(0, 0), cB, voffB); PG8_STAGE(PG8_SB(0, 1), cB + hstep, voffB); PG8_STAGE_A(PG8_SA(0, 0), cA, 0, 0, gc); PG8_STAGE_A(PG8_SA(0, 1), cA, 0, 1, gc);
    if (wr == 1) PG8_BAR;
    PG8_WAIT_V(2); PG8_BAR;
    PG8_STAGE(PG8_SB(1, 0), cB + kstep, voffB); PG8_STAGE_A(PG8_SA(1, 0), cA, kstep, 0, gc); PG8_STAGE(PG8_SB(1, 1), cB + hstep + kstep, voffB);
    PG8_WAIT_V(6); PG8_BAR;
    for (;;) {
        LAS unsigned* side_u = side + (ui & 1) * 768;
        if (Epi::NSIDE > 0 && wid < 4) E.side_issue(cur, tid, side_u);
        const bool has_next = S.next(ui + 1, nxt);
        const char* nA = has_next ? nxt.A : cA; const char* nB = has_next ? nxt.B : cB;
        for (int t = 0; t < nt; t += 2) {
            const bool last = (t == nt - 2);
            if (GATHER && t == nt - 6) {
                int t2 = tid; asm volatile("" : "+v"(t2));
#pragma unroll
                for (int i = 0; i < 2; ++i) { int R, C; stage_rc(t2 * 16 + i * 8192, R, C);
#pragma unroll
                    for (int h = 0; h < 2; ++h) gn[h][i] = S.goff(has_next ? nxt : cur, h * HALF + R); }
            }
            const size_t k1 = (size_t)(t + 1) * kstep;
            const char* a2 = last ? nA : cA; const size_t ka2 = last ? 0 : (size_t)(t + 2) * kstep;
            const char* b2 = last ? nB : cB + (size_t)(t + 2) * kstep;
            const char* b3 = b2 + kstep;
            PG8_LDB(B0, 0, 0); PG8_LDB(B1, 0, 1); PG8_SCHED; PG8_LDA(At, 0, 0); PG8_STAGE_A(PG8_SA(1, 1), cA, k1, 1, gc);
            if (GATHER && last) {
#pragma unroll
                for (int h = 0; h < 2; ++h)
#pragma unroll
                    for (int i = 0; i < 2; ++i) gc[h][i] = Sched::gbytes(gn[h][i]);
            }
            PG8_WAIT_V(8); PG8_WAIT_L(0); PG8_BAR; PG8_MMA(0, 0, At, B0); PG8_MMA(0, 1, At, B1); PG8_BAR; PG8_SCHED;
            PG8_LDA(At, 0, 1); PG8_STAGE(PG8_SB(0, 0), b2, voffB); PG8_STAGE(PG8_SB(0, 1), b2 + hstep, voffB); PG8_STAGE_A(PG8_SA(0, 0), a2, ka2, 0, gc);
            PG8_WAIT_V(8); PG8_WAIT_L(0); PG8_BAR; PG8_MMA(1, 0, At, B0); PG8_MMA(1, 1, At, B1); PG8_BAR; PG8_SCHED;
            PG8_LDB(B0, 1, 0); PG8_LDB(B1, 1, 1); PG8_SCHED; PG8_LDA(At, 1, 0); PG8_STAGE_A(PG8_SA(0, 1), a2, ka2, 1, gc);
            PG8_WAIT_V(8); PG8_WAIT_L(0); PG8_BAR; PG8_MMA(0, 0, At, B0); PG8_MMA(0, 1, At, B1); PG8_BAR; PG8_SCHED;
            PG8_LDA(At, 1, 1); PG8_STAGE(PG8_SB(1, 0), b3, voffB); PG8_STAGE(PG8_SB(1, 1), b3 + hstep, voffB); PG8_STAGE_A(PG8_SA(1, 0), a2, ka2 + kstep, 0, gc);
            PG8_WAIT_V(8); PG8_WAIT_L(0); PG8_BAR; PG8_MMA(1, 0, At, B0); PG8_MMA(1, 1, At, B1); PG8_BAR; PG8_SCHED;
        }
        if (wr == 0) PG8_BAR;
        E(acc, cur, wr, wc, fr, fq, side_u);
        if (!has_next) break;
#pragma unroll
        for (int a = 0; a < 2; ++a)
#pragma unroll
            for (int b = 0; b < 2; ++b)
#pragma unroll
                for (int m = 0; m < 4; ++m)
#pragma unroll
                    for (int n = 0; n < 2; ++n) acc[a][b][m][n] = (f32x4){0.f, 0.f, 0.f, 0.f};
        cur = nxt; cA = nA; cB = nB; ++ui;
        if (wr == 1) PG8_BAR;
    }
    PG8_WAIT_V(0);
    PG8_BAR;
#undef PG8_SA
#undef PG8_SB
#undef PG8_STAGE
#undef PG8_STAGE_A
#undef PG8_LDA
#undef PG8_LDB
#undef PG8_MMA
#undef PG8_WAIT_V
#undef PG8_WAIT_L
#undef PG8_BAR
#undef PG8_SCHED
}
}

struct Frame {
    LAS unsigned char* lds;
    unsigned* ctl;
    unsigned char* ws;
    const float* const* in;
    float* out;
    int wave, G, blk;
};
DI int lane_id() { return (int)__builtin_amdgcn_mbcnt_hi(~0u, __builtin_amdgcn_mbcnt_lo(~0u, 0u)); }
DI const float* inp(const Frame& F, int i) {
    const unsigned long long v = (unsigned long long)F.in[i];
    const unsigned lo = __builtin_amdgcn_readfirstlane((unsigned)v), hi = __builtin_amdgcn_readfirstlane((unsigned)(v >> 32));
    return (const float*)(((unsigned long long)hi << 32) | lo);
}
DI float* modv(const Frame& F, int l, int r) { return (float*)(F.ws + WS_MODV) + ((size_t)l * 9 + r) * 6144; }
DI int bidx_of(int row) { return row < TLAT ? (row >> 12) : 8; }

struct CvtRegs { f32x4 v[16]; };
DI void convert_load(CvtRegs& R, const float* src, int ld, int nvalid, int lane) {
    const int c4 = (lane & 15) * 4, kr = lane >> 4;
#pragma unroll
    for (int i = 0; i < 16; ++i) R.v[i] = (c4 < nvalid) ? __builtin_nontemporal_load((const f32x4*)(src + (size_t)(kr + 4 * i) * ld + c4)) : (f32x4){0.f, 0.f, 0.f, 0.f};
}
DI void convert_store(const CvtRegs& R, int nvalid, bf16_t* dst, LAS float* scr, int lane, bf16_t* dst_hi = nullptr) {
    const int c4 = (lane & 15) * 4, kr = lane >> 4;
#pragma unroll
    for (int i = 0; i < 16; ++i) { LAS float* p = scr + (kr + 4 * i) * 65 + c4; p[0] = R.v[i][0]; p[1] = R.v[i][1]; p[2] = R.v[i][2]; p[3] = R.v[i][3]; }
    LDS_WAIT(); asm volatile("" ::: "memory");
#pragma unroll
    for (int j = 0; j < 8; ++j) {
        const int q = lane + 64 * j, n = q >> 3, c8 = q & 7;
        const LAS float* s = scr + (8 * c8) * 65 + n;
        u32x4 o; o.x = pk2(s[0], s[65]); o.y = pk2(s[2 * 65], s[3 * 65]); o.z = pk2(s[4 * 65], s[5 * 65]); o.w = pk2(s[6 * 65], s[7 * 65]);
        if (n < nvalid) *(u32x4*)(((dst_hi && n >= 32) ? dst_hi : dst) + (size_t)n * 1024 + 8 * c8) = o;
    }
    LDS_WAIT(); asm volatile("" ::: "memory");
}
DI void convert_tile(const float* src, int ld, int nvalid, bf16_t* dst, LAS float* scr, int lane, bf16_t* dst_hi = nullptr) {
    CvtRegs R; convert_load(R, src, ld, nvalid, lane); convert_store(R, nvalid, dst, scr, lane, dst_hi);
}
DI float silu_f(float x) { return x / (1.f + __expf(-x)); }
DI void convert_moe_layer(const Frame& F, int l, int bidx, int nblk) {
    const int lane = lane_id();
    LAS float* scr = (LAS float*)(F.lds + F.wave * 16640);
    const int gw = bidx * 8 + F.wave, NGW = nblk * 8;
    constexpr int T_GU = 32 * 512, T_DN = 32 * 256;
    const float* gu = inp(F, 23) + (size_t)l * 32 * 1024 * 2048; const float* dn = inp(F, 25) + (size_t)l * 32 * 1024 * 1024;
    bf16_t* wgu = (bf16_t*)(F.ws + WS_WGU) + (size_t)l * 32 * 2048 * 1024; bf16_t* wdn = (bf16_t*)(F.ws + WS_WDN) + (size_t)l * 32 * 1024 * 1024;
    auto tsrc = [&](int t, int& ld) -> const float* { if (t < T_GU) { const int mat = t >> 9, kb = (t >> 5) & 15, nb = t & 31; ld = 2048; return gu + (size_t)mat * 1024 * 2048 + (size_t)(kb * 64) * 2048 + nb * 64; }
        const int r = t - T_GU, mat = r >> 8, kb = (r >> 4) & 15, nb = r & 15; ld = 1024; return dn + (size_t)mat * 1024 * 1024 + (size_t)(kb * 64) * 1024 + nb * 64; };
    auto tdst = [&](int t) -> bf16_t* { if (t < T_GU) { const int mat = t >> 9, kb = (t >> 5) & 15, nb = t & 31, n0 = nb * 64;
            const int drow = n0 < 1024 ? ((n0 >> 7) * 256 + (n0 & 127)) : ((((n0 - 1024) >> 7) * 256) + 128 + ((n0 - 1024) & 127));
            return wgu + (size_t)mat * 2048 * 1024 + (size_t)drow * 1024 + kb * 64; }
        const int r = t - T_GU, mat = r >> 8, kb = (r >> 4) & 15, nb = r & 15; return wdn + (size_t)mat * 1024 * 1024 + (size_t)(nb * 64) * 1024 + kb * 64; };
    constexpr int NT_ALL = T_GU + T_DN;
    CvtRegs RA, RB; int ld;
    if (gw < NT_ALL) { const float* sp = tsrc(gw, ld); convert_load(RA, sp, ld, 64, lane); }
    for (int t = gw; t < NT_ALL; t += 2 * NGW) {
        const int t1 = t + NGW, t2 = t + 2 * NGW;
        if (t1 < NT_ALL) { const float* sp = tsrc(t1, ld); convert_load(RB, sp, ld, 64, lane); }
        convert_store(RA, 64, tdst(t), scr, lane);
        if (t1 < NT_ALL) {
            if (t2 < NT_ALL) { const float* sp = tsrc(t2, ld); convert_load(RA, sp, ld, 64, lane); }
            convert_store(RB, 64, tdst(t1), scr, lane);
        }
    }
}
DI void convert_small(const Frame& F) {
    const int lane = lane_id();
    LAS float* scr = (LAS float*)(F.lds + F.wave * 16640);
    const int gw = F.blk * 8 + F.wave, NGW = F.G * 8;
    constexpr int T_WO = 4 * 256, T_WE = 2 * 16 * 49, T_WD = 2 * 16 * 20;
    for (int t = gw; t < T_WO + T_WE + T_WD; t += NGW) {
        int r = t;
        if (r < T_WO) { const int l = r >> 8, kb = (r >> 4) & 15, nb = r & 15; const float* src = ((l & 1) ? inp(F, 17) : inp(F, 9)) + (size_t)(l >> 1) * 1024 * 1024;
            convert_tile(src + (size_t)(kb * 64) * 1024 + nb * 64, 1024, 64, (bf16_t*)(F.ws + WS_WOUT) + (size_t)l * 1024 * 1024 + (size_t)(nb * 64) * 1024 + kb * 64, scr, lane); continue; }
        r -= T_WO;
        if (r < T_WE) { const int i = r / (16 * 49), q = r % (16 * 49), kb = q / 49, nb = q % 49; const int nv = (EVEN_IN - nb * 64) < 64 ? (EVEN_IN - nb * 64) : 64;
            const int n0 = nb * 64, d0 = n0 < 1536 ? n0 : (n0 == 1536 ? 3072 : n0 - 32), d1 = n0 == 1536 ? 1536 : d0 + 32;
            bf16_t* wb = (bf16_t*)(F.ws + WS_WINE) + (size_t)i * EVEN_LD * 1024 + kb * 64;
            convert_tile(inp(F, 8) + (size_t)i * 1024 * EVEN_IN + (size_t)(kb * 64) * EVEN_IN + n0, EVEN_IN, nv, wb + (size_t)d0 * 1024, scr, lane, wb + (size_t)(d1 - 32) * 1024); continue; }
        r -= T_WE;
        { const int i = r / (16 * 20), q = r % (16 * 20), kb = q / 20, nb = q % 20;
            convert_tile(inp(F, 16) + (size_t)i * 1024 * ODD_IN + (size_t)(kb * 64) * ODD_IN + nb * 64, ODD_IN, 64, (bf16_t*)(F.ws + WS_WINO) + (size_t)i * ODD_IN * 1024 + (size_t)(nb * 64) * 1024 + kb * 64, scr, lane); }
    }
}
DI void phase_p0(const Frame& F) {
    const int lane = lane_id(), tid = F.wave * 64 + lane; (void)tid; (void)lane;
    for (int item = F.blk; item < 96; item += F.G) {
        const int l = item / 24, cc = item % 24;
        LAS float* sil = (LAS float*)F.lds;
        LAS float* part = (LAS float*)(F.lds + 36864);
        for (int i = tid; i < 9 * 1024; i += 512) { const int r = i >> 10, k = i & 1023; const float c = r < 8 ? inp(F, 1)[r * 1024 + k] : inp(F, 3)[k]; sil[i] = silu_f(c); }
        __syncthreads();
        const float* W = inp(F, 4) + (size_t)l * 1024 * 6144 + cc * 256 + 4 * lane;
        f32x4 acc[9];
#pragma unroll
        for (int r = 0; r < 9; ++r) acc[r] = (f32x4){0.f, 0.f, 0.f, 0.f};
        for (int k = 128 * F.wave; k < 128 * F.wave + 128; ++k) {
            const f32x4 w = *(const f32x4*)(W + (size_t)k * 6144);
#pragma unroll
            for (int r = 0; r < 9; ++r) { const float s = sil[r * 1024 + k]; acc[r] += w * s; }
        }
#pragma unroll
        for (int r = 0; r < 9; ++r) *(LAS f32x4*)(part + (F.wave * 9 + r) * 256 + 4 * lane) = acc[r];
        __syncthreads();
        for (int i = tid; i < 9 * 256; i += 512) { const int r = i >> 8, c = i & 255; float s = 0.f;
#pragma unroll
            for (int w = 0; w < 8; ++w) s += part[(w * 9 + r) * 256 + c];
            modv(F, l, r)[cc * 256 + c] = s + inp(F, 5)[l * 6144 + cc * 256 + c]; }
        __syncthreads();
    }
    convert_small(F);
    convert_moe_layer(F, 0, F.blk, F.G);
}

DI void norm_mod_store(const f32x4 (&v)[4], float rs, const float* gam, const float* mv_sh, const float* mv_sc, bf16_t* orow, int lane) {
#pragma unroll
    for (int j = 0; j < 4; ++j) {
        const int c = 4 * lane + 256 * j;
        const f32x4 g = *(const f32x4*)(gam + c), sc = *(const f32x4*)(mv_sc + c), sh = *(const f32x4*)(mv_sh + c);
        const f32x4 h = v[j] * rs * g * (sc + 1.0f) + sh;
        u32x2 o; o.x = pk2(h[0], h[1]); o.y = pk2(h[2], h[3]);
        *(u32x2*)(orow + c) = o;
    }
}
DI void phase_norm1_l0(const Frame& F) {
    const int lane = lane_id(), tid = F.wave * 64 + lane; (void)tid; (void)lane;
    {
        float* rtb = (float*)(F.ws + WS_RTB); float* rtbias = (float*)(F.ws + WS_RTBIAS);
        const float* gam2 = inp(F, 7); const float* wr_all = inp(F, 21); const float* br_all = inp(F, 22);
        const int gt = F.blk * 512 + tid, NGT = F.G * 512;
        for (int i = gt; i < 4 * 9 * 1024 * 32; i += NGT) { const int e = i & 31, k = (i >> 5) & 1023, lb = i >> 15, l = lb / 9, b = lb % 9;
            rtb[i] = gam2[l * D + k] * (1.0f + modv(F, l, b)[4096 + k]) * wr_all[((size_t)l * D + k) * NEXP + e]; }
        LAS float* red = (LAS float*)F.lds;
        for (int item = F.blk; item < 36; item += F.G) {
            const int l = item / 9, b = item % 9, e = tid & 31, part = tid >> 5; const float* sh = modv(F, l, b) + 3072 + part * 64; const float* wr = wr_all + ((size_t)l * D + part * 64) * NEXP + e;
            float a0 = 0.f, a1 = 0.f, a2 = 0.f, a3 = 0.f;
#pragma unroll 4
            for (int k = 0; k < 64; k += 4) { a0 += sh[k] * wr[(size_t)k * NEXP]; a1 += sh[k + 1] * wr[(size_t)(k + 1) * NEXP]; a2 += sh[k + 2] * wr[(size_t)(k + 2) * NEXP]; a3 += sh[k + 3] * wr[(size_t)(k + 3) * NEXP]; }
            red[part * 32 + e] = (a0 + a1) + (a2 + a3);
            __syncthreads();
            if (tid < 32) { float sacc = 0.f;
#pragma unroll
                for (int q = 0; q < 16; ++q) sacc += red[q * 32 + tid];
                rtbias[(l * 9 + b) * NEXP + tid] = sacc + br_all[l * NEXP + tid]; }
            __syncthreads();
        }
    }
    const int gw = F.blk * 8 + F.wave, NGW = F.G * 8;
    bf16_t* H = (bf16_t*)(F.ws + WS_H);
    for (int row = gw; row < TALL; row += NGW) {
        const float* xr = row < TLAT ? inp(F, 0) + (size_t)row * D : inp(F, 2) + (size_t)(row - TLAT) * D;
        f32x4 v[4]; float s = 0.f;
#pragma unroll
        for (int j = 0; j < 4; ++j) { v[j] = *(const f32x4*)(xr + 4 * lane + 256 * j); s += (v[j][0] * v[j][0] + v[j][1] * v[j][1]) + (v[j][2] * v[j][2] + v[j][3] * v[j][3]); }
        const float rs = 1.0f / sqrtf(wave_sum(s) * (1.f / D) + EPS);
        const float* mv = modv(F, 0, bidx_of(row));
        norm_mod_store(v, rs, inp(F, 6), mv, mv + 1024, H + (size_t)row * D, lane);
    }
}
DI void phase_combine(const Frame& F, int l) {
    const int lane = lane_id(), tid = F.wave * 64 + lane; (void)tid; (void)lane;
    const int gw = F.blk * 8 + F.wave, NGW = F.G * 8;
    const int nrows = l < DEPTH - 1 ? TALL : TLAT;
    float* X = (float*)(F.ws + WS_X); bf16_t* H = (bf16_t*)(F.ws + WS_H); const bf16_t* Y = (const bf16_t*)(F.ws + WS_Y);
    for (int row = gw; row < nrows; row += NGW) {
        const int b = bidx_of(row);
        const float* g2 = modv(F, l, b) + 5120;
        f32x4 v[4]; float s = 0.f;
#pragma unroll
        for (int j = 0; j < 4; ++j) {
            const int c = 4 * lane + 256 * j;
            f32x4 y = (f32x4){0.f, 0.f, 0.f, 0.f};
#pragma unroll
            for (int k = 0; k < 4; ++k) { const u32x2 w = *(const u32x2*)(Y + ((size_t)row * 4 + k) * D + c); y += (f32x4){bflo(w.x), bfhi(w.x), bflo(w.y), bfhi(w.y)}; }
            v[j] = *(const f32x4*)(X + (size_t)row * D + c) + *(const f32x4*)(g2 + c) * y;
            s += (v[j][0] * v[j][0] + v[j][1] * v[j][1]) + (v[j][2] * v[j][2] + v[j][3] * v[j][3]);
        }
        if (l == DEPTH - 1) {
#pragma unroll
            for (int j = 0; j < 4; ++j) *(f32x4*)(F.out + (size_t)row * D + 4 * lane + 256 * j) = v[j];
        } else {
#pragma unroll
            for (int j = 0; j < 4; ++j) *(f32x4*)(X + (size_t)row * D + 4 * lane + 256 * j) = v[j];
            const float rs = 1.0f / sqrtf(wave_sum(s) * (1.f / D) + EPS);
            const float* mv = modv(F, l + 1, b);
            norm_mod_store(v, rs, inp(F, 6) + (l + 1) * D, mv, mv + 1024, H + (size_t)row * D, lane);
        }
    }
}

struct DenseSched {
    pg8::TileOrder ord; const char* A; const char* B; int pm0 = 0;
    DI bool next(int i, pg8::Unit& u) const { int pm, pn; if (!ord.tile(i, pm, pn)) return false; pm += pm0;
        u.A = A + (size_t)pm * 256 * 2048; u.B = B + (size_t)pn * 256 * 2048; u.r0 = pm * 256; u.c0 = pn * 256; u.e = 0; u.nvalid = 256; u.gl = nullptr; u.wl = nullptr; return true; }
    DI unsigned goff(const pg8::Unit&, int) const { return 0u; }
    static DI unsigned gbytes(unsigned e) { return e; }
};
struct MoeTables { const LAS int* tstart; const LAS int* cnt; };
DI void moe_tables_build(const Frame& F, int l, LAS int* tstart, LAS int* cnt) {
    const int lane = lane_id(), tid = F.wave * 64 + lane;
    if (tid < 64) {
        const int c = lane < NEXP ? (int)F.ctl[CW_CNT + 64 * l + lane] : 0; const int tiles = (c + 255) >> 8;
        int incl = tiles;
#pragma unroll
        for (int o = 1; o < 32; o <<= 1) { const int v = __shfl_up(incl, o); if (lane >= o) incl += v; }
        if (lane < NEXP) { cnt[lane] = c; tstart[lane] = incl - tiles; }
        if (lane == NEXP - 1) tstart[NEXP] = incl;
    }
    __syncthreads();
}
template <bool GATEUP> struct MoeSched {
    pg8::TileOrder ord; MoeTables T; const char* A; const char* W; const int* list; const float* wlist;
    DI bool next(int i, pg8::Unit& u) const { int mtg, pn; if (!ord.tile(i, mtg, pn)) return false;
        int e = 0;
#pragma unroll
        for (int s = 16; s >= 1; s >>= 1) { if (T.tstart[e + s] <= mtg) e += s; }
        const int mt = mtg - T.tstart[e];
        u.e = e; u.nvalid = T.cnt[e] - mt * 256; if (u.nvalid > 256) u.nvalid = 256; u.gl = list + (size_t)e * TALL + mt * 256; u.wl = wlist + (size_t)e * TALL + mt * 256; u.r0 = mtg * 256;
        if (GATEUP) { u.A = A; u.B = W + (size_t)e * (2048 * 2048) + (size_t)pn * 256 * 2048; u.c0 = pn * 128; }
        else { u.A = A + (size_t)mtg * 256 * 2048; u.B = W + (size_t)e * (1024 * 2048) + (size_t)pn * 256 * 2048; u.c0 = pn * 256; }
        return true; }
    DI unsigned goff(const pg8::Unit& u, int row) const { const int r = row < u.nvalid ? row : 0; return (unsigned)u.gl[r]; }
    static DI unsigned gbytes(unsigned entry) { return (entry >> 2) * 2048u; }
};

DI void dma4(const void* g, LAS unsigned* dst_wave_base) { __builtin_amdgcn_global_load_lds((const unsigned*)g, dst_wave_base, 4, 0, 0); }
struct EpiPrj {
    static constexpr bool PERM = true; static constexpr int NSIDE = 0;
    DI void side_issue(const pg8::Unit&, int, LAS unsigned*) const {}
    bf16_t* O; int ldc;
    DI void operator()(const f32x4 (&acc)[2][2][4][2], const pg8::Unit& u, int wr, int wc, int fr, int fq, const LAS unsigned*) const {
        const int row0 = u.r0 + wr * 64 + fr, col0 = u.c0 + wc * 32 + 8 * fq;
#pragma unroll
        for (int ai = 0; ai < 2; ++ai)
#pragma unroll
            for (int m = 0; m < 4; ++m) { const int row = row0 + ai * 128 + m * 16;
#pragma unroll
                for (int bj = 0; bj < 2; ++bj) { const f32x4 v0 = acc[ai][bj][m][0], v1 = acc[ai][bj][m][1];
                    u32x4 w; w.x = pk2(v0[0], v0[1]); w.y = pk2(v0[2], v0[3]); w.z = pk2(v1[0], v1[1]); w.w = pk2(v1[2], v1[3]);
                    *(u32x4*)(O + pidx(row, col0 + bj * 128)) = w; } }
    }
};
struct EpiRes {
    static constexpr bool PERM = false; static constexpr int NSIDE = 1;
    const float* xlat; const float* xctx; float* xout; const float* gate;
    DI void side_issue(const pg8::Unit& u, int t, LAS unsigned* side) const { dma4(gate + (size_t)bidx_of(u.r0) * 6144 + u.c0 + t, side + (t & ~63)); }
    DI void operator()(const f32x4 (&acc)[2][2][4][2], const pg8::Unit& u, int wr, int wc, int fr, int fq, const LAS unsigned* side) const {
        const int row0 = u.r0 + wr * 64 + fr, col0 = u.c0 + wc * 32 + 4 * fq;
        const float* xin = u.r0 < TLAT ? xlat : xctx - (size_t)TLAT * D;
        f32x4 gv[2][2];
#pragma unroll
        for (int bj = 0; bj < 2; ++bj)
#pragma unroll
            for (int n = 0; n < 2; ++n) gv[bj][n] = *(const LAS f32x4*)(side + wc * 32 + 4 * fq + bj * 128 + n * 16);
#pragma unroll
        for (int ai = 0; ai < 2; ++ai) {
            f32x4 xv[4][2][2];
#pragma unroll
            for (int m = 0; m < 4; ++m) { const size_t off = (size_t)(row0 + ai * 128 + m * 16) * D + col0;
#pragma unroll
                for (int bj = 0; bj < 2; ++bj)
#pragma unroll
                    for (int n = 0; n < 2; ++n) xv[m][bj][n] = *(const f32x4*)(xin + off + bj * 128 + n * 16); }
            asm volatile("" : "+v"(xv[0][0][0]), "+v"(xv[0][0][1]), "+v"(xv[0][1][0]), "+v"(xv[0][1][1]), "+v"(xv[1][0][0]), "+v"(xv[1][0][1]), "+v"(xv[1][1][0]), "+v"(xv[1][1][1]));
            asm volatile("" : "+v"(xv[2][0][0]), "+v"(xv[2][0][1]), "+v"(xv[2][1][0]), "+v"(xv[2][1][1]), "+v"(xv[3][0][0]), "+v"(xv[3][0][1]), "+v"(xv[3][1][0]), "+v"(xv[3][1][1]));
#pragma unroll
            for (int m = 0; m < 4; ++m) { const size_t off = (size_t)(row0 + ai * 128 + m * 16) * D + col0;
#pragma unroll
                for (int bj = 0; bj < 2; ++bj)
#pragma unroll
                    for (int n = 0; n < 2; ++n) *(f32x4*)(xout + off + bj * 128 + n * 16) = xv[m][bj][n] + gv[bj][n] * acc[ai][bj][m][n]; }
        }
    }
};
struct EpiSwiglu {
    static constexpr bool PERM = true; static constexpr int NSIDE = 1;
    bf16_t* ACT; const float* bgu;
    DI void side_issue(const pg8::Unit& u, int t, LAS unsigned* side) const { dma4(bgu + (size_t)u.e * 2048 + u.c0 + (t < 128 ? t : 1024 + t - 128), side + (t & ~63)); }
    DI void operator()(const f32x4 (&acc)[2][2][4][2], const pg8::Unit& u, int wr, int wc, int fr, int fq, const LAS unsigned* side) const {
        const int row0 = u.r0 + wr * 64 + fr, lc = wc * 32 + 8 * fq;
        f32x4 bgl[2], bli[2];
#pragma unroll
        for (int n = 0; n < 2; ++n) { bgl[n] = *(const LAS f32x4*)(side + lc + 4 * n); bli[n] = *(const LAS f32x4*)(side + 128 + lc + 4 * n); }
#pragma unroll
        for (int ai = 0; ai < 2; ++ai)
#pragma unroll
            for (int m = 0; m < 4; ++m) {
                float o[8];
#pragma unroll
                for (int n = 0; n < 2; ++n)
#pragma unroll
                    for (int j = 0; j < 4; ++j) {
                        float g = acc[ai][0][m][n][j] + bgl[n][j], li = acc[ai][1][m][n][j] + bli[n][j];
                        g = fminf(g, 7.0f); li = fminf(fmaxf(li, -7.0f), 7.0f);
                        const float sg = __builtin_amdgcn_rcpf(1.0f + __expf(-1.702f * g));
                        o[4 * n + j] = g * sg * (li + 1.0f);
                    }
                u32x4 w; w.x = pk2(o[0], o[1]); w.y = pk2(o[2], o[3]); w.z = pk2(o[4], o[5]); w.w = pk2(o[6], o[7]);
                *(u32x4*)(ACT + (size_t)(row0 + ai * 128 + m * 16) * 1024 + u.c0 + lc) = w;
            }
    }
};
struct EpiDown {
    static constexpr bool PERM = true; static constexpr int NSIDE = 3;
    bf16_t* Y; const float* bdn;
    DI void side_issue(const pg8::Unit& u, int t, LAS unsigned* side) const {
        const int r = t < u.nvalid ? t : 0;
        dma4(u.gl + r, side + (t & ~63)); dma4(u.wl + r, side + 256 + (t & ~63)); dma4(bdn + (size_t)u.e * 1024 + u.c0 + t, side + 512 + (t & ~63)); }
    DI void operator()(const f32x4 (&acc)[2][2][4][2], const pg8::Unit& u, int wr, int wc, int fr, int fq, const LAS unsigned* side) const {
        const int rl0 = wr * 64 + fr, lc = wc * 32 + 8 * fq, col0 = u.c0 + lc;
        f32x4 bv[2][2];
#pragma unroll
        for (int bj = 0; bj < 2; ++bj)
#pragma unroll
            for (int n = 0; n < 2; ++n) bv[bj][n] = *(const LAS f32x4*)(side + 512 + lc + bj * 128 + 4 * n);
#pragma unroll
        for (int ai = 0; ai < 2; ++ai)
#pragma unroll
            for (int m = 0; m < 4; ++m) {
                const int r = rl0 + ai * 128 + m * 16; const int ent = (int)side[r]; const float w = __builtin_bit_cast(float, side[256 + r]);
                if (r < u.nvalid) { bf16_t* rowp = Y + (size_t)ent * 1024 + col0;
#pragma unroll
                    for (int bj = 0; bj < 2; ++bj) { const f32x4 v0 = (acc[ai][bj][m][0] + bv[bj][0]) * w, v1 = (acc[ai][bj][m][1] + bv[bj][1]) * w;
                        u32x4 o; o.x = pk2(v0[0], v0[1]); o.y = pk2(v0[2], v0[3]); o.z = pk2(v1[0], v1[1]); o.w = pk2(v1[2], v1[3]);
                        *(u32x4*)(rowp + bj * 128) = o; } }
            }
    }
};

DI void phase_router(const Frame& F, int l, int grp_begin, int grp_end) {
    const int lane = lane_id(), tid = F.wave * 64 + lane;
    const int ngroups = grp_end - grp_begin;
    const float* __restrict__ X = (const float*)(F.ws + WS_X); bf16_t* __restrict__ Hh = (bf16_t*)(F.ws + WS_H);
    const float* gam = inp(F, 7) + l * D;
    LAS float* P = (LAS float*)F.lds;
    LAS float* SSq = (LAS float*)(F.lds + 32768);
    LAS int* cntL = (LAS int*)(F.lds + 36864 + 128);
    LAS int* baseL = (LAS int*)(F.lds + 36864 + 256);
    LAS int* entE = (LAS int*)(F.lds + 40960);
    LAS float* entW = (LAS float*)(F.lds + 40960 + 16384);
    LAS int* entT = (LAS int*)(F.lds + 40960 + 32768);
    if (tid < 32) cntL[tid] = 0;
    const int e_l = lane & 31, kk = lane >> 5;
    const int kbase = 128 * F.wave + 64 * kk;
    float Breg[64]; float bias_e = 0.f; int cur_b = -1;
#pragma unroll
    for (int s = 0; s < 64; ++s) Breg[s] = 0.f;
    __syncthreads();
    int nent = 0;
    const int g_lo = grp_begin + (int)(((long)F.blk * ngroups) / F.G), g_hi = grp_begin + (int)(((long)(F.blk + 1) * ngroups) / F.G);
    for (int g = g_lo; g < g_hi; ++g) {
        const int t0 = g * 32, b = bidx_of(t0);
        const float* mv = modv(F, l, b);
        const float* xr = X + (size_t)(t0 + e_l) * D + kbase;
        f32x4 xv[16];
#pragma unroll
        for (int q = 0; q < 16; ++q) xv[q] = *(const f32x4*)(xr + 4 * q);
        if (b != cur_b) {
            cur_b = b;
            const float* bp = (const float*)(F.ws + WS_RTB) + ((size_t)(l * 9 + b) * 1024 + kbase) * NEXP + e_l; const float* bp2 = bp + 32 * NEXP;
#pragma unroll
            for (int s = 0; s < 32; ++s) { Breg[s] = bp[s * NEXP]; Breg[32 + s] = bp2[s * NEXP]; }
            bias_e = ((const float*)(F.ws + WS_RTBIAS))[(l * 9 + b) * NEXP + e_l];
        }
        asm volatile("" : "+v"(xv[0]), "+v"(xv[1]), "+v"(xv[2]), "+v"(xv[3]), "+v"(xv[4]), "+v"(xv[5]), "+v"(xv[6]), "+v"(xv[7]));
        asm volatile("" : "+v"(xv[8]), "+v"(xv[9]), "+v"(xv[10]), "+v"(xv[11]), "+v"(xv[12]), "+v"(xv[13]), "+v"(xv[14]), "+v"(xv[15]));
        f32x16 acc;
#pragma unroll
        for (int i = 0; i < 16; ++i) acc[i] = 0.f;
        float ss = 0.f;
#pragma unroll
        for (int q = 0; q < 16; ++q) {
            ss += (xv[q][0] * xv[q][0] + xv[q][1] * xv[q][1]) + (xv[q][2] * xv[q][2] + xv[q][3] * xv[q][3]);
#pragma unroll
            for (int j = 0; j < 4; ++j) acc = __builtin_amdgcn_mfma_f32_32x32x2f32(xv[q][j], Breg[4 * q + j], acc, 0, 0, 0);
        }
        ss = xhalf_sum(ss);
        if (kk == 0) SSq[F.wave * 32 + e_l] = ss;
#pragma unroll
        for (int r = 0; r < 16; ++r) { const int i = (r & 3) + 8 * (r >> 2) + 4 * kk; P[(F.wave * 32 + i) * 32 + e_l] = acc[r]; }
        __syncthreads();
        {
            float tot = 0.f;
#pragma unroll
            for (int w = 0; w < 8; ++w) tot += SSq[w * 32 + e_l];
            const float rs = 1.0f / sqrtf(tot * (1.f / D) + EPS);
            bf16_t* hr = Hh + (size_t)(t0 + e_l) * D + kbase;
#pragma unroll
            for (int q = 0; q < 16; q += 2) {
                const f32x4 g0 = *(const f32x4*)(gam + kbase + 4 * q), c0 = *(const f32x4*)(mv + 4096 + kbase + 4 * q), h0 = *(const f32x4*)(mv + 3072 + kbase + 4 * q);
                const f32x4 g1 = *(const f32x4*)(gam + kbase + 4 * q + 4), c1 = *(const f32x4*)(mv + 4096 + kbase + 4 * q + 4), h1 = *(const f32x4*)(mv + 3072 + kbase + 4 * q + 4);
                const f32x4 f0 = xv[q] * rs * g0 * (c0 + 1.0f) + h0, f1 = xv[q + 1] * rs * g1 * (c1 + 1.0f) + h1;
                u32x4 o; o.x = pk2(f0[0], f0[1]); o.y = pk2(f0[2], f0[3]); o.z = pk2(f1[0], f1[1]); o.w = pk2(f1[2], f1[3]);
                *(u32x4*)(hr + 4 * q) = o;
            }
        }
#pragma unroll 1
        for (int pass = 0; pass < 2; ++pass) {
            const int ti = 4 * F.wave + 2 * pass + kk;
            float v = 0.f, tot = 0.f;
#pragma unroll
            for (int w = 0; w < 8; ++w) { v += P[(w * 32 + ti) * 32 + e_l]; tot += SSq[w * 32 + ti]; }
            v = (1.0f / sqrtf(tot * (1.f / D) + EPS)) * v + bias_e;
            float tv[4]; int te[4];
#pragma unroll
            for (int k = 0; k < 4; ++k) {
                float m = v;
#pragma unroll
                for (int o = 16; o >= 1; o >>= 1) m = fmaxf(m, __shfl_xor(m, o));
                const unsigned long long bal = __ballot(v == m);
                const unsigned half = (unsigned)(bal >> (32 * kk));
                const int idx = __builtin_ctz(half);
                tv[k] = m; te[k] = idx;
                if (e_l == idx) v = -3.0e38f;
            }
            const float e1 = __expf(tv[1] - tv[0]), e2 = __expf(tv[2] - tv[0]), e3 = __expf(tv[3] - tv[0]);
            const float inv = 1.0f / (1.0f + e1 + e2 + e3);
            const float wk[4] = {inv, e1 * inv, e2 * inv, e3 * inv};
            if (e_l < 4) {
                const int k = e_l; const int ex = k == 0 ? te[0] : k == 1 ? te[1] : k == 2 ? te[2] : te[3]; const float ww = k == 0 ? wk[0] : k == 1 ? wk[1] : k == 2 ? wk[2] : wk[3];
                const int rk = atomicAdd((int*)(cntL + ex), 1);
                const int n = nent + ti * 4 + k;
                entE[n] = (ex << 20) | rk; entW[n] = ww; entT[n] = (t0 + ti) * 4 + k;
            }
        }
        nent += 128;
        __syncthreads();
    }
    if (tid < 32) baseL[tid] = cntL[tid] > 0 ? (int)atomicAdd(F.ctl + CW_CNT + 64 * l + tid, (unsigned)cntL[tid]) : 0;
    __syncthreads();
    int* list = (int*)(F.ws + WS_LIST); float* wtok = (float*)(F.ws + WS_WTOK);
    for (int n = tid; n < nent; n += 512) { const int er = entE[n], ex = er >> 20, rk = er & 0xfffff, ent = entT[n];
        list[(size_t)ex * TALL + baseL[ex] + rk] = ent; wtok[(size_t)ex * TALL + baseL[ex] + rk] = entW[n]; }
    __syncthreads();
}

constexpr int KS = 128;
constexpr int VS = 136;
constexpr int K_IMG = 64 * KS, V_IMG = 64 * VS, KV_PAIR = K_IMG + V_IMG;
#define MFMA32(a, b, c) __builtin_amdgcn_mfma_f32_32x32x16_bf16((a), (b), (c), 0, 0, 0)
DI int crow(int r, int h) { return (r & 3) + 8 * (r >> 2) + 4 * h; }
struct KVRegs { u32x4 k, v; };
DI KVRegs kv_load(const bf16_t* prj, int ld, int tok, int kcol, int vcol, int part) {
    (void)ld; KVRegs x; x.k = *(const u32x4*)(prj + pidx(tok, kcol + part * 8)); x.v = *(const u32x4*)(prj + pidx(tok, vcol + part * 8)); return x;
}
template <bool ROPE> DI void kv_write(const KVRegs& x, LAS unsigned char* Kb, LAS unsigned char* VTb, int key, int part, const float* gk, const LAS f32x2* rtab, int prow, int pcol) {
    float kf[8];
    kf[0] = bflo(x.k.x); kf[1] = bfhi(x.k.x); kf[2] = bflo(x.k.y); kf[3] = bfhi(x.k.y); kf[4] = bflo(x.k.z); kf[5] = bfhi(x.k.z); kf[6] = bflo(x.k.w); kf[7] = bfhi(x.k.w);
    float ss = 0.f;
#pragma unroll
    for (int i = 0; i < 8; ++i) ss += kf[i] * kf[i];
    ss += dpp_xor1(ss); ss += dpp_xor2(ss); ss += dpp_hmirror(ss);
    const float rs = 1.0f / sqrtf(ss * (1.f / 64.f) + EPS);
    const f32x4 g0 = *(const f32x4*)(gk + part * 8), g1 = *(const f32x4*)(gk + part * 8 + 4);
#pragma unroll
    for (int i = 0; i < 8; ++i) kf[i] *= rs * (i < 4 ? g0[i] : g1[i - 4]);
    if (ROPE) {
        const int pos = (part >> 2) ? pcol : prow, i0 = (part & 1) * 8; const bool isx2 = (part >> 1) & 1;
#pragma unroll
        for (int i = 0; i < 8; ++i) { const float pk = dpp_xor2(kf[i]); const f32x2 cs = rtab[pos * 16 + i0 + i];
            kf[i] = isx2 ? (pk * cs.y + kf[i] * cs.x) : (kf[i] * cs.x - pk * cs.y); }
    }
    u32x4 o; o.x = pk2(kf[0], kf[1]); o.y = pk2(kf[2], kf[3]); o.z = pk2(kf[4], kf[5]); o.w = pk2(kf[6], kf[7]);
    *(LAS u32x4*)(Kb + key * KS + ((part ^ ((key >> 1) & 7)) << 4)) = o;
    LAS unsigned short* vt = (LAS unsigned short*)(VTb + (part * 8) * VS + (((key >> 2) ^ part) * 4 + (key & 3)) * 2);
    vt[0 * (VS / 2)] = (unsigned short)(x.v.x & 0xffffu); vt[1 * (VS / 2)] = (unsigned short)(x.v.x >> 16);
    vt[2 * (VS / 2)] = (unsigned short)(x.v.y & 0xffffu); vt[3 * (VS / 2)] = (unsigned short)(x.v.y >> 16);
    vt[4 * (VS / 2)] = (unsigned short)(x.v.z & 0xffffu); vt[5 * (VS / 2)] = (unsigned short)(x.v.z >> 16);
    vt[6 * (VS / 2)] = (unsigned short)(x.v.w & 0xffffu); vt[7 * (VS / 2)] = (unsigned short)(x.v.w >> 16);
}
template <bool ROPE> DI void q_load(bf16x8 (&qf)[4], const bf16_t* qrow, int h, const float* gq, float scale, const LAS f32x2* rtab, int prow, int pcol) {
    float x[4][8]; float ss = 0.f;
#pragma unroll
    for (int ks = 0; ks < 4; ++ks) { const u32x4 w = *(const u32x4*)(qrow + 16 * ks + 8 * h);
        x[ks][0] = bflo(w.x); x[ks][1] = bfhi(w.x); x[ks][2] = bflo(w.y); x[ks][3] = bfhi(w.y); x[ks][4] = bflo(w.z); x[ks][5] = bfhi(w.z); x[ks][6] = bflo(w.w); x[ks][7] = bfhi(w.w);
#pragma unroll
        for (int j = 0; j < 8; ++j) ss += x[ks][j] * x[ks][j]; }
    ss = xhalf_sum(ss);
    const float rs = 1.0f / sqrtf(ss * (1.f / 64.f) + EPS);
#pragma unroll
    for (int ks = 0; ks < 4; ++ks) { const f32x4 g0 = *(const f32x4*)(gq + 16 * ks + 8 * h), g1 = *(const f32x4*)(gq + 16 * ks + 8 * h + 4);
#pragma unroll
        for (int j = 0; j < 8; ++j) x[ks][j] *= rs * (j < 4 ? g0[j] : g1[j - 4]); }
    if (ROPE) {
#pragma unroll
        for (int a = 0; a < 2; ++a) { const int pos = a ? pcol : prow;
#pragma unroll
            for (int j = 0; j < 8; ++j) { const f32x2 cs = rtab[pos * 16 + 8 * h + j]; const float x1 = x[2 * a][j], x2 = x[2 * a + 1][j];
                x[2 * a][j] = x1 * cs.x - x2 * cs.y; x[2 * a + 1][j] = x1 * cs.y + x2 * cs.x; } }
    }
#pragma unroll
    for (int ks = 0; ks < 4; ++ks) { u32x4 o; o.x = pk2(x[ks][0] * scale, x[ks][1] * scale); o.y = pk2(x[ks][2] * scale, x[ks][3] * scale); o.z = pk2(x[ks][4] * scale, x[ks][5] * scale); o.w = pk2(x[ks][6] * scale, x[ks][7] * scale);
        qf[ks] = __builtin_bit_cast(bf16x8, o); }
}
template <class MaskF> DI void attn_tile(const LAS unsigned char* Kimg, const LAS unsigned char* VTt, const int vtile, const bf16x8 (&qf)[4], f32x16 (&o)[2], float& m, float& l, int r32, int h, const MaskF& mask) {
    __builtin_amdgcn_sched_barrier(0);
    f32x16 s;
#pragma unroll
    for (int i = 0; i < 16; ++i) s[i] = 0.f;
#pragma unroll
    for (int ks = 0; ks < 4; ++ks) { const int kk = 32 * vtile + r32; const bf16x8 kf = *(const LAS bf16x8*)(Kimg + kk * KS + (((2 * ks + h) ^ ((kk >> 1) & 7)) << 4)); s = MFMA32(kf, qf[ks], s); }
    float mt = -1.0e30f;
    mask(s);
#pragma unroll
    for (int r = 0; r < 16; ++r) mt = fmaxf(mt, s[r]);
    mt = xhalf_max(mt);
    const float mn = fmaxf(m, mt), alpha = __builtin_amdgcn_exp2f(m - mn);
    m = mn;
    float ps = 0.f;
#pragma unroll
    for (int r = 0; r < 16; ++r) { s[r] = __builtin_amdgcn_exp2f(s[r] - mn); ps += s[r]; }
    l = l * alpha + ps;
#pragma unroll
    for (int i = 0; i < 16; ++i) { o[0][i] *= alpha; o[1][i] *= alpha; }
    bf16x8 pa[2];
#pragma unroll
    for (int st = 0; st < 2; ++st) { u32x4 w; w.x = pk2(s[8 * st], s[8 * st + 1]); w.y = pk2(s[8 * st + 2], s[8 * st + 3]); w.z = pk2(s[8 * st + 4], s[8 * st + 5]); w.w = pk2(s[8 * st + 6], s[8 * st + 7]); pa[st] = __builtin_bit_cast(bf16x8, w); }
#pragma unroll
    for (int dvb = 0; dvb < 2; ++dvb)
#pragma unroll
        for (int st = 0; st < 2; ++st) {
            const int dv = 32 * dvb + r32, c0 = 8 * vtile + 4 * st + h;
            const LAS unsigned char* vrow = VTt + dv * VS;
            const u32x2 lo = *(const LAS u32x2*)(vrow + ((c0 ^ (dv >> 3)) << 3)), hi = *(const LAS u32x2*)(vrow + (((c0 + 2) ^ (dv >> 3)) << 3));
            u32x4 w; w.x = lo.x; w.y = lo.y; w.z = hi.x; w.w = hi.y;
            o[dvb] = MFMA32(__builtin_bit_cast(bf16x8, w), pa[st], o[dvb]);
        }
    __builtin_amdgcn_sched_barrier(0);
}
DI void attn_store(const f32x16 (&o)[2], float l, float extra, bf16_t* orow, int h) {
    const float lt = xhalf_sum(l) + extra;
    const float inv = 1.0f / lt;
#pragma unroll
    for (int dvb = 0; dvb < 2; ++dvb)
#pragma unroll
        for (int g = 0; g < 4; ++g) { u32x2 w; w.x = pk2(o[dvb][4 * g] * inv, o[dvb][4 * g + 1] * inv); w.y = pk2(o[dvb][4 * g + 2] * inv, o[dvb][4 * g + 3] * inv);
            *(u32x2*)(orow + 32 * dvb + 8 * g + 4 * h) = w; }
}

DI void phase_swa(const Frame& F, int l) {
    const int lane = lane_id(), tid = F.wave * 64 + lane, r32 = lane & 31, h = lane >> 5, key = tid >> 3, part = tid & 7;
    const bf16_t* PRJ = (const bf16_t*)(F.ws + WS_PRJ); bf16_t* OM = (bf16_t*)(F.ws + WS_OMIX);
    const int idx = l >> 1; const float* gq = inp(F, 18) + idx * 64; const float* gk = inp(F, 19) + idx * 64; const float* sinks = inp(F, 20) + idx * 16;
    LAS unsigned char* CTXI = F.lds;
    LAS unsigned char* RING = F.lds + 4 * KV_PAIR;
    LAS f32x2* rtab = (LAS f32x2*)(F.lds + 9 * KV_PAIR);
    for (int i = tid; i < 1024; i += 512) { const float ang = (float)(i >> 4) * exp2f(-(float)(i & 15) * (13.287712379549449f / 16.0f)); rtab[i] = (f32x2){cosf(ang), sinf(ang)}; }
    __syncthreads();
    const bool with_ctx = l < DEPTH - 1;
    const int nunits = 2048 + (with_ctx ? 128 : 0);
    const float qscale = 0.125f * LOG2E;
    const int u_lo = (int)(((long)F.blk * nunits) / F.G), u_hi = (int)(((long)(F.blk + 1) * nunits) / F.G);
    int cur_grp = -1, have_lo = 0, have_hi = -1;
    for (int u = u_lo; u < u_hi; ++u) {
        const bool is_ctx = u >= 2048;
        int b, kvh, qb, hh2; if (!is_ctx) { b = u >> 8; kvh = (u >> 7) & 1; qb = (u >> 1) & 63; hh2 = u & 1; } else { const int v = u - 2048; b = v >> 4; kvh = (v >> 3) & 1; qb = (v >> 1) & 3; hh2 = v & 1; }
        const int hq = kvh * 8 + hh2 * 4 + (F.wave >> 1), qs = F.wave & 1, q0 = qb * 64, a = q0 + 32 * qs, tq = a + r32;
        const int kcol = O_K + kvh * 64, vcol = O_V + kvh * 64;
        const int tokq = is_ctx ? TLAT + b * CTXL + tq : b * SEQ + tq;
        if (b * 2 + kvh != cur_grp) {
            cur_grp = b * 2 + kvh; have_lo = 0; have_hi = -1;
            KVRegs cx[4];
#pragma unroll
            for (int s = 0; s < 4; ++s) cx[s] = kv_load(PRJ, ODD_IN, TLAT + b * CTXL + 64 * s + key, kcol, vcol, part);
#pragma unroll
            for (int s = 0; s < 4; ++s) kv_write<false>(cx[s], CTXI + s * KV_PAIR, CTXI + s * KV_PAIR + K_IMG, key, part, gk, rtab, 0, 0);
        }
        const int need_lo = qb - 2 < 0 ? 0 : qb - 2, need_hi = qb + 2 > 63 ? 63 : qb + 2;
        if (!is_ctx) {
            const int first = have_hi + 1 > need_lo ? have_hi + 1 : need_lo;
#pragma unroll 1
            for (int kb = first; kb <= need_hi; ++kb) {
                const KVRegs x = kv_load(PRJ, ODD_IN, b * SEQ + 64 * kb + key, kcol, vcol, part);
                LAS unsigned char* Kn = RING + (kb % 5) * KV_PAIR; kv_write<true>(x, Kn, Kn + K_IMG, key, part, gk, rtab, kb, key);
            }
            have_lo = need_lo; have_hi = need_hi;
        }
        KVRegs pf; int pf_kb = -1;
        { const int nu = u + 1;
          if (!is_ctx && nu < u_hi && nu < 2048 && (nu >> 7) == (u >> 7)) { const int nqb = (nu >> 1) & 63; const int want = nqb + 2 > 63 ? 63 : nqb + 2;
              if (want > have_hi) { pf_kb = want; pf = kv_load(PRJ, ODD_IN, b * SEQ + 64 * want + key, kcol, vcol, part); } } }
        bf16x8 qf[4]; f32x16 o[2]; float m = -1.0e30f, lsum = 0.f;
        if (is_ctx) q_load<false>(qf, PRJ + pidx(tokq, O_Q + hq * 64), h, gq, qscale, rtab, 0, 0);
        else q_load<true>(qf, PRJ + pidx(tokq, O_Q + hq * 64), h, gq, qscale, rtab, tq >> 6, tq & 63);
#pragma unroll
        for (int i = 0; i < 16; ++i) { o[0][i] = 0.f; o[1][i] = 0.f; }
        __syncthreads();
#pragma unroll 1
        for (int s = 0; s < 4; ++s) {
            const LAS unsigned char* Kc = CTXI + s * KV_PAIR; const LAS unsigned char* Vc = Kc + K_IMG;
#pragma unroll
            for (int tt = 0; tt < 2; ++tt) attn_tile(Kc, Vc, tt, qf, o, m, lsum, r32, h, [](f32x16&) {});
        }
        if (!is_ctx) {
#pragma unroll 1
            for (int kb = need_lo; kb <= need_hi; ++kb) {
                const LAS unsigned char* Kc = RING + (kb % 5) * KV_PAIR; const LAS unsigned char* Vc = Kc + K_IMG;
#pragma unroll
                for (int tt = 0; tt < 2; ++tt) {
                    const int kt0 = 64 * kb + 32 * tt;
                    if (kt0 + 31 >= a - 128 && kt0 <= a + 31 + 128)
                        attn_tile(Kc, Vc, tt, qf, o, m, lsum, r32, h,
                                  [&](f32x16& sc) {
#pragma unroll
                                      for (int r = 0; r < 16; ++r) { const int kp = kt0 + crow(r, h); sc[r] = ((unsigned)(tq - kp + 128) <= 256u) ? sc[r] : -1.0e30f; } });
                }
            }
        }
        attn_store(o, lsum, __builtin_amdgcn_exp2f(sinks[hq] * LOG2E - m), OM + (size_t)tokq * D + hq * 64, h);
        __syncthreads();
        if (pf_kb >= 0) { LAS unsigned char* Kn = RING + (pf_kb % 5) * KV_PAIR; kv_write<true>(pf, Kn, Kn + K_IMG, key, part, gk, rtab, pf_kb, key); have_hi = pf_kb; }
    }
}

DI void na_units(const Frame& F, int l) {
    const int lane = lane_id(), tid = F.wave * 64 + lane, r32 = lane & 31, h = lane >> 5, key = tid >> 3, part = tid & 7;
    const bf16_t* PRJ = (const bf16_t*)(F.ws + WS_PRJ); bf16_t* OM = (bf16_t*)(F.ws + WS_OMIX);
    const int idx = l >> 1; const float* gq = inp(F, 13) + idx * 64; const float* gk = inp(F, 14) + idx * 64;
    LAS unsigned char* CTXI = F.lds;
    LAS unsigned char* RING = F.lds + 4 * KV_PAIR;
    LAS float* rpbL = (LAS float*)(F.lds + 6 * KV_PAIR);
    const bool with_ctx = l < DEPTH - 1;
    const int nunits = 1024 + (with_ctx ? 64 : 0);
    const float qscale = 0.125f * LOG2E;
    const float* rpb_all = inp(F, 15) + (size_t)idx * 8 * 465;
    const int u_lo = (int)(((long)F.blk * nunits) / F.G), u_hi = (int)(((long)(F.blk + 1) * nunits) / F.G);
    int cur_grp = -1;
    for (int u = u_lo; u < u_hi; ++u) {
        const bool is_ctx = u >= 1024;
        int b, hh, rg; if (!is_ctx) { b = u >> 7; hh = (u >> 4) & 7; rg = u & 15; } else { const int v = u - 1024; b = v >> 3; hh = v & 7; rg = 0; }
        const int R0 = 4 * rg, R = R0 + (F.wave >> 1), qh = F.wave & 1, c = 32 * qh + r32;
        const int kcol = C_NK + hh * 64, vcol = C_NV + hh * 64;
        const int tokq = is_ctx ? TLAT + b * CTXL + 32 * F.wave + r32 : b * SEQ + R * 64 + c;
        if (b * 8 + hh != cur_grp) {
            cur_grp = b * 8 + hh;
            KVRegs cx[4];
#pragma unroll
            for (int s = 0; s < 4; ++s) cx[s] = kv_load(PRJ, EVEN_LD, TLAT + b * CTXL + 64 * s + key, kcol, vcol, part);
            const float* rp = rpb_all + (size_t)hh * 465; for (int i = tid; i < 465; i += 512) rpbL[i] = rp[i] * LOG2E;
#pragma unroll
            for (int s = 0; s < 4; ++s) kv_write<false>(cx[s], CTXI + s * KV_PAIR, CTXI + s * KV_PAIR + K_IMG, key, part, gk, (const LAS f32x2*)nullptr, 0, 0);
        }
        bf16x8 qf[4]; f32x16 o[2]; float m = -1.0e30f, lsum = 0.f;
        q_load<false>(qf, PRJ + pidx(tokq, C_NQ + hh * 64), h, gq, qscale, (const LAS f32x2*)nullptr, 0, 0);
#pragma unroll
        for (int i = 0; i < 16; ++i) { o[0][i] = 0.f; o[1][i] = 0.f; }
        const int sR = R - 4 < 0 ? 0 : (R - 4 > 56 ? 56 : R - 4);
        const int klo = R0 - 4 < 0 ? 0 : (R0 - 4 > 56 ? 56 : R0 - 4), khi = (R0 - 1 < 0 ? 0 : (R0 - 1 > 56 ? 56 : R0 - 1)) + 7;
        const int nrow = is_ctx ? 0 : (khi - klo + 1);
        KVRegs nx;
        if (!is_ctx) nx = kv_load(PRJ, EVEN_LD, b * SEQ + klo * 64 + key, kcol, vcol, part);
        __syncthreads();
#pragma unroll 1
        for (int s = 0; s < 4; ++s) {
            const LAS unsigned char* Kc = CTXI + s * KV_PAIR; const LAS unsigned char* Vc = Kc + K_IMG;
#pragma unroll
            for (int tt = 0; tt < 2; ++tt) attn_tile(Kc, Vc, tt, qf, o, m, lsum, r32, h, [](f32x16&) {});
        }
        if (!is_ctx) {
            kv_write<false>(nx, RING, RING + K_IMG, key, part, gk, (const LAS f32x2*)nullptr, 0, 0);
            __syncthreads();
            const int w0 = c - 8 < 0 ? 0 : (c - 8 > 48 ? 48 : c - 8);
            for (int s = 0; s < nrow; ++s) {
                const bool more = s + 1 < nrow;
                if (more) nx = kv_load(PRJ, EVEN_LD, b * SEQ + (klo + s + 1) * 64 + key, kcol, vcol, part);
                const LAS unsigned char* Kc = RING + (s & 1) * KV_PAIR; const LAS unsigned char* Vc = Kc + K_IMG;
                const int kr = klo + s;
                if (kr >= sR && kr < sR + 8) {
                    const LAS float* brow = rpbL + (kr - R + 7) * 31 + 15 - c;
#pragma unroll
                    for (int tt = 0; tt < 2; ++tt)
                        attn_tile(Kc, Vc, tt, qf, o, m, lsum, r32, h,
                                  [&](f32x16& sc) { float bv[16];
#pragma unroll
                                      for (int r = 0; r < 16; ++r) { const int kc = 32 * tt + crow(r, h); const int bi = kc < w0 ? w0 : (kc > w0 + 15 ? w0 + 15 : kc); bv[r] = brow[bi]; }
#pragma unroll
                                      for (int r = 0; r < 16; ++r) { const int kc = 32 * tt + crow(r, h); const unsigned ok = (unsigned)(kc - w0) < 16u; sc[r] = ok ? sc[r] + bv[r] : -1.0e30f; } });
                }
                if (more) { LAS unsigned char* Kn = RING + ((s + 1) & 1) * KV_PAIR; kv_write<false>(nx, Kn, Kn + K_IMG, key, part, gk, (const LAS f32x2*)nullptr, 0, 0); }
                __syncthreads();
            }
        }
        attn_store(o, lsum, 0.f, OM + (size_t)tokq * D + 512 + hh * 64, h);
        __syncthreads();
    }
}

constexpr int GLA_CH = 68, GLA_ITEMS = NBATCH * 4 * 2 * GLA_CH;
DI int gla_tok0(int b, int dir, int p) { const int q = dir ? (p < 4 ? 3 - p : 67 - p) : (p < 4 ? p : p - 4); return p < 4 ? TLAT + b * CTXL + 64 * q : b * SEQ + 64 * q; }
DI float logsig16(float z) { return (fminf(z, 0.f) - __logf(1.0f + __expf(-fabsf(z)))) * (1.0f / 16.0f); }
constexpr int GT_STRIDE = 136;
DI void gla_local(const Frame& F, int l, int it_begin, int it_end) {
    const int lane = lane_id(), r32 = lane & 31, h = lane >> 5;
    const bf16_t* PRJ = (const bf16_t*)(F.ws + WS_PRJ);
    const int idx = l >> 1;
    LAS unsigned char* KT = F.lds + F.wave * 17408;
    LAS unsigned char* VT = KT + 8704;
    bf16_t* Ug = (bf16_t*)(F.ws + WS_GU); float* Dg = (float*)(F.ws + WS_GD); bf16_t* QTg = (bf16_t*)(F.ws + WS_GQ); bf16_t* KTg = (bf16_t*)(F.ws + WS_GK);
    const float* wa2 = inp(F, 10) + (size_t)idx * 2 * 16 * 256; const float* ba2 = inp(F, 11) + idx * 2 * 256;
    for (int it = it_begin + F.wave; it < it_end; it += 8) {
        const int ch = it / GLA_CH, p = it % GLA_CH, dir = ch & 1, hd = (ch >> 1) & 3, b = ch >> 3;
        const int tok0 = gla_tok0(b, dir, p);
        { const bf16_t* ap = PRJ + pidx(tok0 + lane, dir ? C_AB : C_AF); const u32x4 a0 = *(const u32x4*)ap, a1 = *(const u32x4*)(ap + 8);
          *(LAS u32x4*)(VT + lane * 32) = a0; *(LAS u32x4*)(VT + lane * 32 + 16) = a1; }
        float w[16];
#pragma unroll
        for (int r = 0; r < 16; ++r) w[r] = wa2[((size_t)dir * 16 + r) * 256 + hd * 64 + lane];
        const float bb = ba2[dir * 256 + hd * 64 + lane];
        const bf16_t* kp = PRJ + pidx(tok0, C_K + hd * 64) + lane;
        const bf16_t* qp = PRJ + pidx(tok0, C_Q + hd * 64) + lane;
        LDS_WAIT();
        float g[64]; float tot = 0.f;
#pragma unroll
        for (int t = 0; t < 64; ++t) {
            const u32x4 a0 = *(const LAS u32x4*)(VT + t * 32), a1 = *(const LAS u32x4*)(VT + t * 32 + 16);
            float z = bb;
            z += bflo(a0.x) * w[0] + bfhi(a0.x) * w[1] + bflo(a0.y) * w[2] + bfhi(a0.y) * w[3] + bflo(a0.z) * w[4] + bfhi(a0.z) * w[5] + bflo(a0.w) * w[6] + bfhi(a0.w) * w[7];
            z += bflo(a1.x) * w[8] + bfhi(a1.x) * w[9] + bflo(a1.y) * w[10] + bfhi(a1.y) * w[11] + bflo(a1.z) * w[12] + bfhi(a1.z) * w[13] + bflo(a1.w) * w[14] + bfhi(a1.w) * w[15];
            g[t] = logsig16(z); tot += g[t];
        }
        Dg[(size_t)it * 64 + lane] = __expf(tot);
        float run = 0.f;
        bf16_t* qo = QTg + ((size_t)dir * TALL + tok0) * 256 + hd * 64 + lane; bf16_t* ko = KTg + ((size_t)dir * TALL + tok0) * 256 + hd * 64 + lane;
#pragma unroll
        for (int c8 = 0; c8 < 8; ++c8) {
            unsigned short kr[8], qr[8];
#pragma unroll
            for (int e = 0; e < 8; ++e) { kr[e] = kp[(size_t)(8 * c8 + e) * 64]; qr[e] = qp[(size_t)(8 * c8 + e) * 64]; }
            float kh[8];
#pragma unroll
            for (int e = 0; e < 8; ++e) {
                const int t = 8 * c8 + e;
                const float C = dir ? (tot - run) : (run + g[t]);
                run += g[t];
                const float kf = bf2f(kr[e]), qf_ = bf2f(qr[e]);
                kh[e] = kf * __expf(tot - C);
                ko[(size_t)t * 256] = (bf16_t)f2bf(kf * __expf(-C));
                qo[(size_t)t * 256] = (bf16_t)f2bf(qf_ * 0.125f * __expf(C));
            }
#pragma unroll
            for (int e = 0; e < 8; e += 2) *(LAS unsigned*)(KT + lane * GT_STRIDE + (8 * c8 + e) * 2) = pk2(kh[e], kh[e + 1]);
        }
        LDS_WAIT();
#pragma unroll 1
        for (int hv = 0; hv < 2; ++hv) {
            const bf16_t* vp = PRJ + pidx(tok0, C_V + hd * 128 + 64 * hv) + lane;
            unsigned short vv[64];
#pragma unroll
            for (int t = 0; t < 64; ++t) vv[t] = vp[(size_t)t * 64];
#pragma unroll
            for (int t = 0; t < 64; t += 2) *(LAS unsigned*)(VT + lane * GT_STRIDE + t * 2) = (unsigned)vv[t] | ((unsigned)vv[t + 1] << 16);
            LDS_WAIT();
            f32x16 acc[2][2];
#pragma unroll
            for (int mb = 0; mb < 2; ++mb)
#pragma unroll
                for (int nb = 0; nb < 2; ++nb)
#pragma unroll
                    for (int i = 0; i < 16; ++i) acc[mb][nb][i] = 0.f;
#pragma unroll
            for (int ks = 0; ks < 4; ++ks) {
                bf16x8 af[2], bfr[2];
#pragma unroll
                for (int mb = 0; mb < 2; ++mb) { const LAS unsigned char* ap = KT + (32 * mb + r32) * GT_STRIDE + (16 * ks + 8 * h) * 2; const u32x2 lo = *(const LAS u32x2*)ap, hi = *(const LAS u32x2*)(ap + 8);
                    u32x4 x; x.x = lo.x; x.y = lo.y; x.z = hi.x; x.w = hi.y; af[mb] = __builtin_bit_cast(bf16x8, x); }
#pragma unroll
                for (int nb = 0; nb < 2; ++nb) { const LAS unsigned char* bp = VT + (32 * nb + r32) * GT_STRIDE + (16 * ks + 8 * h) * 2; const u32x2 lo = *(const LAS u32x2*)bp, hi = *(const LAS u32x2*)(bp + 8);
                    u32x4 x; x.x = lo.x; x.y = lo.y; x.z = hi.x; x.w = hi.y; bfr[nb] = __builtin_bit_cast(bf16x8, x); }
#pragma unroll
                for (int mb = 0; mb < 2; ++mb)
#pragma unroll
                    for (int nb = 0; nb < 2; ++nb) acc[mb][nb] = MFMA32(af[mb], bfr[nb], acc[mb][nb]);
            }
            bf16_t* up = Ug + (size_t)it * 8192 + (size_t)(64 * hv + r32) * 64;
#pragma unroll
            for (int mb = 0; mb < 2; ++mb)
#pragma unroll
                for (int nb = 0; nb < 2; ++nb)
#pragma unroll
                    for (int g = 0; g < 4; ++g) { u32x2 w; w.x = pk2(acc[mb][nb][4 * g], acc[mb][nb][4 * g + 1]); w.y = pk2(acc[mb][nb][4 * g + 2], acc[mb][nb][4 * g + 3]);
                        *(u32x2*)(up + (size_t)(32 * nb) * 64 + 32 * mb + 8 * g + 4 * h) = w; }
            LDS_WAIT();
        }
    }
}
DI void phase_even_a(const Frame& F, int l) {
    const int nunits = 1024 + (l < DEPTH - 1 ? 64 : 0);
    const int base = (((GLA_ITEMS + 8 * nunits + F.G - 1) / F.G) + 7) & ~7;
    auto ulo = [&](int j) -> int { return (int)(((long)j * nunits) / F.G); };
    int it_begin = base * F.blk - 8 * ulo(F.blk), it_end = base * (F.blk + 1) - 8 * ulo(F.blk + 1);
    if (it_begin > GLA_ITEMS) it_begin = GLA_ITEMS; if (it_end > GLA_ITEMS) it_end = GLA_ITEMS; if (F.blk == F.G - 1) it_end = GLA_ITEMS;
    gla_local(F, l, it_begin, it_end); __syncthreads(); na_units(F, l);
}

DI void phase_gla_scan(const Frame& F, int l) {
    const int lane = lane_id(), gt = (F.blk * 8 + F.wave) * 64 + lane, NGT = F.G * 512;
    const bf16_t* __restrict__ Ug = (const bf16_t*)(F.ws + WS_GU); const float* __restrict__ Dg = (const float*)(F.ws + WS_GD); bf16_t* __restrict__ ST = (bf16_t*)(F.ws + WS_GS);
    for (int w = gt; w < 64 * 2048; w += NGT) {
        const int ch = w >> 11, dv = (w >> 4) & 127, dkg = w & 15;
        float s[4] = {0.f, 0.f, 0.f, 0.f};
        const bf16_t* up = Ug + (size_t)ch * GLA_CH * 8192 + (size_t)dv * 64 + 4 * dkg; const float* dp = Dg + (size_t)ch * GLA_CH * 64 + 4 * dkg; bf16_t* sp = ST + (size_t)ch * GLA_CH * 8192 + (size_t)dv * 64 + 4 * dkg;
#pragma unroll 1
        for (int p0 = 0; p0 < GLA_CH; p0 += 17) {
            u32x2 uw[17]; f32x4 dk[17];
#pragma unroll
            for (int q = 0; q < 17; ++q) { uw[q] = *(const u32x2*)(up + (size_t)(p0 + q) * 8192); dk[q] = *(const f32x4*)(dp + (size_t)(p0 + q) * 64); }
#pragma unroll
            for (int q = 0; q < 17; ++q) {
                u32x2 o; o.x = pk2(s[0], s[1]); o.y = pk2(s[2], s[3]);
                *(u32x2*)(sp + (size_t)(p0 + q) * 8192) = o;
                s[0] = dk[q][0] * s[0] + bflo(uw[q].x); s[1] = dk[q][1] * s[1] + bfhi(uw[q].x); s[2] = dk[q][2] * s[2] + bflo(uw[q].y); s[3] = dk[q][3] * s[3] + bfhi(uw[q].y);
            }
        }
    }
}

DI void phase_gla_out(const Frame& F, int l) {
    const int lane = lane_id(), r32 = lane & 31, h = lane >> 5;
    const bf16_t* PRJ = (const bf16_t*)(F.ws + WS_PRJ); bf16_t* OM = (bf16_t*)(F.ws + WS_OMIX); const bf16_t* ST = (const bf16_t*)(F.ws + WS_GS);
    const bf16_t* QTg = (const bf16_t*)(F.ws + WS_GQ); const bf16_t* KTg = (const bf16_t*)(F.ws + WS_GK);
    const int idx = l >> 1; const bool with_ctx = l < DEPTH - 1;
    LAS unsigned char* VT = F.lds;
    LAS float* SS = (LAS float*)(F.lds + 128 * GT_STRIDE);
    const int iblk = F.wave & 1, dvq = F.wave >> 1;
    const float* gn = inp(F, 12) + idx * 128 + 32 * dvq;
    const int nitems = NBATCH * 4 * GLA_CH;
    for (int it = F.blk; it < nitems; it += F.G) {
        const int sc = it % GLA_CH, hd = (it / GLA_CH) & 3, b = it / (GLA_CH * 4);
        if (sc < 4 && !with_ctx) continue;
        const int tok0 = sc < 4 ? TLAT + b * CTXL + 64 * sc : b * SEQ + 64 * (sc - 4);
        const int ti = 32 * iblk + r32;
        unsigned short v0[8], v1[8];
        { const bf16_t* vp = PRJ + pidx(tok0 + 8 * F.wave, C_V + hd * 128) + lane; const bf16_t* vp1 = PRJ + pidx(tok0 + 8 * F.wave, C_V + hd * 128 + 64) + lane;
#pragma unroll
          for (int e = 0; e < 8; ++e) { v0[e] = vp[(size_t)e * 64]; v1[e] = vp1[(size_t)e * 64]; } }
        u32x4 qw[2][4], kd[2][4], ko[4], sw[2][4];
        const int odir = iblk ? 0 : 1, ojb = 1 - iblk;
        size_t item[2];
#pragma unroll
        for (int dir = 0; dir < 2; ++dir) {
            const int pp = dir ? (sc < 4 ? 3 - sc : 71 - sc) : sc;
            item[dir] = (size_t)(((b * 4 + hd) * 2 + dir) * GLA_CH + pp);
            const bf16_t* qp = QTg + ((size_t)dir * TALL + tok0 + ti) * 256 + hd * 64 + 8 * h;
            const bf16_t* kp = KTg + ((size_t)dir * TALL + tok0 + ti) * 256 + hd * 64 + 8 * h;
            const bf16_t* sp = ST + item[dir] * 8192 + (size_t)(32 * dvq + r32) * 64 + 8 * h;
#pragma unroll
            for (int ks = 0; ks < 4; ++ks) { qw[dir][ks] = *(const u32x4*)(qp + 16 * ks); kd[dir][ks] = *(const u32x4*)(kp + 16 * ks); sw[dir][ks] = *(const u32x4*)(sp + 16 * ks); }
        }
        { const bf16_t* kp = KTg + ((size_t)odir * TALL + tok0 + 32 * ojb + r32) * 256 + hd * 64 + 8 * h;
#pragma unroll
          for (int ks = 0; ks < 4; ++ks) ko[ks] = *(const u32x4*)(kp + 16 * ks); }
#pragma unroll
        for (int e = 0; e < 8; e += 2) { *(LAS unsigned*)(VT + lane * GT_STRIDE + (8 * F.wave + e) * 2) = (unsigned)v0[e] | ((unsigned)v0[e + 1] << 16);
            *(LAS unsigned*)(VT + (lane + 64) * GT_STRIDE + (8 * F.wave + e) * 2) = (unsigned)v1[e] | ((unsigned)v1[e + 1] << 16); }
        __syncthreads();
        f32x16 o;
#pragma unroll
        for (int i = 0; i < 16; ++i) o[i] = 0.f;
#pragma unroll
        for (int dir = 0; dir < 2; ++dir) {
#pragma unroll
            for (int blkk = 0; blkk < 2; ++blkk) {
                if (blkk == 1 && dir != odir) continue;
                const int jb = blkk ? ojb : iblk;
                f32x16 sacc;
#pragma unroll
                for (int i = 0; i < 16; ++i) sacc[i] = 0.f;
#pragma unroll
                for (int ks = 0; ks < 4; ++ks) sacc = MFMA32(__builtin_bit_cast(bf16x8, blkk ? ko[ks] : kd[dir][ks]), __builtin_bit_cast(bf16x8, qw[dir][ks]), sacc);
                if (blkk == 0) {
#pragma unroll
                    for (int r = 0; r < 16; ++r) { const int j = 32 * jb + crow(r, h); const bool keep = dir == 0 ? (j <= ti) : (j >= ti); sacc[r] = keep ? sacc[r] : 0.f; }
                }
#pragma unroll
                for (int st = 0; st < 2; ++st) {
                    u32x4 pw; pw.x = pk2(sacc[8 * st], sacc[8 * st + 1]); pw.y = pk2(sacc[8 * st + 2], sacc[8 * st + 3]); pw.z = pk2(sacc[8 * st + 4], sacc[8 * st + 5]); pw.w = pk2(sacc[8 * st + 6], sacc[8 * st + 7]);
                    const LAS unsigned char* vp = VT + (32 * dvq + r32) * GT_STRIDE + (32 * jb + 16 * st + 4 * h) * 2;
                    const u32x2 lo = *(const LAS u32x2*)vp, hi = *(const LAS u32x2*)(vp + 16);
                    u32x4 vw; vw.x = lo.x; vw.y = lo.y; vw.z = hi.x; vw.w = hi.y;
                    o = MFMA32(__builtin_bit_cast(bf16x8, vw), __builtin_bit_cast(bf16x8, pw), o);
                }
            }
#pragma unroll
            for (int ks = 0; ks < 4; ++ks) o = MFMA32(__builtin_bit_cast(bf16x8, sw[dir][ks]), __builtin_bit_cast(bf16x8, qw[dir][ks]), o);
        }
        float ss = 0.f;
#pragma unroll
        for (int i = 0; i < 16; ++i) ss += o[i] * o[i];
        ss = xhalf_sum(ss);
        if (h == 0) SS[dvq * 64 + ti] = ss;
        const bf16_t* gp = PRJ + pidx(tok0 + ti, C_G + hd * 128 + 32 * dvq);
        u32x2 gw[4]; f32x4 gv[4];
#pragma unroll
        for (int g = 0; g < 4; ++g) { gw[g] = *(const u32x2*)(gp + 8 * g + 4 * h); gv[g] = *(const f32x4*)(gn + 8 * g + 4 * h); }
        __syncthreads();
        const float tot = SS[ti] + SS[64 + ti] + SS[128 + ti] + SS[192 + ti];
        const float rs = 1.0f / sqrtf(tot * (1.f / 128.f) + EPS);
        bf16_t* op = OM + (size_t)(tok0 + ti) * D + hd * 128 + 32 * dvq;
#pragma unroll
        for (int g = 0; g < 4; ++g) {
            const float g0 = bflo(gw[g].x), g1 = bfhi(gw[g].x), g2 = bflo(gw[g].y), g3 = bfhi(gw[g].y);
            u32x2 ow; ow.x = pk2(o[4 * g] * rs * gv[g][0] * silu_f(g0), o[4 * g + 1] * rs * gv[g][1] * silu_f(g1)); ow.y = pk2(o[4 * g + 2] * rs * gv[g][2] * silu_f(g2), o[4 * g + 3] * rs * gv[g][3] * silu_f(g3));
            *(u32x2*)(op + 8 * g + 4 * h) = ow;
        }
        __syncthreads();
    }
}

constexpr int N_PHASES = 2 + 10 * DEPTH;
#ifndef NB_CONV
#define NB_CONV 48
#endif
#ifndef NB_CONV_ODD
#define NB_CONV_ODD 64
#endif
struct Args { const float* in[27]; float* out; unsigned char* ws; int ph_lo, ph_hi; };
#define PH_IN(k) (lo <= (k) && (k) < hi)
#define PH_BAR(k) do { if (PH_IN(k) && PH_IN((k) + 1)) xcd_barrier(bar); } while (0)
template <int l> DI void layer_program(Frame& F, const XcdBarrier& bar, const int lo, const int hi) {
    constexpr int pb = 2 + 10 * l;
    constexpr bool odd = (l & 1) != 0, with_ctx = l < DEPTH - 1;
    if (PH_IN(pb)) {
        DenseSched S; S.ord.init(TALL / 256, odd ? 5 : 13, F.G, F.blk); S.A = (const char*)(F.ws + WS_H);
        S.B = (const char*)(F.ws + (odd ? WS_WINO + (size_t)(l >> 1) * ODD_IN * 2048 : WS_WINE + (size_t)(l >> 1) * EVEN_LD * 2048));
        EpiPrj E{(bf16_t*)(F.ws + WS_PRJ), odd ? ODD_IN : EVEN_LD};
        pg8::gemm_phase<EpiPrj, DenseSched, false>(F.lds, S, E, F.wave, (LAS unsigned*)(F.lds + MISC_OFF + 1024));
    }
    PH_BAR(pb);
    if (PH_IN(pb + 1)) {
        constexpr int NBC = (l < DEPTH - 1) ? (odd ? NB_CONV_ODD : NB_CONV) : 0;
        if (NBC > 0 && F.blk >= F.G - NBC) convert_moe_layer(F, l + 1, F.blk - (F.G - NBC), NBC);
        else { Frame Fm = F; Fm.G = F.G - NBC; if (odd) phase_swa(Fm, l); else phase_even_a(Fm, l); }
    }
    PH_BAR(pb + 1);
    if (!odd) {
        if (PH_IN(pb + 2)) phase_gla_scan(F, l);
        PH_BAR(pb + 2);
        if (PH_IN(pb + 3)) phase_gla_out(F, l);
        PH_BAR(pb + 3);
    }
    if (PH_IN(pb + 4)) {
        DenseSched S; S.ord.init(TLAT / 256, 4, F.G, F.blk); S.A = (const char*)(F.ws + WS_OMIX); S.B = (const char*)(F.ws + WS_WOUT + (size_t)l * 1024 * 2048);
        float* X = (float*)(F.ws + WS_X);
        EpiRes E{l == 0 ? inp(F, 0) : X, l == 0 ? inp(F, 2) : X + (size_t)TLAT * D, X, modv(F, l, 0) + 2048};
        pg8::gemm_phase<EpiRes, DenseSched, false>(F.lds, S, E, F.wave, (LAS unsigned*)(F.lds + MISC_OFF + 1024));
    }
    PH_BAR(pb + 4);
    if (PH_IN(pb + 5)) {
        constexpr int NCX = with_ctx ? (TCTX / 256) * 4 : 0;
        if (with_ctx && F.G > 2 * NCX) {
            if (F.blk < NCX) {
                DenseSched S; S.ord.init(TCTX / 256, 4, NCX, F.blk); S.pm0 = TLAT / 256; S.A = (const char*)(F.ws + WS_OMIX); S.B = (const char*)(F.ws + WS_WOUT + (size_t)l * 1024 * 2048);
                float* X = (float*)(F.ws + WS_X);
                EpiRes E{l == 0 ? inp(F, 0) : X, l == 0 ? inp(F, 2) : X + (size_t)TLAT * D, X, modv(F, l, 0) + 2048};
                pg8::gemm_phase<EpiRes, DenseSched, false>(F.lds, S, E, F.wave, (LAS unsigned*)(F.lds + MISC_OFF + 1024));
            } else { Frame Fr = F; Fr.blk = F.blk - NCX; Fr.G = F.G - NCX; phase_router(Fr, l, 0, TLAT / 32); }
        } else {
            if (with_ctx) {
                DenseSched S; S.ord.init(TCTX / 256, 4, F.G, F.blk); S.pm0 = TLAT / 256; S.A = (const char*)(F.ws + WS_OMIX); S.B = (const char*)(F.ws + WS_WOUT + (size_t)l * 1024 * 2048);
                float* X = (float*)(F.ws + WS_X);
                EpiRes E{l == 0 ? inp(F, 0) : X, l == 0 ? inp(F, 2) : X + (size_t)TLAT * D, X, modv(F, l, 0) + 2048};
                pg8::gemm_phase<EpiRes, DenseSched, false>(F.lds, S, E, F.wave, (LAS unsigned*)(F.lds + MISC_OFF + 1024));
                xcd_barrier(bar);
            }
            phase_router(F, l, 0, TLAT / 32);
        }
    }
    PH_BAR(pb + 5);
    if (with_ctx) {
        if (PH_IN(pb + 6)) phase_router(F, l, TLAT / 32, TALL / 32);
        PH_BAR(pb + 6);
    }
    if (PH_IN(pb + 7)) {
        LAS int* ts = (LAS int*)(F.lds + MISC_OFF); LAS int* cn = ts + 64;
        moe_tables_build(F, l, ts, cn);
        MoeSched<true> S; S.T.tstart = ts; S.T.cnt = cn; S.ord.init(ts[NEXP], 8, F.G, F.blk); S.A = (const char*)(F.ws + WS_H); S.W = (const char*)(F.ws + WS_WGU + (size_t)l * 32 * 2048 * 2048); S.list = (const int*)(F.ws + WS_LIST); S.wlist = (const float*)(F.ws + WS_WTOK);
        EpiSwiglu E{(bf16_t*)(F.ws + WS_ACT), inp(F, 24) + (size_t)l * 32 * 2048};
        pg8::gemm_phase<EpiSwiglu, MoeSched<true>, true>(F.lds, S, E, F.wave, (LAS unsigned*)(F.lds + MISC_OFF + 1024));
    }
    PH_BAR(pb + 7);
    if (PH_IN(pb + 8)) {
        LAS int* ts = (LAS int*)(F.lds + MISC_OFF); LAS int* cn = ts + 64;
        moe_tables_build(F, l, ts, cn);
        MoeSched<false> S; S.T.tstart = ts; S.T.cnt = cn; S.ord.init(ts[NEXP], 4, F.G, F.blk); S.A = (const char*)(F.ws + WS_ACT); S.W = (const char*)(F.ws + WS_WDN + (size_t)l * 32 * 1024 * 2048); S.list = (const int*)(F.ws + WS_LIST); S.wlist = (const float*)(F.ws + WS_WTOK);
        EpiDown E{(bf16_t*)(F.ws + WS_Y), inp(F, 26) + (size_t)l * 32 * 1024};
        pg8::gemm_phase<EpiDown, MoeSched<false>, false>(F.lds, S, E, F.wave, (LAS unsigned*)(F.lds + MISC_OFF + 1024));
    }
    PH_BAR(pb + 8);
    if (PH_IN(pb + 9)) phase_combine(F, l);
    if (l < DEPTH - 1) PH_BAR(pb + 9);
}
__global__ void __launch_bounds__(512, 2) fwd_kernel(Args args) {
    extern __shared__ __attribute__((aligned(16))) unsigned char lds_raw[];
    Frame F; F.lds = (LAS unsigned char*)lds_raw; F.ws = args.ws; F.ctl = (unsigned*)(args.ws + WS_CTL); F.out = args.out;
    {
        const unsigned long long kp = (unsigned long long)__builtin_amdgcn_kernarg_segment_ptr(); unsigned klo = (unsigned)kp, khi = (unsigned)(kp >> 32);
        asm volatile("" : "+v"(klo), "+v"(khi)); klo = __builtin_amdgcn_readfirstlane(klo); khi = __builtin_amdgcn_readfirstlane(khi);
        F.in = (const float* const*)(((unsigned long long)khi << 32) | klo); }
    F.wave = __builtin_amdgcn_readfirstlane((int)(threadIdx.x >> 6)); F.G = gridDim.x; F.blk = blockIdx.x;
    const int lo = args.ph_lo, hi = args.ph_hi;
    if (threadIdx.x < 4) ((LAS unsigned*)(F.lds + XB_OFF))[threadIdx.x] = 0u;
    __syncthreads();
    XcdBarrier bar; bar.bar = F.ctl + CW_BAR; bar.x = 0; bar.st = (volatile LAS unsigned*)(F.lds + XB_OFF); bar.wave = F.wave;
    if (hi - lo > 1) bar = xcd_barrier_post(F.ctl + CW_BAR, (volatile LAS unsigned*)(F.lds + XB_OFF), F.wave);
    if (PH_IN(0)) phase_p0(F);
    PH_BAR(0);
    if (PH_IN(1)) phase_norm1_l0(F);
    PH_BAR(1);
    layer_program<0>(F, bar, lo, hi);
    layer_program<1>(F, bar, lo, hi);
    layer_program<2>(F, bar, lo, hi);
    layer_program<3>(F, bar, lo, hi);
}

#ifndef MK_PER_PHASE
#define MK_PER_PHASE 0
#endif
extern "C" void kernel_launch(void* const* d_in, const int* in_sizes, int n_in, void* d_out, int out_size, void* d_ws, size_t ws_size, hipStream_t stream) {
    static int grid = 0;
    if (grid == 0) {
        if (n_in != 27 || out_size != TLAT * D || ws_size < WS_END) { fprintf(stderr, "kernel_launch: unexpected problem shape (n_in %d, out %d, ws %zu < %zu)\n", n_in, out_size, ws_size, (size_t)WS_END); grid = -1; return; }
        int dev = 0, cus = 0, per_cu = 0;
        if (hipGetDevice(&dev) != hipSuccess || hipDeviceGetAttribute(&cus, hipDeviceAttributeMultiprocessorCount, dev) != hipSuccess) { grid = -1; return; }
        if (hipFuncSetAttribute((const void*)fwd_kernel, hipFuncAttributeMaxDynamicSharedMemorySize, LDS_BYTES) != hipSuccess) { fprintf(stderr, "kernel_launch: hipFuncSetAttribute failed\n"); grid = -1; return; }
        if (hipOccupancyMaxActiveBlocksPerMultiprocessor(&per_cu, (const void*)fwd_kernel, 512, LDS_BYTES) != hipSuccess || per_cu < 1) fprintf(stderr, "kernel_launch: occupancy query reports %d\n", per_cu);
        (void)hipGetLastError();
        grid = cus;
    }
    if (grid < 0) return;
    (void)hipMemsetAsync((char*)d_ws + WS_CTL, 0, CTL_ZERO_BYTES, stream);
    Args a{};
    for (int i = 0; i < 27; ++i) a.in[i] = (const float*)d_in[i];
    a.out = (float*)d_out; a.ws = (unsigned char*)d_ws;
#if MK_PER_PHASE
    for (int p = 0; p < N_PHASES; ++p) {
        const int l = (p - 2) / 10, q = (p - 2) % 10;
        if (p >= 2 && (((l & 1) && (q == 2 || q == 3)) || (l == DEPTH - 1 && q == 6))) continue;
        a.ph_lo = p; a.ph_hi = p + 1;
        hipLaunchKernelGGL(fwd_kernel, dim3(grid), dim3(512), LDS_BYTES, stream, a);
    }
#else
    a.ph_lo = 0; a.ph_hi = N_PHASES;
    hipLaunchKernelGGL(fwd_kernel, dim3(grid), dim3(512), LDS_BYTES, stream, a);
#endif
}
```

```cpp
#include <hip/hip_runtime.h>
#include <cstdio>
#include <cstdint>

#define LAS __attribute__((address_space(3)))
#define GAS __attribute__((address_space(1)))
#define DI __device__ __forceinline__
typedef unsigned short bf16_t;
typedef short bf16x8 __attribute__((ext_vector_type(8)));
typedef short s16x4 __attribute__((ext_vector_type(4)));
typedef float f32x2 __attribute__((ext_vector_type(2)));
typedef float f32x4 __attribute__((ext_vector_type(4)));
typedef float f32x16 __attribute__((ext_vector_type(16)));
typedef unsigned u32x2 __attribute__((ext_vector_type(2)));
typedef unsigned u32x4 __attribute__((ext_vector_type(4)));
typedef __bf16 bf16x2_t __attribute__((ext_vector_type(2)));

constexpr int D = 1024, NBATCH = 8, SEQ = 4096, CTXL = 256, DEPTH = 4;
constexpr int TLAT = NBATCH * SEQ, TCTX = NBATCH * CTXL, TALL = TLAT + TCTX;
constexpr int EVEN_IN = 3104, EVEN_LD = 3328, ODD_IN = 1280;
constexpr int NEXP = 32, TOPK = 4, DEXP = 1024;
constexpr int C_Q = 0, C_K = 256, C_V = 512, C_G = 1024, C_NQ = 1536, C_NK = 2048, C_NV = 2560, C_AF = 3072, C_AB = 3088;
DI size_t pidx(int tok, int col) { return ((size_t)(col >> 6) * TALL + tok) * 64 + (col & 63); }
constexpr int O_Q = 0, O_K = 1024, O_V = 1152;
constexpr float EPS = 1e-6f;
constexpr float LOG2E = 1.4426950408889634f;

constexpr size_t MiB = 1u << 20;
constexpr size_t WS_CTL = 0, CTL_ZERO_BYTES = 1 * MiB;
constexpr size_t WS_MODV = 1 * MiB;
constexpr size_t WS_WGU = 2 * MiB;
constexpr size_t WS_WDN = WS_WGU + 512 * MiB;
constexpr size_t WS_WINE = WS_WDN + 256 * MiB;
constexpr size_t WS_WINO = WS_WINE + 13 * MiB;
constexpr size_t WS_WOUT = WS_WINO + 5 * MiB;
constexpr size_t WS_X = WS_WOUT + 8 * MiB;
constexpr size_t WS_H = WS_X + 136 * MiB;
constexpr size_t WS_PRJ = WS_H + 68 * MiB;
constexpr size_t WS_OMIX = WS_PRJ + 221 * MiB;
constexpr size_t WS_ACT = WS_OMIX + 68 * MiB;
constexpr size_t WS_Y = WS_ACT + 288 * MiB;
constexpr size_t WS_LIST = WS_Y + 272 * MiB;
constexpr size_t WS_WTOK = WS_LIST + 5 * MiB;
constexpr size_t WS_GU = WS_WTOK + 5 * MiB;
constexpr size_t WS_GD = WS_GU + 136 * MiB;
constexpr size_t WS_GS = WS_GD + 2 * MiB;
constexpr size_t WS_GQ = WS_GS + 68 * MiB;
constexpr size_t WS_GK = WS_GQ + 34 * MiB;
constexpr size_t WS_RTB = WS_GK + 34 * MiB;
constexpr size_t WS_RTBIAS = WS_MODV + 917504;
constexpr size_t WS_END = WS_RTB + 5 * MiB;
static_assert(TALL * (size_t)D * 4 <= 136 * MiB && TALL * (size_t)EVEN_LD * 2 <= 221 * MiB && (size_t)TALL * 4 * D * 2 <= 272 * MiB, "ws map");
constexpr int CW_BAR = 4096;
constexpr int CW_DEP = 12288;
constexpr int CW_CNT = 8192;

constexpr int RING_BYTES = 131072;
constexpr int MISC_OFF = RING_BYTES;
constexpr int MISC_BYTES = 12288;
constexpr int LDS_BYTES = 9 * 16896 + 8192 + 1264 + 16;
constexpr int XB_OFF = LDS_BYTES - 16;
static_assert(MISC_OFF + MISC_BYTES <= XB_OFF && 9 * 16896 + 8192 <= XB_OFF && XB_OFF + 16 <= LDS_BYTES && LDS_BYTES <= 163840 && XB_OFF % 16 == 0, "LDS map");

DI unsigned f2bf(float f) { unsigned u = __builtin_bit_cast(unsigned, f); return (u + 0x7fffu + ((u >> 16) & 1u)) >> 16; }
DI unsigned pk2(float lo, float hi) { f32x2 v = {lo, hi}; bf16x2_t b = __builtin_convertvector(v, bf16x2_t); return __builtin_bit_cast(unsigned, b); }
DI float bflo(unsigned u) { return __builtin_bit_cast(float, u << 16); }
DI float bfhi(unsigned u) { return __builtin_bit_cast(float, u & 0xffff0000u); }
DI float bf2f(bf16_t b) { return __builtin_bit_cast(float, ((unsigned)b) << 16); }
DI float xhalf_max(float x) { float a = x, b = x; asm volatile("s_nop 1\n\tv_permlane32_swap_b32 %0, %1\n\ts_nop 1" : "+v"(a), "+v"(b)); return fmaxf(a, b); }
DI float xhalf_sum(float x) { float a = x, b = x; asm volatile("s_nop 1\n\tv_permlane32_swap_b32 %0, %1\n\ts_nop 1" : "+v"(a), "+v"(b)); return a + b; }
DI float dpp_xor1(float x) { return __builtin_bit_cast(float, __builtin_amdgcn_update_dpp(0, __builtin_bit_cast(int, x), 0xB1, 0xF, 0xF, true)); }
DI float dpp_xor2(float x) { return __builtin_bit_cast(float, __builtin_amdgcn_update_dpp(0, __builtin_bit_cast(int, x), 0x4E, 0xF, 0xF, true)); }
DI float dpp_hmirror(float x) { return __builtin_bit_cast(float, __builtin_amdgcn_update_dpp(0, __builtin_bit_cast(int, x), 0x141, 0xF, 0xF, true)); }
DI float dpp_rmirror(float x) { return __builtin_bit_cast(float, __builtin_amdgcn_update_dpp(0, __builtin_bit_cast(int, x), 0x140, 0xF, 0xF, true)); }
DI float half32_max(float x) {
    x = fmaxf(x, dpp_xor1(x)); x = fmaxf(x, dpp_xor2(x)); x = fmaxf(x, dpp_hmirror(x)); x = fmaxf(x, dpp_rmirror(x));
    float a = x, b = x; asm volatile("s_nop 1\n\tv_permlane16_swap_b32 %0, %1\n\ts_nop 1" : "+v"(a), "+v"(b));
    return fmaxf(a, b);
}
DI float wave_sum(float x) {
    x += dpp_xor1(x); x += dpp_xor2(x); x += dpp_hmirror(x); x += dpp_rmirror(x);
    float a = x, b = x; asm volatile("s_nop 1\n\tv_permlane16_swap_b32 %0, %1\n\ts_nop 1" : "+v"(a), "+v"(b));
    return xhalf_sum(a + b);
}
#define LDS_WAIT() asm volatile("s_waitcnt lgkmcnt(0)" ::: "memory")
#define VM_WAIT() asm volatile("s_waitcnt vmcnt(0)" ::: "memory")

#define XB_TMO      128
#define XB_XCNT(j)  (256  + 64 * (j))
#define XB_XSUB(j)  (1280 + 64 * (j))
#define XB_XGEN(j)  (2304 + 64 * (j))
#define XB_TOP      3328
#define XB_TOPGEN   3392
#define XCD_BAR_WORDS 3456
#define XB_SPIN_CAP (1u << 22)
DI unsigned xb_ld(unsigned* p)              { return __hip_atomic_load(p, __ATOMIC_RELAXED, __HIP_MEMORY_SCOPE_AGENT); }
DI unsigned xb_add(unsigned* p, unsigned v) { return __hip_atomic_fetch_add(p, v, __ATOMIC_RELAXED, __HIP_MEMORY_SCOPE_AGENT); }
DI unsigned xb_xcc_id() { return (unsigned)__builtin_amdgcn_s_getreg((3 << 11) | 20) & 0xFu; }
#define XB_SPIN(cond, bar) do { unsigned _sp = 0; while (cond) { __builtin_amdgcn_s_sleep(1); \
    if ((++_sp & 255u) == 0u) { if (xb_ld(&(bar)[XB_TMO])) break; if (_sp > XB_SPIN_CAP) { atomicAdd(&(bar)[XB_TMO], 1u); break; } } } } while (0)
struct XcdBarrier { unsigned* bar; unsigned x; volatile LAS unsigned* st; int wave; };
DI bool xb_first(int wave) { return wave == 0 && __builtin_amdgcn_mbcnt_hi(~0u, __builtin_amdgcn_mbcnt_lo(~0u, 0u)) == 0u; }
DI XcdBarrier xcd_barrier_post(unsigned* bar, volatile LAS unsigned* st, int wave) {
    XcdBarrier b; b.bar = bar; b.x = xb_xcc_id(); b.st = st; b.wave = wave;
    if (xb_first(wave)) (void)xb_add(&bar[XB_XCNT(b.x)], 1u);
    return b;
}
DI void xcd_barrier_complete(unsigned* bar, unsigned x, unsigned& nloc, unsigned& nx) {
    const unsigned G = gridDim.x * gridDim.y * gridDim.z;
    unsigned sum, cnt, mine, sp = 0u;
    for (;;) {
        sum = 0u; cnt = 0u; mine = 0u;
#pragma unroll
        for (unsigned j = 0; j < 16; ++j) { const unsigned c = xb_ld(&bar[XB_XCNT(j)]); sum += c; cnt += (c > 0u) ? 1u : 0u; mine = (j == x) ? c : mine; }
        if (sum == G) break;
        __builtin_amdgcn_s_sleep(1);
        if ((++sp & 255u) == 0u) { if (xb_ld(&bar[XB_TMO])) break; if (sp > XB_SPIN_CAP) { atomicAdd(&bar[XB_TMO], 1u); break; } }
    }
    nloc = mine > 0u ? mine : 1u; nx = cnt > 0u ? cnt : 1u;
}
DI void xcd_barrier(const XcdBarrier& b) {
    asm volatile("s_waitcnt vmcnt(0)" ::: "memory");
    __syncthreads();
    if (xb_first(b.wave)) {
        unsigned* bar = b.bar;
        __builtin_amdgcn_s_waitcnt(0);
        unsigned nloc = b.st[0], nx = b.st[1];
        if (nloc == 0u) { xcd_barrier_complete(bar, b.x, nloc, nx); b.st[0] = nloc; b.st[1] = nx; }
        const unsigned old = xb_add(&bar[XB_XSUB(b.x)], 1u);
        const unsigned gen = old / nloc;
        if (old + 1u == (gen + 1u) * nloc) {
            __builtin_amdgcn_fence(__ATOMIC_RELEASE, "agent");
            asm volatile("s_waitcnt vmcnt(0)" ::: "memory");
            const unsigned og = xb_add(&bar[XB_TOP], 1u);
            const unsigned tg = og / nx;
            if (og + 1u == (tg + 1u) * nx) xb_add(&bar[XB_TOPGEN], 1u);
            else XB_SPIN(xb_ld(&bar[XB_TOPGEN]) == tg, bar);
            __builtin_amdgcn_fence(__ATOMIC_ACQUIRE, "agent");
            xb_add(&bar[XB_XGEN(b.x)], 1u);
            asm volatile("s_waitcnt vmcnt(0)" ::: "memory");
        } else {
            XB_SPIN(xb_ld(&bar[XB_XGEN(b.x)]) == gen, bar);
            __builtin_amdgcn_fence(__ATOMIC_ACQUIRE, "agent");
            asm volatile("s_waitcnt vmcnt(0)" ::: "memory");
        }
    }
    __syncthreads();
}

DI void dep_signal(int wave, unsigned* ctr) {
    asm volatile("s_waitcnt vmcnt(0)" ::: "memory");
    __syncthreads();
    if (xb_first(wave)) { __builtin_amdgcn_fence(__ATOMIC_RELEASE, "agent"); asm volatile("s_waitcnt vmcnt(0)" ::: "memory"); (void)xb_add(ctr, 1u); }
}
DI void dep_wait(int wave, unsigned* ctr, unsigned target, unsigned* bar) {
    __syncthreads();
    if (xb_first(wave)) { XB_SPIN(xb_ld(ctr) < target, bar); __builtin_amdgcn_fence(__ATOMIC_ACQUIRE, "agent"); asm volatile("s_waitcnt vmcnt(0)" ::: "memory"); }
    __syncthreads();
}

namespace pg8 {
constexpr int BM = 256, BK = 64, HALF = 128, HTB = HALF * BK * 2, STAGE_BYTES = 8 * HTB, NXCD = 8, WGM = 8, KDIM = 1024, NT = KDIM / BK;
DI int lds_byte(int r, int c) { const int st = (r >> 4) * 2 + (c >> 5), rr = r & 15, cc = c & 31, ob = rr * 64 + cc * 2; return st * 1024 + (ob ^ (((ob >> 9) & 1) << 5)); }
DI void stage_rc(int b, int& R, int& C) { const int st = b / 1024, sb = b % 1024, swz = sb ^ (((sb >> 9) & 1) << 5); R = (st >> 1) * 16 + swz / 64; C = (st & 1) * 32 + (swz % 64) / 2; }
DI int perm32(int rho) { const int n = rho >> 4, i = rho & 15; return 8 * (i >> 2) + 4 * n + (i & 3); }

struct Unit { const char* A; const char* B; int r0, c0, e, nvalid; const int* gl; const float* wl; };
struct TileOrder {
    int nM, nN, nwg, G, c;
    DI void init(int nM_, int nN_, int G_, int c_) { nM = nM_; nN = nN_; nwg = nM * nN; G = G_; c = c_; }
    DI bool tile(int i, int& pm, int& pn) const {
        const long L = (long)i * G + c; if (L >= nwg) return false;
        int wgid = (int)L; { const int q = nwg / NXCD, r = nwg % NXCD, xcd = wgid % NXCD, off = wgid / NXCD; wgid = (xcd < r ? xcd * (q + 1) : r * (q + 1) + (xcd - r) * q) + off; }
        const int nig = WGM * nN, gid = wgid / nig, fm = gid * WGM, gsz = (nM - fm) < WGM ? (nM - fm) : WGM;
        pm = fm + ((wgid % nig) % gsz); pn = (wgid % nig) / gsz; return true;
    }
};

template <class Epi, class Sched, bool GATHER>
DI void gemm_phase(LAS unsigned char* lds, const Sched& S, const Epi& E, const int wave_sgpr, LAS unsigned* side) {
    int tid = wave_sgpr * 64 + (int)__builtin_amdgcn_mbcnt_hi(~0u, __builtin_amdgcn_mbcnt_lo(~0u, 0u)); asm volatile("" : "+v"(tid));
    const int wid = __builtin_amdgcn_readfirstlane(tid >> 6), lane = tid & 63, wr = wid >> 2, wc = wid & 3, fr = lane & 15, fq = lane >> 4;
    constexpr int K = KDIM, nt = NT;
    unsigned voffA, voffB;
    { int R, C; stage_rc(tid * 16, R, C); const int Rb = Epi::PERM ? ((R & ~31) + perm32(R & 31)) : R;
      voffA = GATHER ? (unsigned)(C * 2) : (unsigned)(R * K + C) * 2u; voffB = (unsigned)(Rb * K + C) * 2u; }
    constexpr size_t pstep = (size_t)64 * K * 2;
    constexpr size_t kstep = (size_t)(BK * 2);
    constexpr size_t hstep = (size_t)HALF * K * 2;
    const unsigned ldsw = (unsigned)wid * 1024u;
    const int aoff = lds_byte(wr * 64 + fr, fq * 8), boff = lds_byte(wc * 32 + fr, fq * 8);
#define PG8_SA(b, h) (((b) * 2 + (h)) * HTB)
#define PG8_SB(b, h) ((4 + (b) * 2 + (h)) * HTB)
#define PG8_STAGE(bufoff, gbase, voff) do { _Pragma("unroll") for (int _i = 0; _i < 2; ++_i) \
        __builtin_amdgcn_global_load_lds((const unsigned*)((const char*)(gbase) + (size_t)_i * pstep + (voff)), (LAS unsigned*)(lds + (bufoff) + ldsw + _i * 8192), 16, 0, 0); } while (0)
#define PG8_STAGE_A(bufoff, gbase, ko, h, go) do { _Pragma("unroll") for (int _i = 0; _i < 2; ++_i) \
        __builtin_amdgcn_global_load_lds((const unsigned*)((const char*)(gbase) + (ko) + (GATHER ? (size_t)(go)[h][_i] : (size_t)(h) * hstep + (size_t)_i * pstep) + voffA), (LAS unsigned*)(lds + (bufoff) + ldsw + _i * 8192), 16, 0, 0); } while (0)
#define PG8_LDA(dst, b, h) do { _Pragma("unroll") for (int m = 0; m < 4; ++m) _Pragma("unroll") for (int k = 0; k < 2; ++k) dst[m][k] = *(const LAS bf16x8*)(lds + PG8_SA(b, h) + aoff + m * 2048 + k * 1024); } while (0)
#define PG8_LDB(dst, b, h) do { _Pragma("unroll") for (int n = 0; n < 2; ++n) _Pragma("unroll") for (int k = 0; k < 2; ++k) dst[n][k] = *(const LAS bf16x8*)(lds + PG8_SB(b, h) + boff + n * 2048 + k * 1024); } while (0)
#define PG8_MMA(ai, bj, At, Bt) do { __builtin_amdgcn_s_setprio(1); _Pragma("unroll") for (int m = 0; m < 4; ++m) _Pragma("unroll") for (int n = 0; n < 2; ++n) _Pragma("unroll") for (int k = 0; k < 2; ++k) \
        acc[ai][bj][m][n] = __builtin_amdgcn_mfma_f32_16x16x32_bf16(Bt[n][k], At[m][k], acc[ai][bj][m][n], 0, 0, 0); __builtin_amdgcn_s_setprio(0); } while (0)
#define PG8_WAIT_V(n) asm volatile("s_waitcnt vmcnt(" #n ")" ::: "memory")
#define PG8_WAIT_L(n) asm volatile("s_waitcnt lgkmcnt(" #n ")" ::: "memory")
#define PG8_BAR __builtin_amdgcn_s_barrier()
#define PG8_SCHED __builtin_amdgcn_sched_barrier(0)
    Unit cur, nxt; int ui = 0;
    if (!S.next(0, cur)) return;
    f32x4 acc[2][2][4][2];
#pragma unroll
    for (int a = 0; a < 2; ++a)
#pragma unroll
        for (int b = 0; b < 2; ++b)
#pragma unroll
            for (int m = 0; m < 4; ++m)
#pragma unroll
                for (int n = 0; n < 2; ++n) acc[a][b][m][n] = (f32x4){0.f, 0.f, 0.f, 0.f};
    bf16x8 At[4][2], B0[2][2], B1[2][2];
    unsigned gc[2][2] = {{0u, 0u}, {0u, 0u}}, gn[2][2] = {{0u, 0u}, {0u, 0u}};
    if (GATHER) {
#pragma unroll
        for (int i = 0; i < 2; ++i) { int R, C; stage_rc(tid * 16 + i * 8192, R, C);
#pragma unroll
            for (int h = 0; h < 2; ++h) gc[h][i] = S.goff(cur, h * HALF + R); }
#pragma unroll
        for (int i = 0; i < 2; ++i)
#pragma unroll
            for (int h = 0; h < 2; ++h) gc[h][i] = Sched::gbytes(gc[h][i]);
    }
    const char* cA = cur.A; const char* cB = cur.B;
    PG8_STAGE(PG8_SB(0, 0), cB, voffB); PG8_STAGE(PG8_SB(0, 1), cB + hstep, voffB); PG8_STAGE_A(PG8_SA(0, 0), cA, 0, 0, gc); PG8_STAGE_A(PG8_SA(0, 1), cA, 0, 1, gc);
    if (wr == 1) PG8_BAR;
    PG8_WAIT_V(2); PG8_BAR;
    PG8_STAGE(PG8_SB(1, 0), cB + kstep, voffB); PG8_STAGE_A(PG8_SA(1, 0), cA, kstep, 0, gc); PG8_STAGE(PG8_SB(1, 1), cB + hstep + kstep, voffB);
    PG8_WAIT_V(6); PG8_BAR;
    for (;;) {
        LAS unsigned* side_u = side + (ui & 1) * 768;
        if (Epi::NSIDE > 0 && wid < 4) E.side_issue(cur, tid, side_u);
        const bool has_next = S.next(ui + 1, nxt);
        const char* nA = has_next ? nxt.A : cA; const char* nB = has_next ? nxt.B : cB;
        for (int t = 0; t < nt; t += 2) {
            const bool last = (t == nt - 2);
            if (GATHER && t == nt - 6) {
                int t2 = tid; asm volatile("" : "+v"(t2));
#pragma unroll
                for (int i = 0; i < 2; ++i) { int R, C; stage_rc(t2 * 16 + i * 8192, R, C);
#pragma unroll
                    for (int h = 0; h < 2; ++h) gn[h][i] = S.goff(has_next ? nxt : cur, h * HALF + R); }
            }
            const size_t k1 = (size_t)(t + 1) * kstep;
            const char* a2 = last ? nA : cA; const size_t ka2 = last ? 0 : (size_t)(t + 2) * kstep;
            const char* b2 = last ? nB : cB + (size_t)(t + 2) * kstep;
            const char* b3 = b2 + kstep;
            PG8_LDB(B0, 0, 0); PG8_LDB(B1, 0, 1); PG8_SCHED; PG8_LDA(At, 0, 0); PG8_STAGE_A(PG8_SA(1, 1), cA, k1, 1, gc);
            if (GATHER && last) {
#pragma unroll
                for (int h = 0; h < 2; ++h)
#pragma unroll
                    for (int i = 0; i < 2; ++i) gc[h][i] = Sched::gbytes(gn[h][i]);
            }
            PG8_WAIT_V(8); PG8_WAIT_L(0); PG8_BAR; PG8_MMA(0, 0, At, B0); PG8_MMA(0, 1, At, B1); PG8_BAR; PG8_SCHED;
            PG8_LDA(At, 0, 1); PG8_STAGE(PG8_SB(0, 0), b2, voffB); PG8_STAGE(PG8_SB(0, 1), b2 + hstep, voffB); PG8_STAGE_A(PG8_SA(0, 0), a2, ka2, 0, gc);
            PG8_WAIT_V(8); PG8_WAIT_L(0); PG8_BAR; PG8_MMA(1, 0, At, B0); PG8_MMA(1, 1, At, B1); PG8_BAR; PG8_SCHED;
            PG8_LDB(B0, 1, 0); PG8_LDB(B1, 1, 1); PG8_SCHED; PG8_LDA(At, 1, 0); PG8_STAGE_A(PG8_SA(0, 1), a2, ka2, 1, gc);
            PG8_WAIT_V(8); PG8_WAIT_L(0); PG8_BAR; PG8_MMA(0, 0, At, B0); PG8_MMA(0, 1, At, B1); PG8_BAR; PG8_SCHED;
            PG8_LDA(At, 1, 1); PG8_STAGE(PG8_SB(1, 0), b3, voffB); PG8_STAGE(PG8_SB(1, 1), b3 + hstep, voffB); PG8_STAGE_A(PG8_SA(1, 0), a2, ka2 + kstep, 0, gc);
            PG8_WAIT_V(8); PG8_WAIT_L(0); PG8_BAR; PG8_MMA(1, 0, At, B0); PG8_MMA(1, 1, At, B1); PG8_BAR; PG8_SCHED;
        }
        if (wr == 0) PG8_BAR;
        E(acc, cur, wr, wc, fr, fq, side_u);
        if (!has_next) break;
#pragma unroll
        for (int a = 0; a < 2; ++a)
#pragma unroll
            for (int b = 0; b < 2; ++b)
#pragma unroll
                for (int m = 0; m < 4; ++m)
#pragma unroll
                    for (int n = 0; n < 2; ++n) acc[a][b][m][n] = (f32x4){0.f, 0.f, 0.f, 0.f};
        cur = nxt; cA = nA; cB = nB; ++ui;
        if (wr == 1) PG8_BAR;
    }
    PG8_WAIT_V(0);
    PG8_BAR;
#undef PG8_SA
#undef PG8_SB
#undef PG8_STAGE
#undef PG8_STAGE_A
#undef PG8_LDA
#undef PG8_LDB
#undef PG8_MMA
#undef PG8_WAIT_V
#undef PG8_WAIT_L
#undef PG8_BAR
#undef PG8_SCHED
}
}

struct Frame {
    LAS unsigned char* lds;
    unsigned* ctl;
    unsigned char* ws;
    const float* const* in;
    float* out;
    int wave, G, blk;
};
DI int lane_id() { return (int)__builtin_amdgcn_mbcnt_hi(~0u, __builtin_amdgcn_mbcnt_lo(~0u, 0u)); }
DI const float* inp(const Frame& F, int i) {
    const unsigned long long v = (unsigned long long)F.in[i];
    const unsigned lo = __builtin_amdgcn_readfirstlane((unsigned)v), hi = __builtin_amdgcn_readfirstlane((unsigned)(v >> 32));
    return (const float*)(((unsigned long long)hi << 32) | lo);
}
DI float* modv(const Frame& F, int l, int r) { return (float*)(F.ws + WS_MODV) + ((size_t)l * 9 + r) * 6144; }
DI int bidx_of(int row) { return row < TLAT ? (row >> 12) : 8; }

struct CvtRegs { f32x4 v[16]; };
DI void convert_load(CvtRegs& R, const float* src, int ld, int nvalid, int lane) {
    const int c4 = (lane & 15) * 4, kr = lane >> 4;
#pragma unroll
    for (int i = 0; i < 16; ++i) R.v[i] = (c4 < nvalid) ? __builtin_nontemporal_load((const f32x4*)(src + (size_t)(kr + 4 * i) * ld + c4)) : (f32x4){0.f, 0.f, 0.f, 0.f};
}
DI void convert_store(const CvtRegs& R, int nvalid, bf16_t* dst, LAS float* scr, int lane, bf16_t* dst_hi = nullptr) {
    const int c4 = (lane & 15) * 4, kr = lane >> 4;
#pragma unroll
    for (int i = 0; i < 16; ++i) { LAS float* p = scr + (kr + 4 * i) * 65 + c4; p[0] = R.v[i][0]; p[1] = R.v[i][1]; p[2] = R.v[i][2]; p[3] = R.v[i][3]; }
    LDS_WAIT(); asm volatile("" ::: "memory");
#pragma unroll
    for (int j = 0; j < 8; ++j) {
        const int q = lane + 64 * j, n = q >> 3, c8 = q & 7;
        const LAS float* s = scr + (8 * c8) * 65 + n;
        u32x4 o; o.x = pk2(s[0], s[65]); o.y = pk2(s[2 * 65], s[3 * 65]); o.z = pk2(s[4 * 65], s[5 * 65]); o.w = pk2(s[6 * 65], s[7 * 65]);
        if (n < nvalid) __builtin_nontemporal_store(o, (u32x4*)(((dst_hi && n >= 32) ? dst_hi : dst) + (size_t)n * 1024 + 8 * c8));
    }
    LDS_WAIT(); asm volatile("" ::: "memory");
}
DI void convert_tile(const float* src, int ld, int nvalid, bf16_t* dst, LAS float* scr, int lane, bf16_t* dst_hi = nullptr) {
    CvtRegs R; convert_load(R, src, ld, nvalid, lane); convert_store(R, nvalid, dst, scr, lane, dst_hi);
}
DI float silu_f(float x) { return x / (1.f + __expf(-x)); }
DI void convert_moe_layer(const Frame& F, int l, int bidx, int nblk) {
    const int lane = lane_id();
    LAS float* scr = (LAS float*)(F.lds + F.wave * 16640);
    const int gw = bidx * 8 + F.wave, NGW = nblk * 8;
    constexpr int T_GU = 32 * 512, T_DN = 32 * 256;
    const float* gu = inp(F, 23) + (size_t)l * 32 * 1024 * 2048; const float* dn = inp(F, 25) + (size_t)l * 32 * 1024 * 1024;
    bf16_t* wgu = (bf16_t*)(F.ws + WS_WGU) + (size_t)l * 32 * 2048 * 1024; bf16_t* wdn = (bf16_t*)(F.ws + WS_WDN) + (size_t)l * 32 * 1024 * 1024;
    auto tsrc = [&](int t, int& ld) -> const float* { if (t < T_GU) { const int mat = t >> 9, kb = (t >> 5) & 15, nb = t & 31; ld = 2048; return gu + (size_t)mat * 1024 * 2048 + (size_t)(kb * 64) * 2048 + nb * 64; }
        const int r = t - T_GU, mat = r >> 8, kb = (r >> 4) & 15, nb = r & 15; ld = 1024; return dn + (size_t)mat * 1024 * 1024 + (size_t)(kb * 64) * 1024 + nb * 64; };
    auto tdst = [&](int t) -> bf16_t* { if (t < T_GU) { const int mat = t >> 9, kb = (t >> 5) & 15, nb = t & 31, n0 = nb * 64;
            const int drow = n0 < 1024 ? ((n0 >> 7) * 256 + (n0 & 127)) : ((((n0 - 1024) >> 7) * 256) + 128 + ((n0 - 1024) & 127));
            return wgu + (size_t)mat * 2048 * 1024 + (size_t)drow * 1024 + kb * 64; }
        const int r = t - T_GU, mat = r >> 8, kb = (r >> 4) & 15, nb = r & 15; return wdn + (size_t)mat * 1024 * 1024 + (size_t)(nb * 64) * 1024 + kb * 64; };
    constexpr int NT_ALL = T_GU + T_DN;
    CvtRegs RA, RB; int ld;
    if (gw < NT_ALL) { const float* sp = tsrc(gw, ld); convert_load(RA, sp, ld, 64, lane); }
    for (int t = gw; t < NT_ALL; t += 2 * NGW) {
        const int t1 = t + NGW, t2 = t + 2 * NGW;
        if (t1 < NT_ALL) { const float* sp = tsrc(t1, ld); convert_load(RB, sp, ld, 64, lane); }
        convert_store(RA, 64, tdst(t), scr, lane);
        if (t1 < NT_ALL) {
            if (t2 < NT_ALL) { const float* sp = tsrc(t2, ld); convert_load(RA, sp, ld, 64, lane); }
            convert_store(RB, 64, tdst(t1), scr, lane);
        }
    }
}
DI void convert_small(const Frame& F) {
    const int lane = lane_id();
    LAS float* scr = (LAS float*)(F.lds + F.wave * 16640);
    const int gw = F.blk * 8 + F.wave, NGW = F.G * 8;
    constexpr int T_WO = 4 * 256, T_WE = 2 * 16 * 49, T_WD = 2 * 16 * 20;
    for (int t = gw; t < T_WO + T_WE + T_WD; t += NGW) {
        int r = t;
        if (r < T_WO) { const int l = r >> 8, kb = (r >> 4) & 15, nb = r & 15; const float* src = ((l & 1) ? inp(F, 17) : inp(F, 9)) + (size_t)(l >> 1) * 1024 * 1024;
            convert_tile(src + (size_t)(kb * 64) * 1024 + nb * 64, 1024, 64, (bf16_t*)(F.ws + WS_WOUT) + (size_t)l * 1024 * 1024 + (size_t)(nb * 64) * 1024 + kb * 64, scr, lane); continue; }
        r -= T_WO;
        if (r < T_WE) { const int i = r / (16 * 49), q = r % (16 * 49), kb = q / 49, nb = q % 49; const int nv = (EVEN_IN - nb * 64) < 64 ? (EVEN_IN - nb * 64) : 64;
            const int n0 = nb * 64, d0 = n0 < 1536 ? n0 : (n0 == 1536 ? 3072 : n0 - 32), d1 = n0 == 1536 ? 1536 : d0 + 32;
            bf16_t* wb = (bf16_t*)(F.ws + WS_WINE) + (size_t)i * EVEN_LD * 1024 + kb * 64;
            convert_tile(inp(F, 8) + (size_t)i * 1024 * EVEN_IN + (size_t)(kb * 64) * EVEN_IN + n0, EVEN_IN, nv, wb + (size_t)d0 * 1024, scr, lane, wb + (size_t)(d1 - 32) * 1024); continue; }
        r -= T_WE;
        { const int i = r / (16 * 20), q = r % (16 * 20), kb = q / 20, nb = q % 20;
            convert_tile(inp(F, 16) + (size_t)i * 1024 * ODD_IN + (size_t)(kb * 64) * ODD_IN + nb * 64, ODD_IN, 64, (bf16_t*)(F.ws + WS_WINO) + (size_t)i * ODD_IN * 1024 + (size_t)(nb * 64) * 1024 + kb * 64, scr, lane); }
    }
}
DI void phase_p0(const Frame& F) {
    const int lane = lane_id(), tid = F.wave * 64 + lane; (void)tid; (void)lane;
    for (int item = F.blk; item < 192; item += F.G) {
        const int l = item / 48, cc = item % 48;
        LAS float* sil = (LAS float*)F.lds;
        LAS float* part = (LAS float*)(F.lds + 36864);
        for (int i = tid; i < 9 * 1024; i += 512) { const int r = i >> 10, k = i & 1023; const float c = r < 8 ? inp(F, 1)[r * 1024 + k] : inp(F, 3)[k]; sil[i] = silu_f(c); }
        __syncthreads();
        const float* W = inp(F, 4) + (size_t)l * 1024 * 6144 + cc * 128 + 2 * lane;
        f32x2 acc[9];
#pragma unroll
        for (int r = 0; r < 9; ++r) acc[r] = (f32x2){0.f, 0.f};
#pragma unroll 1
        for (int k0 = 128 * F.wave; k0 < 128 * F.wave + 128; k0 += 32) {
            f32x2 wv[32];
#pragma unroll
            for (int i = 0; i < 32; ++i) wv[i] = __builtin_nontemporal_load((const f32x2*)(W + (size_t)(k0 + i) * 6144));
#pragma unroll
            for (int i = 0; i < 32; ++i)
#pragma unroll
                for (int r = 0; r < 9; ++r) { const float s = sil[r * 1024 + k0 + i]; acc[r] += wv[i] * s; }
        }
#pragma unroll
        for (int r = 0; r < 9; ++r) *(LAS f32x2*)(part + (F.wave * 9 + r) * 128 + 2 * lane) = acc[r];
        __syncthreads();
        for (int i = tid; i < 9 * 128; i += 512) { const int r = i >> 7, c = i & 127; float s = 0.f;
#pragma unroll
            for (int w = 0; w < 8; ++w) s += part[(w * 9 + r) * 128 + c];
            modv(F, l, r)[cc * 128 + c] = s + inp(F, 5)[l * 6144 + cc * 128 + c]; }
        __syncthreads();
    }
    convert_small(F);
}

DI void norm_mod_store(const f32x4 (&v)[4], float rs, const float* gam, const float* mv_sh, const float* mv_sc, bf16_t* orow, int lane) {
#pragma unroll
    for (int j = 0; j < 4; ++j) {
        const int c = 4 * lane + 256 * j;
        const f32x4 g = *(const f32x4*)(gam + c), sc = *(const f32x4*)(mv_sc + c), sh = *(const f32x4*)(mv_sh + c);
        const f32x4 h = v[j] * rs * g * (sc + 1.0f) + sh;
        u32x2 o; o.x = pk2(h[0], h[1]); o.y = pk2(h[2], h[3]);
        *(u32x2*)(orow + c) = o;
    }
}
DI void phase_norm1_l0(const Frame& F) {
    const int lane = lane_id(), tid = F.wave * 64 + lane; (void)tid; (void)lane;
    {
        unsigned short* rtb = (unsigned short*)(F.ws + WS_RTB); float* rtbias = (float*)(F.ws + WS_RTBIAS);
        const float* gam2 = inp(F, 7); const float* wr_all = inp(F, 21); const float* br_all = inp(F, 22);
        const int gt = F.blk * 512 + tid, NGT = F.G * 512;
        for (int i = gt; i < 4 * 9 * 1024 * 32; i += NGT) { const int e = i & 31, k = (i >> 5) & 1023, lb = i >> 15, l = lb / 9, b = lb % 9;
            const float v = gam2[l * D + k] * (1.0f + modv(F, l, b)[4096 + k]) * wr_all[((size_t)l * D + k) * NEXP + e];
            const unsigned hi = pk2(v, 0.f) & 0xffffu, lo = pk2(v - bflo(hi), 0.f) & 0xffffu;
            unsigned short* o = rtb + (((size_t)lb * 128 + (k >> 3)) * 32 + e) * 16 + (k & 7); o[0] = (unsigned short)hi; o[8] = (unsigned short)lo; }
        LAS float* red = (LAS float*)F.lds;
        for (int item = F.blk; item < 36; item += F.G) {
            const int l = item / 9, b = item % 9, e = tid & 31, part = tid >> 5; const float* sh = modv(F, l, b) + 3072 + part * 64; const float* wr = wr_all + ((size_t)l * D + part * 64) * NEXP + e;
            float a0 = 0.f, a1 = 0.f, a2 = 0.f, a3 = 0.f;
#pragma unroll 4
            for (int k = 0; k < 64; k += 4) { a0 += sh[k] * wr[(size_t)k * NEXP]; a1 += sh[k + 1] * wr[(size_t)(k + 1) * NEXP]; a2 += sh[k + 2] * wr[(size_t)(k + 2) * NEXP]; a3 += sh[k + 3] * wr[(size_t)(k + 3) * NEXP]; }
            red[part * 32 + e] = (a0 + a1) + (a2 + a3);
            __syncthreads();
            if (tid < 32) { float sacc = 0.f;
#pragma unroll
                for (int q = 0; q < 16; ++q) sacc += red[q * 32 + tid];
                rtbias[(l * 9 + b) * NEXP + tid] = sacc + br_all[l * NEXP + tid]; }
            __syncthreads();
        }
    }
    const int gw = F.blk * 8 + F.wave, NGW = F.G * 8;
    bf16_t* H = (bf16_t*)(F.ws + WS_H);
    for (int row = gw; row < TALL; row += NGW) {
        const float* xr = row < TLAT ? inp(F, 0) + (size_t)row * D : inp(F, 2) + (size_t)(row - TLAT) * D;
        f32x4 v[4]; float s = 0.f;
#pragma unroll
        for (int j = 0; j < 4; ++j) { v[j] = *(const f32x4*)(xr + 4 * lane + 256 * j); s += (v[j][0] * v[j][0] + v[j][1] * v[j][1]) + (v[j][2] * v[j][2] + v[j][3] * v[j][3]); }
        const float rs = 1.0f / sqrtf(wave_sum(s) * (1.f / D) + EPS);
        const float* mv = modv(F, 0, bidx_of(row));
        norm_mod_store(v, rs, inp(F, 6), mv, mv + 1024, H + (size_t)row * D, lane);
    }
}
DI void phase_combine(const Frame& F, int l) {
    const int lane = lane_id(), tid = F.wave * 64 + lane; (void)tid; (void)lane;
    const int gw = F.blk * 8 + F.wave, NGW = F.G * 8;
    const int nrows = l < DEPTH - 1 ? TALL : TLAT;
    bf16_t* X = (bf16_t*)(F.ws + WS_X); bf16_t* H = (bf16_t*)(F.ws + WS_H); const bf16_t* Y = (const bf16_t*)(F.ws + WS_Y);
    const int r_lo = (int)(((long)gw * nrows) / NGW), r_hi = (int)(((long)(gw + 1) * nrows) / NGW);
    f32x4 g2v[4], gmv[4], shv[4]; int cur_b = -1;
#pragma unroll
    for (int j = 0; j < 4; ++j) { g2v[j] = (f32x4){0.f, 0.f, 0.f, 0.f}; gmv[j] = g2v[j]; shv[j] = g2v[j]; }
    for (int row = r_lo; row < r_hi; ++row) {
        const int b = bidx_of(row);
        if (b != cur_b) {
            cur_b = b;
            const float* g2 = modv(F, l, b) + 5120;
#pragma unroll
            for (int j = 0; j < 4; ++j) g2v[j] = *(const f32x4*)(g2 + 4 * lane + 256 * j);
            if (l < DEPTH - 1) { const float* mv = modv(F, l + 1, b); const float* gam = inp(F, 6) + (l + 1) * D;
#pragma unroll
                for (int j = 0; j < 4; ++j) { const int c = 4 * lane + 256 * j; gmv[j] = *(const f32x4*)(gam + c) * (*(const f32x4*)(mv + 1024 + c) + 1.0f); shv[j] = *(const f32x4*)(mv + c); } }
        }
        f32x4 v[4]; float s = 0.f;
#pragma unroll
        for (int j = 0; j < 4; ++j) {
            const int c = 4 * lane + 256 * j;
            f32x4 y = (f32x4){0.f, 0.f, 0.f, 0.f};
#pragma unroll
            for (int k = 0; k < 4; ++k) { const u32x2 w = __builtin_nontemporal_load((const u32x2*)(Y + ((size_t)row * 4 + k) * D + c)); y += (f32x4){bflo(w.x), bfhi(w.x), bflo(w.y), bfhi(w.y)}; }
            const u32x2 xw = *(const u32x2*)(X + (size_t)row * D + c);
            v[j] = (f32x4){bflo(xw.x), bfhi(xw.x), bflo(xw.y), bfhi(xw.y)} + g2v[j] * y;
            s += (v[j][0] * v[j][0] + v[j][1] * v[j][1]) + (v[j][2] * v[j][2] + v[j][3] * v[j][3]);
        }
        if (l == DEPTH - 1) {
#pragma unroll
            for (int j = 0; j < 4; ++j) *(f32x4*)(F.out + (size_t)row * D + 4 * lane + 256 * j) = v[j];
        } else {
#pragma unroll
            for (int j = 0; j < 4; ++j) { u32x2 o; o.x = pk2(v[j][0], v[j][1]); o.y = pk2(v[j][2], v[j][3]); *(u32x2*)(X + (size_t)row * D + 4 * lane + 256 * j) = o; }
            const float rs = 1.0f / sqrtf(wave_sum(s) * (1.f / D) + EPS);
#pragma unroll
            for (int j = 0; j < 4; ++j) { const f32x4 hv = v[j] * rs * gmv[j] + shv[j]; u32x2 o; o.x = pk2(hv[0], hv[1]); o.y = pk2(hv[2], hv[3]); *(u32x2*)(H + (size_t)row * D + 4 * lane + 256 * j) = o; }
        }
    }
}

struct DenseSched {
    pg8::TileOrder ord; const char* A; const char* B; int pm0 = 0;
    DI bool next(int i, pg8::Unit& u) const { int pm, pn; if (!ord.tile(i, pm, pn)) return false; pm += pm0;
        u.A = A + (size_t)pm * 256 * 2048; u.B = B + (size_t)pn * 256 * 2048; u.r0 = pm * 256; u.c0 = pn * 256; u.e = 0; u.nvalid = 256; u.gl = nullptr; u.wl = nullptr; return true; }
    DI unsigned goff(const pg8::Unit&, int) const { return 0u; }
    static DI unsigned gbytes(unsigned e) { return e; }
};
struct MoeTables { const LAS int* tstart; const LAS int* cnt; };
DI void moe_tables_build(const Frame& F, int l, LAS int* tstart, LAS int* cnt) {
    const int lane = lane_id(), tid = F.wave * 64 + lane;
    if (tid < 64) {
        const int c = lane < NEXP ? (int)F.ctl[CW_CNT + 64 * l + lane] : 0; const int tiles = (c + 255) >> 8;
        int incl = tiles;
#pragma unroll
        for (int o = 1; o < 32; o <<= 1) { const int v = __shfl_up(incl, o); if (lane >= o) incl += v; }
        if (lane < NEXP) { cnt[lane] = c; tstart[lane] = incl - tiles; }
        if (lane == NEXP - 1) tstart[NEXP] = incl;
    }
    __syncthreads();
}
template <bool GATEUP> struct MoeSched {
    pg8::TileOrder ord; MoeTables T; const char* A; const char* W; const int* list; const float* wlist;
    DI bool next(int i, pg8::Unit& u) const { int mtg, pn; if (!ord.tile(i, mtg, pn)) return false;
        int e = 0;
#pragma unroll
        for (int s = 16; s >= 1; s >>= 1) { if (T.tstart[e + s] <= mtg) e += s; }
        const int mt = mtg - T.tstart[e];
        u.e = e; u.nvalid = T.cnt[e] - mt * 256; if (u.nvalid > 256) u.nvalid = 256; u.gl = list + (size_t)e * TALL + mt * 256; u.wl = wlist + (size_t)e * TALL + mt * 256; u.r0 = mtg * 256;
        if (GATEUP) { u.A = A; u.B = W + (size_t)e * (2048 * 2048) + (size_t)pn * 256 * 2048; u.c0 = pn * 128; }
        else { u.A = A + (size_t)mtg * 256 * 2048; u.B = W + (size_t)e * (1024 * 2048) + (size_t)pn * 256 * 2048; u.c0 = pn * 256; }
        return true; }
    DI unsigned goff(const pg8::Unit& u, int row) const { const int r = row < u.nvalid ? row : 0; return (unsigned)u.gl[r]; }
    static DI unsigned gbytes(unsigned entry) { return (entry >> 2) * 2048u; }
};

DI void dma4(const void* g, LAS unsigned* dst_wave_base) { __builtin_amdgcn_global_load_lds((const unsigned*)g, dst_wave_base, 4, 0, 0); }
struct EpiPrj {
    static constexpr bool PERM = true; static constexpr int NSIDE = 0;
    DI void side_issue(const pg8::Unit&, int, LAS unsigned*) const {}
    bf16_t* O; int ldc;
    DI void operator()(const f32x4 (&acc)[2][2][4][2], const pg8::Unit& u, int wr, int wc, int fr, int fq, const LAS unsigned*) const {
        const int row0 = u.r0 + wr * 64 + fr, col0 = u.c0 + wc * 32 + 8 * fq;
#pragma unroll
        for (int ai = 0; ai < 2; ++ai)
#pragma unroll
            for (int m = 0; m < 4; ++m) { const int row = row0 + ai * 128 + m * 16;
#pragma unroll
                for (int bj = 0; bj < 2; ++bj) { const f32x4 v0 = acc[ai][bj][m][0], v1 = acc[ai][bj][m][1];
                    u32x4 w; w.x = pk2(v0[0], v0[1]); w.y = pk2(v0[2], v0[3]); w.z = pk2(v1[0], v1[1]); w.w = pk2(v1[2], v1[3]);
                    *(u32x4*)(O + pidx(row, col0 + bj * 128)) = w; } }
    }
};
template <bool XF32> struct EpiRes {
    static constexpr bool PERM = true; static constexpr int NSIDE = 1;
    const float* xlat; const float* xctx; bf16_t* X; const float* gate;
    DI void side_issue(const pg8::Unit& u, int t, LAS unsigned* side) const { dma4(gate + (size_t)bidx_of(u.r0) * 6144 + u.c0 + t, side + (t & ~63)); }
    DI void operator()(const f32x4 (&acc)[2][2][4][2], const pg8::Unit& u, int wr, int wc, int fr, int fq, const LAS unsigned* side) const {
        const int row0 = u.r0 + wr * 64 + fr, col0 = u.c0 + wc * 32 + 8 * fq;
        const float* xin = u.r0 < TLAT ? xlat : xctx - (size_t)TLAT * D;
        f32x4 gv[2][2];
#pragma unroll
        for (int bj = 0; bj < 2; ++bj)
#pragma unroll
            for (int n = 0; n < 2; ++n) gv[bj][n] = *(const LAS f32x4*)(side + wc * 32 + 8 * fq + bj * 128 + n * 4);
#pragma unroll
        for (int ai = 0; ai < 2; ++ai) {
            if (XF32) {
                f32x4 xv[4][2][2];
#pragma unroll
                for (int m = 0; m < 4; ++m) { const size_t off = (size_t)(row0 + ai * 128 + m * 16) * D + col0;
#pragma unroll
                    for (int bj = 0; bj < 2; ++bj)
#pragma unroll
                        for (int n = 0; n < 2; ++n) xv[m][bj][n] = *(const f32x4*)(xin + off + bj * 128 + n * 4); }
                asm volatile("" : "+v"(xv[0][0][0]), "+v"(xv[0][0][1]), "+v"(xv[0][1][0]), "+v"(xv[0][1][1]), "+v"(xv[1][0][0]), "+v"(xv[1][0][1]), "+v"(xv[1][1][0]), "+v"(xv[1][1][1]));
                asm volatile("" : "+v"(xv[2][0][0]), "+v"(xv[2][0][1]), "+v"(xv[2][1][0]), "+v"(xv[2][1][1]), "+v"(xv[3][0][0]), "+v"(xv[3][0][1]), "+v"(xv[3][1][0]), "+v"(xv[3][1][1]));
#pragma unroll
                for (int m = 0; m < 4; ++m) { const size_t off = (size_t)(row0 + ai * 128 + m * 16) * D + col0;
#pragma unroll
                    for (int bj = 0; bj < 2; ++bj) { const f32x4 r0 = xv[m][bj][0] + gv[bj][0] * acc[ai][bj][m][0], r1 = xv[m][bj][1] + gv[bj][1] * acc[ai][bj][m][1];
                        u32x4 w; w.x = pk2(r0[0], r0[1]); w.y = pk2(r0[2], r0[3]); w.z = pk2(r1[0], r1[1]); w.w = pk2(r1[2], r1[3]);
                        *(u32x4*)(X + off + bj * 128) = w; } }
            } else {
                u32x4 xb[4][2];
#pragma unroll
                for (int m = 0; m < 4; ++m) { const size_t off = (size_t)(row0 + ai * 128 + m * 16) * D + col0;
#pragma unroll
                    for (int bj = 0; bj < 2; ++bj) xb[m][bj] = *(const u32x4*)(X + off + bj * 128); }
                asm volatile("" : "+v"(xb[0][0]), "+v"(xb[0][1]), "+v"(xb[1][0]), "+v"(xb[1][1]), "+v"(xb[2][0]), "+v"(xb[2][1]), "+v"(xb[3][0]), "+v"(xb[3][1]));
#pragma unroll
                for (int m = 0; m < 4; ++m) { const size_t off = (size_t)(row0 + ai * 128 + m * 16) * D + col0;
#pragma unroll
                    for (int bj = 0; bj < 2; ++bj) { const u32x4 x = xb[m][bj];
                        const f32x4 r0 = (f32x4){bflo(x.x), bfhi(x.x), bflo(x.y), bfhi(x.y)} + gv[bj][0] * acc[ai][bj][m][0], r1 = (f32x4){bflo(x.z), bfhi(x.z), bflo(x.w), bfhi(x.w)} + gv[bj][1] * acc[ai][bj][m][1];
                        u32x4 w; w.x = pk2(r0[0], r0[1]); w.y = pk2(r0[2], r0[3]); w.z = pk2(r1[0], r1[1]); w.w = pk2(r1[2], r1[3]);
                        *(u32x4*)(X + off + bj * 128) = w; } }
            }
        }
    }
};
struct EpiSwiglu {
    static constexpr bool PERM = true; static constexpr int NSIDE = 1;
    bf16_t* ACT; const float* bgu;
    DI void side_issue(const pg8::Unit& u, int t, LAS unsigned* side) const { dma4(bgu + (size_t)u.e * 2048 + u.c0 + (t < 128 ? t : 1024 + t - 128), side + (t & ~63)); }
    DI void operator()(const f32x4 (&acc)[2][2][4][2], const pg8::Unit& u, int wr, int wc, int fr, int fq, const LAS unsigned* side) const {
        const int row0 = u.r0 + wr * 64 + fr, lc = wc * 32 + 8 * fq;
        f32x4 bgl[2], bli[2];
#pragma unroll
        for (int n = 0; n < 2; ++n) { bgl[n] = *(const LAS f32x4*)(side + lc + 4 * n); bli[n] = *(const LAS f32x4*)(side + 128 + lc + 4 * n); }
#pragma unroll
        for (int ai = 0; ai < 2; ++ai)
#pragma unroll
            for (int m = 0; m < 4; ++m) {
                float o[8];
#pragma unroll
                for (int n = 0; n < 2; ++n)
#pragma unroll
                    for (int j = 0; j < 4; ++j) {
                        float g = acc[ai][0][m][n][j] + bgl[n][j], li = acc[ai][1][m][n][j] + bli[n][j];
                        g = fminf(g, 7.0f); li = fminf(fmaxf(li, -7.0f), 7.0f);
                        const float sg = __builtin_amdgcn_rcpf(1.0f + __expf(-1.702f * g));
                        o[4 * n + j] = g * sg * (li + 1.0f);
                    }
                u32x4 w; w.x = pk2(o[0], o[1]); w.y = pk2(o[2], o[3]); w.z = pk2(o[4], o[5]); w.w = pk2(o[6], o[7]);
                *(u32x4*)(ACT + (size_t)(row0 + ai * 128 + m * 16) * 1024 + u.c0 + lc) = w;
            }
    }
};
struct EpiDown {
    static constexpr bool PERM = true; static constexpr int NSIDE = 3;
    bf16_t* Y; const float* bdn;
    DI void side_issue(const pg8::Unit& u, int t, LAS unsigned* side) const {
        const int r = t < u.nvalid ? t : 0;
        dma4(u.gl + r, side + (t & ~63)); dma4(u.wl + r, side + 256 + (t & ~63)); dma4(bdn + (size_t)u.e * 1024 + u.c0 + t, side + 512 + (t & ~63)); }
    DI void operator()(const f32x4 (&acc)[2][2][4][2], const pg8::Unit& u, int wr, int wc, int fr, int fq, const LAS unsigned* side) const {
        const int rl0 = wr * 64 + fr, lc = wc * 32 + 8 * fq, col0 = u.c0 + lc;
        f32x4 bv[2][2];
#pragma unroll
        for (int bj = 0; bj < 2; ++bj)
#pragma unroll
            for (int n = 0; n < 2; ++n) bv[bj][n] = *(const LAS f32x4*)(side + 512 + lc + bj * 128 + 4 * n);
#pragma unroll
        for (int ai = 0; ai < 2; ++ai)
#pragma unroll
            for (int m = 0; m < 4; ++m) {
                const int r = rl0 + ai * 128 + m * 16; const int ent = (int)side[r]; const float w = __builtin_bit_cast(float, side[256 + r]);
                if (r < u.nvalid) { bf16_t* rowp = Y + (size_t)ent * 1024 + col0;
#pragma unroll
                    for (int bj = 0; bj < 2; ++bj) { const f32x4 v0 = (acc[ai][bj][m][0] + bv[bj][0]) * w, v1 = (acc[ai][bj][m][1] + bv[bj][1]) * w;
                        u32x4 o; o.x = pk2(v0[0], v0[1]); o.y = pk2(v0[2], v0[3]); o.z = pk2(v1[0], v1[1]); o.w = pk2(v1[2], v1[3]);
                        *(u32x4*)(rowp + bj * 128) = o; } }
            }
    }
};

DI void phase_router(const Frame& F, int l, int grp_begin, int grp_end) {
    const int lane = lane_id(), tid = F.wave * 64 + lane;
    const int ngroups = grp_end - grp_begin;
    const bf16_t* __restrict__ X = (const bf16_t*)(F.ws + WS_X); bf16_t* __restrict__ Hh = (bf16_t*)(F.ws + WS_H);
    const float* gam = inp(F, 7) + l * D;
    LAS float* P = (LAS float*)F.lds;
    LAS float* SSq = (LAS float*)(F.lds + 32768);
    LAS int* cntL = (LAS int*)(F.lds + 36864 + 128);
    LAS int* baseL = (LAS int*)(F.lds + 36864 + 256);
    LAS int* entE = (LAS int*)(F.lds + 40960);
    LAS float* entW = (LAS float*)(F.lds + 40960 + 16384);
    LAS int* entT = (LAS int*)(F.lds + 40960 + 32768);
    if (tid < 32) cntL[tid] = 0;
    const int e_l = lane & 31, kk = lane >> 5;
    const int kbase = 128 * F.wave + 64 * kk;
    u32x4 Bh[8], Bl[8]; float bias_e = 0.f; int cur_b = -1;
#pragma unroll
    for (int s = 0; s < 8; ++s) { Bh[s] = (u32x4){0u, 0u, 0u, 0u}; Bl[s] = (u32x4){0u, 0u, 0u, 0u}; }
    __syncthreads();
    LAS float* RSQ = SSq;
    LAS unsigned char* XI = F.lds + 90112;
    float gc[2][8], hs[2][8];
#pragma unroll
    for (int cs = 0; cs < 2; ++cs)
#pragma unroll
        for (int j = 0; j < 8; ++j) { gc[cs][j] = 0.f; hs[cs][j] = 0.f; }
    int nent = 0, par = 0;
    const int g_lo = grp_begin + (int)(((long)F.blk * ngroups) / F.G), g_hi = grp_begin + (int)(((long)(F.blk + 1) * ngroups) / F.G);
    for (int g = g_lo; g < g_hi; ++g) {
        const int t0 = g * 32, b = bidx_of(t0);
        u32x4 stg[8];
#pragma unroll
        for (int pc = 0; pc < 8; ++pc) stg[pc] = __builtin_nontemporal_load((const u32x4*)(X + (size_t)(t0 + 4 * F.wave + (pc >> 1)) * D + ((pc & 1) * 64 + lane) * 8));
        if (b != cur_b) {
            cur_b = b;
            const bf16_t* bp = (const bf16_t*)(F.ws + WS_RTB) + (((size_t)(l * 9 + b) * 128 + (kbase >> 3)) * 32 + e_l) * 16;
#pragma unroll
            for (int s = 0; s < 8; ++s) { Bh[s] = *(const u32x4*)(bp + s * 512); Bl[s] = *(const u32x4*)(bp + s * 512 + 8); }
            bias_e = ((const float*)(F.ws + WS_RTBIAS))[(l * 9 + b) * NEXP + e_l];
            const float* mv = modv(F, l, b);
#pragma unroll
            for (int cs = 0; cs < 2; ++cs) { const int col = (cs * 64 + lane) * 8;
#pragma unroll
                for (int hf = 0; hf < 2; ++hf) { const f32x4 gg = *(const f32x4*)(gam + col + 4 * hf), cc = *(const f32x4*)(mv + 4096 + col + 4 * hf), hh = *(const f32x4*)(mv + 3072 + col + 4 * hf);
#pragma unroll
                    for (int j = 0; j < 4; ++j) { gc[cs][4 * hf + j] = gg[j] * (cc[j] + 1.0f); hs[cs][4 * hf + j] = hh[j]; } } }
        }
        float rsum[4];
#pragma unroll
        for (int r4 = 0; r4 < 4; ++r4) { const int row = 4 * F.wave + r4; float ssq = 0.f;
#pragma unroll
            for (int pp = 0; pp < 2; ++pp) { const u32x4 w = stg[2 * r4 + pp];
                const float x0 = bflo(w.x), x1 = bfhi(w.x), x2 = bflo(w.y), x3 = bfhi(w.y), x4 = bflo(w.z), x5 = bfhi(w.z), x6 = bflo(w.w), x7 = bfhi(w.w);
                ssq += ((x0 * x0 + x1 * x1) + (x2 * x2 + x3 * x3)) + ((x4 * x4 + x5 * x5) + (x6 * x6 + x7 * x7));
                *(LAS u32x4*)(XI + row * 2048 + (((pp * 64 + lane) ^ (row & 15)) << 4)) = w; }
            rsum[r4] = wave_sum(ssq); }
        if (lane == 0) { RSQ[par * 32 + 4 * F.wave + 0] = rsum[0]; RSQ[par * 32 + 4 * F.wave + 1] = rsum[1]; RSQ[par * 32 + 4 * F.wave + 2] = rsum[2]; RSQ[par * 32 + 4 * F.wave + 3] = rsum[3]; }
        __syncthreads();
        f32x16 acc;
#pragma unroll
        for (int i = 0; i < 16; ++i) acc[i] = 0.f;
#pragma unroll
        for (int q = 0; q < 8; ++q) {
            const u32x4 xq = *(const LAS u32x4*)(XI + e_l * 2048 + (((16 * F.wave + 8 * kk + q) ^ (e_l & 15)) << 4));
            acc = __builtin_amdgcn_mfma_f32_32x32x16_bf16(__builtin_bit_cast(bf16x8, xq), __builtin_bit_cast(bf16x8, Bh[q]), acc, 0, 0, 0);
            acc = __builtin_amdgcn_mfma_f32_32x32x16_bf16(__builtin_bit_cast(bf16x8, xq), __builtin_bit_cast(bf16x8, Bl[q]), acc, 0, 0, 0);
        }
#pragma unroll
        for (int r = 0; r < 16; ++r) { const int i = (r & 3) + 8 * (r >> 2) + 4 * kk; P[(F.wave * 32 + i) * 32 + e_l] = acc[r]; }
#pragma unroll
        for (int pc = 0; pc < 8; ++pc) { const int row = 4 * F.wave + (pc >> 1), cs = pc & 1; const u32x4 w = stg[pc];
            const float rs = 1.0f / sqrtf(RSQ[par * 32 + row] * (1.f / D) + EPS);
            u32x4 o; o.x = pk2(bflo(w.x) * rs * gc[cs][0] + hs[cs][0], bfhi(w.x) * rs * gc[cs][1] + hs[cs][1]); o.y = pk2(bflo(w.y) * rs * gc[cs][2] + hs[cs][2], bfhi(w.y) * rs * gc[cs][3] + hs[cs][3]);
            o.z = pk2(bflo(w.z) * rs * gc[cs][4] + hs[cs][4], bfhi(w.z) * rs * gc[cs][5] + hs[cs][5]); o.w = pk2(bflo(w.w) * rs * gc[cs][6] + hs[cs][6], bfhi(w.w) * rs * gc[cs][7] + hs[cs][7]);
            *(u32x4*)(Hh + (size_t)(t0 + row) * D + (cs * 64 + lane) * 8) = o; }
        __syncthreads();
#pragma unroll 1
        for (int pass = 0; pass < 2; ++pass) {
            const int ti = 4 * F.wave + 2 * pass + kk;
            float v = 0.f, tot = 0.f;
#pragma unroll
            for (int w = 0; w < 8; ++w) v += P[(w * 32 + ti) * 32 + e_l];
            tot = RSQ[par * 32 + ti];
            v = (1.0f / sqrtf(tot * (1.f / D) + EPS)) * v + bias_e;
            float tv[4]; int te[4];
#pragma unroll
            for (int k = 0; k < 4; ++k) {
                const float m = half32_max(v);
                const unsigned long long bal = __ballot(v == m);
                const unsigned half = (unsigned)(bal >> (32 * kk));
                const int idx = __builtin_ctz(half);
                tv[k] = m; te[k] = idx;
                if (e_l == idx) v = -3.0e38f;
            }
            const float e1 = __expf(tv[1] - tv[0]), e2 = __expf(tv[2] - tv[0]), e3 = __expf(tv[3] - tv[0]);
            const float inv = 1.0f / (1.0f + e1 + e2 + e3);
            const float wk[4] = {inv, e1 * inv, e2 * inv, e3 * inv};
            if (e_l < 4) {
                const int k = e_l; const int ex = k == 0 ? te[0] : k == 1 ? te[1] : k == 2 ? te[2] : te[3]; const float ww = k == 0 ? wk[0] : k == 1 ? wk[1] : k == 2 ? wk[2] : wk[3];
                const int rk = atomicAdd((int*)(cntL + ex), 1);
                const int n = nent + ti * 4 + k;
                entE[n] = (ex << 20) | rk; entW[n] = ww; entT[n] = (t0 + ti) * 4 + k;
            }
        }
        nent += 128; par ^= 1;
    }
    __syncthreads();
    if (tid < 32) baseL[tid] = cntL[tid] > 0 ? (int)atomicAdd(F.ctl + CW_CNT + 64 * l + tid, (unsigned)cntL[tid]) : 0;
    __syncthreads();
    int* list = (int*)(F.ws + WS_LIST); float* wtok = (float*)(F.ws + WS_WTOK);
    for (int n = tid; n < nent; n += 512) { const int er = entE[n], ex = er >> 20, rk = er & 0xfffff, ent = entT[n];
        list[(size_t)ex * TALL + baseL[ex] + rk] = ent; wtok[(size_t)ex * TALL + baseL[ex] + rk] = entW[n]; }
    __syncthreads();
}

constexpr int KS = 128;
constexpr int VS = 136;
constexpr int K_IMG = 64 * KS, V_IMG = 64 * VS, KV_PAIR = K_IMG + V_IMG;
#define MFMA32(a, b, c) __builtin_amdgcn_mfma_f32_32x32x16_bf16((a), (b), (c), 0, 0, 0)
DI int crow(int r, int h) { return (r & 3) + 8 * (r >> 2) + 4 * h; }
struct KVRegs { u32x4 k, v; };
DI KVRegs kv_load(const bf16_t* prj, int ld, int tok, int kcol, int vcol, int part) {
    (void)ld; KVRegs x; x.k = *(const u32x4*)(prj + pidx(tok, kcol + part * 8)); x.v = *(const u32x4*)(prj + pidx(tok, vcol + part * 8)); return x;
}
template <bool ROPE> DI void kv_write(const KVRegs& x, LAS unsigned char* Kb, LAS unsigned char* VTb, int key, int part, const float* gk, const LAS f32x2* rtab, int prow, int pcol) {
    float kf[8];
    kf[0] = bflo(x.k.x); kf[1] = bfhi(x.k.x); kf[2] = bflo(x.k.y); kf[3] = bfhi(x.k.y); kf[4] = bflo(x.k.z); kf[5] = bfhi(x.k.z); kf[6] = bflo(x.k.w); kf[7] = bfhi(x.k.w);
    float ss = 0.f;
#pragma unroll
    for (int i = 0; i < 8; ++i) ss += kf[i] * kf[i];
    ss += dpp_xor1(ss); ss += dpp_xor2(ss); ss += dpp_hmirror(ss);
    const float rs = 1.0f / sqrtf(ss * (1.f / 64.f) + EPS);
    const f32x4 g0 = *(const f32x4*)(gk + part * 8), g1 = *(const f32x4*)(gk + part * 8 + 4);
#pragma unroll
    for (int i = 0; i < 8; ++i) kf[i] *= rs * (i < 4 ? g0[i] : g1[i - 4]);
    if (ROPE) {
        const int pos = (part >> 2) ? pcol : prow, i0 = (part & 1) * 8; const bool isx2 = (part >> 1) & 1;
#pragma unroll
        for (int i = 0; i < 8; ++i) { const float pk = dpp_xor2(kf[i]); const f32x2 cs = rtab[pos * 16 + i0 + i];
            kf[i] = isx2 ? (pk * cs.y + kf[i] * cs.x) : (kf[i] * cs.x - pk * cs.y); }
    }
    u32x4 o; o.x = pk2(kf[0], kf[1]); o.y = pk2(kf[2], kf[3]); o.z = pk2(kf[4], kf[5]); o.w = pk2(kf[6], kf[7]);
    *(LAS u32x4*)(Kb + key * KS + ((part ^ ((key >> 1) & 7)) << 4)) = o;
    LAS unsigned short* vt = (LAS unsigned short*)(VTb + (part * 8) * VS + (((key >> 2) ^ part) * 4 + (key & 3)) * 2);
    vt[0 * (VS / 2)] = (unsigned short)(x.v.x & 0xffffu); vt[1 * (VS / 2)] = (unsigned short)(x.v.x >> 16);
    vt[2 * (VS / 2)] = (unsigned short)(x.v.y & 0xffffu); vt[3 * (VS / 2)] = (unsigned short)(x.v.y >> 16);
    vt[4 * (VS / 2)] = (unsigned short)(x.v.z & 0xffffu); vt[5 * (VS / 2)] = (unsigned short)(x.v.z >> 16);
    vt[6 * (VS / 2)] = (unsigned short)(x.v.w & 0xffffu); vt[7 * (VS / 2)] = (unsigned short)(x.v.w >> 16);
}
template <bool ROPE> DI void q_load(bf16x8 (&qf)[4], const bf16_t* qrow, int h, const float* gq, float scale, const LAS f32x2* rtab, int prow, int pcol) {
    float x[4][8]; float ss = 0.f;
#pragma unroll
    for (int ks = 0; ks < 4; ++ks) { const u32x4 w = *(const u32x4*)(qrow + 16 * ks + 8 * h);
        x[ks][0] = bflo(w.x); x[ks][1] = bfhi(w.x); x[ks][2] = bflo(w.y); x[ks][3] = bfhi(w.y); x[ks][4] = bflo(w.z); x[ks][5] = bfhi(w.z); x[ks][6] = bflo(w.w); x[ks][7] = bfhi(w.w);
#pragma unroll
        for (int j = 0; j < 8; ++j) ss += x[ks][j] * x[ks][j]; }
    ss = xhalf_sum(ss);
    const float rs = 1.0f / sqrtf(ss * (1.f / 64.f) + EPS);
#pragma unroll
    for (int ks = 0; ks < 4; ++ks) { const f32x4 g0 = *(const f32x4*)(gq + 16 * ks + 8 * h), g1 = *(const f32x4*)(gq + 16 * ks + 8 * h + 4);
#pragma unroll
        for (int j = 0; j < 8; ++j) x[ks][j] *= rs * (j < 4 ? g0[j] : g1[j - 4]); }
    if (ROPE) {
#pragma unroll
        for (int a = 0; a < 2; ++a) { const int pos = a ? pcol : prow;
#pragma unroll
            for (int j = 0; j < 8; ++j) { const f32x2 cs = rtab[pos * 16 + 8 * h + j]; const float x1 = x[2 * a][j], x2 = x[2 * a + 1][j];
                x[2 * a][j] = x1 * cs.x - x2 * cs.y; x[2 * a + 1][j] = x1 * cs.y + x2 * cs.x; } }
    }
#pragma unroll
    for (int ks = 0; ks < 4; ++ks) { u32x4 o; o.x = pk2(x[ks][0] * scale, x[ks][1] * scale); o.y = pk2(x[ks][2] * scale, x[ks][3] * scale); o.z = pk2(x[ks][4] * scale, x[ks][5] * scale); o.w = pk2(x[ks][6] * scale, x[ks][7] * scale);
        qf[ks] = __builtin_bit_cast(bf16x8, o); }
}
template <class MaskF> DI void attn_tile(const LAS unsigned char* Kimg, const LAS unsigned char* VTt, const int vtile, const bf16x8 (&qf)[4], f32x16 (&o)[2], float& m, float& l, int r32, int h, const MaskF& mask) {
    __builtin_amdgcn_sched_barrier(0);
    f32x16 s;
#pragma unroll
    for (int i = 0; i < 16; ++i) s[i] = 0.f;
#pragma unroll
    for (int ks = 0; ks < 4; ++ks) { const int kk = 32 * vtile + r32; const bf16x8 kf = *(const LAS bf16x8*)(Kimg + kk * KS + (((2 * ks + h) ^ ((kk >> 1) & 7)) << 4)); s = MFMA32(kf, qf[ks], s); }
    float mt = -1.0e30f;
    mask(s);
#pragma unroll
    for (int r = 0; r < 16; ++r) mt = fmaxf(mt, s[r]);
    mt = xhalf_max(mt);
    const float mn = fmaxf(m, mt), alpha = __builtin_amdgcn_exp2f(m - mn);
    m = mn;
    float ps = 0.f;
#pragma unroll
    for (int r = 0; r < 16; ++r) { s[r] = __builtin_amdgcn_exp2f(s[r] - mn); ps += s[r]; }
    l = l * alpha + ps;
#pragma unroll
    for (int i = 0; i < 16; ++i) { o[0][i] *= alpha; o[1][i] *= alpha; }
    bf16x8 pa[2];
#pragma unroll
    for (int st = 0; st < 2; ++st) { u32x4 w; w.x = pk2(s[8 * st], s[8 * st + 1]); w.y = pk2(s[8 * st + 2], s[8 * st + 3]); w.z = pk2(s[8 * st + 4], s[8 * st + 5]); w.w = pk2(s[8 * st + 6], s[8 * st + 7]); pa[st] = __builtin_bit_cast(bf16x8, w); }
#pragma unroll
    for (int dvb = 0; dvb < 2; ++dvb)
#pragma unroll
        for (int st = 0; st < 2; ++st) {
            const int dv = 32 * dvb + r32, c0 = 8 * vtile + 4 * st + h;
            const LAS unsigned char* vrow = VTt + dv * VS;
            const u32x2 lo = *(const LAS u32x2*)(vrow + ((c0 ^ (dv >> 3)) << 3)), hi = *(const LAS u32x2*)(vrow + (((c0 + 2) ^ (dv >> 3)) << 3));
            u32x4 w; w.x = lo.x; w.y = lo.y; w.z = hi.x; w.w = hi.y;
            o[dvb] = MFMA32(__builtin_bit_cast(bf16x8, w), pa[st], o[dvb]);
        }
    __builtin_amdgcn_sched_barrier(0);
}
DI void attn_store(const f32x16 (&o)[2], float l, float extra, bf16_t* orow, int h) {
    const float lt = xhalf_sum(l) + extra;
    const float inv = 1.0f / lt;
#pragma unroll
    for (int dvb = 0; dvb < 2; ++dvb)
#pragma unroll
        for (int g = 0; g < 4; ++g) { u32x2 w; w.x = pk2(o[dvb][4 * g] * inv, o[dvb][4 * g + 1] * inv); w.y = pk2(o[dvb][4 * g + 2] * inv, o[dvb][4 * g + 3] * inv);
            *(u32x2*)(orow + 32 * dvb + 8 * g + 4 * h) = w; }
}

DI void phase_swa(const Frame& F, int l) {
    const int lane = lane_id(), tid = F.wave * 64 + lane, r32 = lane & 31, h = lane >> 5, key = tid >> 3, part = tid & 7;
    const bf16_t* PRJ = (const bf16_t*)(F.ws + WS_PRJ); bf16_t* OM = (bf16_t*)(F.ws + WS_OMIX);
    const int idx = l >> 1; const float* gq = inp(F, 18) + idx * 64; const float* gk = inp(F, 19) + idx * 64; const float* sinks = inp(F, 20) + idx * 16;
    LAS unsigned char* CTXI = F.lds;
    LAS unsigned char* RING = F.lds + 4 * KV_PAIR;
    LAS f32x2* rtab = (LAS f32x2*)(F.lds + 9 * KV_PAIR);
    for (int i = tid; i < 1024; i += 512) { const float ang = (float)(i >> 4) * exp2f(-(float)(i & 15) * (13.287712379549449f / 16.0f)); rtab[i] = (f32x2){cosf(ang), sinf(ang)}; }
    __syncthreads();
    const bool with_ctx = l < DEPTH - 1;
    const int nunits = 2048 + (with_ctx ? 128 : 0);
    const float qscale = 0.125f * LOG2E;
    const int u_lo = (int)(((long)F.blk * nunits) / F.G), u_hi = (int)(((long)(F.blk + 1) * nunits) / F.G);
    int cur_grp = -1, have_lo = 0, have_hi = -1;
    for (int u = u_lo; u < u_hi; ++u) {
        const bool is_ctx = u >= 2048;
        int b, kvh, qb, hh2; if (!is_ctx) { b = u >> 8; kvh = (u >> 7) & 1; qb = (u >> 1) & 63; hh2 = u & 1; } else { const int v = u - 2048; b = v >> 4; kvh = (v >> 3) & 1; qb = (v >> 1) & 3; hh2 = v & 1; }
        const int hq = kvh * 8 + hh2 * 4 + (F.wave >> 1), qs = F.wave & 1, q0 = qb * 64, a = q0 + 32 * qs, tq = a + r32;
        const int kcol = O_K + kvh * 64, vcol = O_V + kvh * 64;
        const int tokq = is_ctx ? TLAT + b * CTXL + tq : b * SEQ + tq;
        if (b * 2 + kvh != cur_grp) {
            cur_grp = b * 2 + kvh; have_lo = 0; have_hi = -1;
            KVRegs cx[4];
#pragma unroll
            for (int s = 0; s < 4; ++s) cx[s] = kv_load(PRJ, ODD_IN, TLAT + b * CTXL + 64 * s + key, kcol, vcol, part);
#pragma unroll
            for (int s = 0; s < 4; ++s) kv_write<false>(cx[s], CTXI + s * KV_PAIR, CTXI + s * KV_PAIR + K_IMG, key, part, gk, rtab, 0, 0);
        }
        const int need_lo = qb - 2 < 0 ? 0 : qb - 2, need_hi = qb + 2 > 63 ? 63 : qb + 2;
        if (!is_ctx) {
            const int first = have_hi + 1 > need_lo ? have_hi + 1 : need_lo;
#pragma unroll 1
            for (int kb = first; kb <= need_hi; ++kb) {
                const KVRegs x = kv_load(PRJ, ODD_IN, b * SEQ + 64 * kb + key, kcol, vcol, part);
                LAS unsigned char* Kn = RING + (kb % 5) * KV_PAIR; kv_write<true>(x, Kn, Kn + K_IMG, key, part, gk, rtab, kb, key);
            }
            have_lo = need_lo; have_hi = need_hi;
        }
        KVRegs pf; int pf_kb = -1;
        { const int nu = u + 1;
          if (!is_ctx && nu < u_hi && nu < 2048 && (nu >> 7) == (u >> 7)) { const int nqb = (nu >> 1) & 63; const int want = nqb + 2 > 63 ? 63 : nqb + 2;
              if (want > have_hi) { pf_kb = want; pf = kv_load(PRJ, ODD_IN, b * SEQ + 64 * want + key, kcol, vcol, part); } } }
        bf16x8 qf[4]; f32x16 o[2]; float m = -1.0e30f, lsum = 0.f;
        if (is_ctx) q_load<false>(qf, PRJ + pidx(tokq, O_Q + hq * 64), h, gq, qscale, rtab, 0, 0);
        else q_load<true>(qf, PRJ + pidx(tokq, O_Q + hq * 64), h, gq, qscale, rtab, tq >> 6, tq & 63);
#pragma unroll
        for (int i = 0; i < 16; ++i) { o[0][i] = 0.f; o[1][i] = 0.f; }
        __syncthreads();
#pragma unroll 1
        for (int s = 0; s < 4; ++s) {
            const LAS unsigned char* Kc = CTXI + s * KV_PAIR; const LAS unsigned char* Vc = Kc + K_IMG;
#pragma unroll
            for (int tt = 0; tt < 2; ++tt) attn_tile(Kc, Vc, tt, qf, o, m, lsum, r32, h, [](f32x16&) {});
        }
        if (!is_ctx) {
#pragma unroll 1
            for (int kb = need_lo; kb <= need_hi; ++kb) {
                const LAS unsigned char* Kc = RING + (kb % 5) * KV_PAIR; const LAS unsigned char* Vc = Kc + K_IMG;
#pragma unroll
                for (int tt = 0; tt < 2; ++tt) {
                    const int kt0 = 64 * kb + 32 * tt;
                    if (kt0 + 31 >= a - 128 && kt0 <= a + 31 + 128)
                        attn_tile(Kc, Vc, tt, qf, o, m, lsum, r32, h,
                                  [&](f32x16& sc) {
#pragma unroll
                                      for (int r = 0; r < 16; ++r) { const int kp = kt0 + crow(r, h); sc[r] = ((unsigned)(tq - kp + 128) <= 256u) ? sc[r] : -1.0e30f; } });
                }
            }
        }
        attn_store(o, lsum, __builtin_amdgcn_exp2f(sinks[hq] * LOG2E - m), OM + (size_t)tokq * D + hq * 64, h);
        __syncthreads();
        if (pf_kb >= 0) { LAS unsigned char* Kn = RING + (pf_kb % 5) * KV_PAIR; kv_write<true>(pf, Kn, Kn + K_IMG, key, part, gk, rtab, pf_kb, key); have_hi = pf_kb; }
    }
}

DI void na_units(const Frame& F, int l) {
    const int lane = lane_id(), tid = F.wave * 64 + lane, r32 = lane & 31, h = lane >> 5, key = tid >> 3, part = tid & 7;
    const bf16_t* PRJ = (const bf16_t*)(F.ws + WS_PRJ); bf16_t* OM = (bf16_t*)(F.ws + WS_OMIX);
    const int idx = l >> 1; const float* gq = inp(F, 13) + idx * 64; const float* gk = inp(F, 14) + idx * 64;
    LAS unsigned char* CTXI = F.lds;
    LAS unsigned char* RING = F.lds + 4 * KV_PAIR;
    LAS float* rpbL = (LAS float*)(F.lds + 6 * KV_PAIR);
    const bool with_ctx = l < DEPTH - 1;
    const int nunits = 1024 + (with_ctx ? 64 : 0);
    const float qscale = 0.125f * LOG2E;
    const float* rpb_all = inp(F, 15) + (size_t)idx * 8 * 465;
    const int u_lo = (int)(((long)F.blk * nunits) / F.G), u_hi = (int)(((long)(F.blk + 1) * nunits) / F.G);
    int cur_grp = -1;
    for (int u = u_lo; u < u_hi; ++u) {
        const bool is_ctx = u >= 1024;
        int b, hh, rg; if (!is_ctx) { b = u >> 7; hh = (u >> 4) & 7; rg = u & 15; } else { const int v = u - 1024; b = v >> 3; hh = v & 7; rg = 0; }
        const int R0 = 4 * rg, R = R0 + (F.wave >> 1), qh = F.wave & 1, c = 32 * qh + r32;
        const int kcol = C_NK + hh * 64, vcol = C_NV + hh * 64;
        const int tokq = is_ctx ? TLAT + b * CTXL + 32 * F.wave + r32 : b * SEQ + R * 64 + c;
        if (b * 8 + hh != cur_grp) {
            cur_grp = b * 8 + hh;
            KVRegs cx[4];
#pragma unroll
            for (int s = 0; s < 4; ++s) cx[s] = kv_load(PRJ, EVEN_LD, TLAT + b * CTXL + 64 * s + key, kcol, vcol, part);
            const float* rp = rpb_all + (size_t)hh * 465; for (int i = tid; i < 465; i += 512) rpbL[i] = rp[i] * LOG2E;
#pragma unroll
            for (int s = 0; s < 4; ++s) kv_write<false>(cx[s], CTXI + s * KV_PAIR, CTXI + s * KV_PAIR + K_IMG, key, part, gk, (const LAS f32x2*)nullptr, 0, 0);
        }
        bf16x8 qf[4]; f32x16 o[2]; float m = -1.0e30f, lsum = 0.f;
        q_load<false>(qf, PRJ + pidx(tokq, C_NQ + hh * 64), h, gq, qscale, (const LAS f32x2*)nullptr, 0, 0);
#pragma unroll
        for (int i = 0; i < 16; ++i) { o[0][i] = 0.f; o[1][i] = 0.f; }
        const int sR = R - 4 < 0 ? 0 : (R - 4 > 56 ? 56 : R - 4);
        const int klo = R0 - 4 < 0 ? 0 : (R0 - 4 > 56 ? 56 : R0 - 4), khi = (R0 - 1 < 0 ? 0 : (R0 - 1 > 56 ? 56 : R0 - 1)) + 7;
        const int nrow = is_ctx ? 0 : (khi - klo + 1);
        KVRegs nx;
        if (!is_ctx) nx = kv_load(PRJ, EVEN_LD, b * SEQ + klo * 64 + key, kcol, vcol, part);
        __syncthreads();
#pragma unroll 1
        for (int s = 0; s < 4; ++s) {
            const LAS unsigned char* Kc = CTXI + s * KV_PAIR; const LAS unsigned char* Vc = Kc + K_IMG;
#pragma unroll
            for (int tt = 0; tt < 2; ++tt) attn_tile(Kc, Vc, tt, qf, o, m, lsum, r32, h, [](f32x16&) {});
        }
        if (!is_ctx) {
            kv_write<false>(nx, RING, RING + K_IMG, key, part, gk, (const LAS f32x2*)nullptr, 0, 0);
            __syncthreads();
            const int w0 = c - 8 < 0 ? 0 : (c - 8 > 48 ? 48 : c - 8);
            for (int s = 0; s < nrow; ++s) {
                const bool more = s + 1 < nrow;
                if (more) nx = kv_load(PRJ, EVEN_LD, b * SEQ + (klo + s + 1) * 64 + key, kcol, vcol, part);
                const LAS unsigned char* Kc = RING + (s & 1) * KV_PAIR; const LAS unsigned char* Vc = Kc + K_IMG;
                const int kr = klo + s;
                if (kr >= sR && kr < sR + 8) {
                    const LAS float* brow = rpbL + (kr - R + 7) * 31 + 15 - c;
#pragma unroll
                    for (int tt = 0; tt < 2; ++tt)
                        attn_tile(Kc, Vc, tt, qf, o, m, lsum, r32, h,
                                  [&](f32x16& sc) { float bv[16];
#pragma unroll
                                      for (int r = 0; r < 16; ++r) { const int kc = 32 * tt + crow(r, h); const int bi = kc < w0 ? w0 : (kc > w0 + 15 ? w0 + 15 : kc); bv[r] = brow[bi]; }
#pragma unroll
                                      for (int r = 0; r < 16; ++r) { const int kc = 32 * tt + crow(r, h); const unsigned ok = (unsigned)(kc - w0) < 16u; sc[r] = ok ? sc[r] + bv[r] : -1.0e30f; } });
                }
                if (more) { LAS unsigned char* Kn = RING + ((s + 1) & 1) * KV_PAIR; kv_write<false>(nx, Kn, Kn + K_IMG, key, part, gk, (const LAS f32x2*)nullptr, 0, 0); }
                __syncthreads();
            }
        }
        attn_store(o, lsum, 0.f, OM + (size_t)tokq * D + 512 + hh * 64, h);
        __syncthreads();
    }
}

constexpr int GLA_CH = 68, GLA_ITEMS = NBATCH * 4 * 2 * GLA_CH;
DI int gla_tok0(int b, int dir, int p) { const int q = dir ? (p < 4 ? 3 - p : 67 - p) : (p < 4 ? p : p - 4); return p < 4 ? TLAT + b * CTXL + 64 * q : b * SEQ + 64 * q; }
DI float logsig16(float z) { return (fminf(z, 0.f) - __logf(1.0f + __expf(-fabsf(z)))) * (1.0f / 16.0f); }
constexpr int GT_STRIDE = 136;
DI void gla_local(const Frame& F, int l, int it_begin, int it_end) {
    const int lane = lane_id(), r32 = lane & 31, h = lane >> 5;
    const bf16_t* PRJ = (const bf16_t*)(F.ws + WS_PRJ);
    const int idx = l >> 1;
    LAS unsigned char* KT = F.lds + F.wave * 17408;
    LAS unsigned char* VT = KT + 8704;
    bf16_t* Ug = (bf16_t*)(F.ws + WS_GU); float* Dg = (float*)(F.ws + WS_GD); bf16_t* QTg = (bf16_t*)(F.ws + WS_GQ); bf16_t* KTg = (bf16_t*)(F.ws + WS_GK);
    const float* wa2 = inp(F, 10) + (size_t)idx * 2 * 16 * 256; const float* ba2 = inp(F, 11) + idx * 2 * 256;
    for (int it = it_begin + F.wave; it < it_end; it += 8) {
        const int ch = it / GLA_CH, p = it % GLA_CH, dir = ch & 1, hd = (ch >> 1) & 3, b = ch >> 3;
        const int tok0 = gla_tok0(b, dir, p);
        { const bf16_t* ap = PRJ + pidx(tok0 + lane, dir ? C_AB : C_AF); const u32x4 a0 = *(const u32x4*)ap, a1 = *(const u32x4*)(ap + 8);
          *(LAS u32x4*)(VT + lane * 32) = a0; *(LAS u32x4*)(VT + lane * 32 + 16) = a1; }
        float w[16];
#pragma unroll
        for (int r = 0; r < 16; ++r) w[r] = wa2[((size_t)dir * 16 + r) * 256 + hd * 64 + lane];
        const float bb = ba2[dir * 256 + hd * 64 + lane];
        const bf16_t* kp = PRJ + pidx(tok0, C_K + hd * 64) + lane;
        const bf16_t* qp = PRJ + pidx(tok0, C_Q + hd * 64) + lane;
        LDS_WAIT();
        float g[64]; float tot = 0.f;
#pragma unroll
        for (int t = 0; t < 64; ++t) {
            const u32x4 a0 = *(const LAS u32x4*)(VT + t * 32), a1 = *(const LAS u32x4*)(VT + t * 32 + 16);
            float z = bb;
            z += bflo(a0.x) * w[0] + bfhi(a0.x) * w[1] + bflo(a0.y) * w[2] + bfhi(a0.y) * w[3] + bflo(a0.z) * w[4] + bfhi(a0.z) * w[5] + bflo(a0.w) * w[6] + bfhi(a0.w) * w[7];
            z += bflo(a1.x) * w[8] + bfhi(a1.x) * w[9] + bflo(a1.y) * w[10] + bfhi(a1.y) * w[11] + bflo(a1.z) * w[12] + bfhi(a1.z) * w[13] + bflo(a1.w) * w[14] + bfhi(a1.w) * w[15];
            g[t] = logsig16(z); tot += g[t];
        }
        Dg[(size_t)it * 64 + lane] = __expf(tot);
        float run = 0.f;
        bf16_t* qo = QTg + ((size_t)dir * TALL + tok0) * 256 + hd * 64 + lane; bf16_t* ko = KTg + ((size_t)dir * TALL + tok0) * 256 + hd * 64 + lane;
#pragma unroll
        for (int c8 = 0; c8 < 8; ++c8) {
            unsigned short kr[8], qr[8];
#pragma unroll
            for (int e = 0; e < 8; ++e) { kr[e] = kp[(size_t)(8 * c8 + e) * 64]; qr[e] = qp[(size_t)(8 * c8 + e) * 64]; }
            float kh[8];
#pragma unroll
            for (int e = 0; e < 8; ++e) {
                const int t = 8 * c8 + e;
                const float C = dir ? (tot - run) : (run + g[t]);
                run += g[t];
                const float kf = bf2f(kr[e]), qf_ = bf2f(qr[e]);
                kh[e] = kf * __expf(tot - C);
                ko[(size_t)t * 256] = (bf16_t)f2bf(kf * __expf(-C));
                qo[(size_t)t * 256] = (bf16_t)f2bf(qf_ * 0.125f * __expf(C));
            }
#pragma unroll
            for (int e = 0; e < 8; e += 2) *(LAS unsigned*)(KT + lane * GT_STRIDE + (8 * c8 + e) * 2) = pk2(kh[e], kh[e + 1]);
        }
        LDS_WAIT();
#pragma unroll 1
        for (int hv = 0; hv < 2; ++hv) {
            const bf16_t* vp = PRJ + pidx(tok0, C_V + hd * 128 + 64 * hv) + lane;
            unsigned short vv[64];
#pragma unroll
            for (int t = 0; t < 64; ++t) vv[t] = vp[(size_t)t * 64];
#pragma unroll
            for (int t = 0; t < 64; t += 2) *(LAS unsigned*)(VT + lane * GT_STRIDE + t * 2) = (unsigned)vv[t] | ((unsigned)vv[t + 1] << 16);
            LDS_WAIT();
            f32x16 acc[2][2];
#pragma unroll
            for (int mb = 0; mb < 2; ++mb)
#pragma unroll
                for (int nb = 0; nb < 2; ++nb)
#pragma unroll
                    for (int i = 0; i < 16; ++i) acc[mb][nb][i] = 0.f;
#pragma unroll
            for (int ks = 0; ks < 4; ++ks) {
                bf16x8 af[2], bfr[2];
#pragma unroll
                for (int mb = 0; mb < 2; ++mb) { const LAS unsigned char* ap = KT + (32 * mb + r32) * GT_STRIDE + (16 * ks + 8 * h) * 2; const u32x2 lo = *(const LAS u32x2*)ap, hi = *(const LAS u32x2*)(ap + 8);
                    u32x4 x; x.x = lo.x; x.y = lo.y; x.z = hi.x; x.w = hi.y; af[mb] = __builtin_bit_cast(bf16x8, x); }
#pragma unroll
                for (int nb = 0; nb < 2; ++nb) { const LAS unsigned char* bp = VT + (32 * nb + r32) * GT_STRIDE + (16 * ks + 8 * h) * 2; const u32x2 lo = *(const LAS u32x2*)bp, hi = *(const LAS u32x2*)(bp + 8);
                    u32x4 x; x.x = lo.x; x.y = lo.y; x.z = hi.x; x.w = hi.y; bfr[nb] = __builtin_bit_cast(bf16x8, x); }
#pragma unroll
                for (int mb = 0; mb < 2; ++mb)
#pragma unroll
                    for (int nb = 0; nb < 2; ++nb) acc[mb][nb] = MFMA32(af[mb], bfr[nb], acc[mb][nb]);
            }
            bf16_t* up = Ug + (size_t)it * 8192 + (size_t)(64 * hv + r32) * 64;
#pragma unroll
            for (int mb = 0; mb < 2; ++mb)
#pragma unroll
                for (int nb = 0; nb < 2; ++nb)
#pragma unroll
                    for (int g = 0; g < 4; ++g) { u32x2 w; w.x = pk2(acc[mb][nb][4 * g], acc[mb][nb][4 * g + 1]); w.y = pk2(acc[mb][nb][4 * g + 2], acc[mb][nb][4 * g + 3]);
                        *(u32x2*)(up + (size_t)(32 * nb) * 64 + 32 * mb + 8 * g + 4 * h) = w; }
            LDS_WAIT();
        }
    }
}
DI void phase_even_a(const Frame& F, int l) {
    const int nunits = 1024 + (l < DEPTH - 1 ? 64 : 0);
    const int base = (((GLA_ITEMS + 8 * nunits + F.G - 1) / F.G) + 7) & ~7;
    auto ulo = [&](int j) -> int { return (int)(((long)j * nunits) / F.G); };
    int it_begin = base * F.blk - 8 * ulo(F.blk), it_end = base * (F.blk + 1) - 8 * ulo(F.blk + 1);
    if (it_begin > GLA_ITEMS) it_begin = GLA_ITEMS; if (it_end > GLA_ITEMS) it_end = GLA_ITEMS; if (F.blk == F.G - 1) it_end = GLA_ITEMS;
    gla_local(F, l, it_begin, it_end); __syncthreads(); na_units(F, l);
}

DI void phase_gla_scan(const Frame& F, int l) {
    const int lane = lane_id(), tid = F.wave * 64 + lane;
    const bf16_t* __restrict__ Ug = (const bf16_t*)(F.ws + WS_GU); const float* __restrict__ Dg = (const float*)(F.ws + WS_GD); bf16_t* __restrict__ ST = (bf16_t*)(F.ws + WS_GS);
    LAS float* DL = (LAS float*)F.lds;
    for (int wb = F.blk; wb < 256; wb += F.G) {
        const int w = wb * 512 + tid;
        const int ch = wb >> 2, dv = (w >> 4) & 127, dkg = w & 15;
        __syncthreads();
        for (int i = tid; i < GLA_CH * 16; i += 512) ((LAS f32x4*)DL)[i] = ((const f32x4*)(Dg + (size_t)ch * GLA_CH * 64))[i];
        float s[4] = {0.f, 0.f, 0.f, 0.f};
        const bf16_t* up = Ug + (size_t)ch * GLA_CH * 8192 + (size_t)dv * 64 + 4 * dkg; bf16_t* sp = ST + (size_t)ch * GLA_CH * 8192 + (size_t)dv * 64 + 4 * dkg;
        const LAS float* dl = DL + 4 * dkg;
#pragma unroll 1
        for (int p0 = 0; p0 < GLA_CH; p0 += 34) {
            u32x2 uw[34];
#pragma unroll
            for (int q = 0; q < 34; ++q) uw[q] = __builtin_nontemporal_load((const u32x2*)(up + (size_t)(p0 + q) * 8192));
            if (p0 == 0) __syncthreads();
#pragma unroll
            for (int q = 0; q < 34; ++q) {
                const f32x4 dk = *(const LAS f32x4*)(dl + (p0 + q) * 64);
                u32x2 o; o.x = pk2(s[0], s[1]); o.y = pk2(s[2], s[3]);
                *(u32x2*)(sp + (size_t)(p0 + q) * 8192) = o;
                s[0] = dk[0] * s[0] + bflo(uw[q].x); s[1] = dk[1] * s[1] + bfhi(uw[q].x); s[2] = dk[2] * s[2] + bflo(uw[q].y); s[3] = dk[3] * s[3] + bfhi(uw[q].y);
            }
        }
    }
    (void)l;
}

DI void phase_gla_out(const Frame& F, int l) {
    const int lane = lane_id(), r32 = lane & 31, h = lane >> 5;
    const bf16_t* PRJ = (const bf16_t*)(F.ws + WS_PRJ); bf16_t* OM = (bf16_t*)(F.ws + WS_OMIX); const bf16_t* ST = (const bf16_t*)(F.ws + WS_GS);
    const bf16_t* QTg = (const bf16_t*)(F.ws + WS_GQ); const bf16_t* KTg = (const bf16_t*)(F.ws + WS_GK);
    const int idx = l >> 1; const bool with_ctx = l < DEPTH - 1;
    LAS unsigned char* VT = F.lds;
    LAS float* SS = (LAS float*)(F.lds + 128 * GT_STRIDE);
    LAS unsigned char* QI = F.lds + 20480; LAS unsigned char* KI = QI + 16384; LAS unsigned char* SI = KI + 16384;
    const int iblk = F.wave & 1, dvq = F.wave >> 1;
    const float* gn = inp(F, 12) + idx * 128 + 32 * dvq;
    const int nitems = NBATCH * 4 * GLA_CH;
    for (int it = F.blk; it < nitems; it += F.G) {
        const int sc = it % GLA_CH, hd = (it / GLA_CH) & 3, b = it / (GLA_CH * 4);
        if (sc < 4 && !with_ctx) continue;
        const int tok0 = sc < 4 ? TLAT + b * CTXL + 64 * sc : b * SEQ + 64 * (sc - 4);
        const int ti = 32 * iblk + r32;
        unsigned short v0[8], v1[8];
        { const bf16_t* vp = PRJ + pidx(tok0 + 8 * F.wave, C_V + hd * 128) + lane; const bf16_t* vp1 = PRJ + pidx(tok0 + 8 * F.wave, C_V + hd * 128 + 64) + lane;
#pragma unroll
          for (int e = 0; e < 8; ++e) { v0[e] = vp[(size_t)e * 64]; v1[e] = vp1[(size_t)e * 64]; } }
        const int odir = iblk ? 0 : 1, ojb = 1 - iblk;
        size_t item[2];
#pragma unroll
        for (int dir = 0; dir < 2; ++dir) { const int pp = dir ? (sc < 4 ? 3 - sc : 71 - sc) : sc; item[dir] = (size_t)(((b * 4 + hd) * 2 + dir) * GLA_CH + pp); }
        u32x4 stg[8];
        const int srow = lane >> 3, scc = lane & 7;
        LAS unsigned char* ibase;
        { const bf16_t* gbase; int rstride;
          if (F.wave < 4) { const int dir = F.wave & 1; gbase = (F.wave < 2 ? QTg : KTg) + ((size_t)dir * TALL + tok0) * 256 + hd * 64; rstride = 256; ibase = (F.wave < 2 ? QI : KI) + dir * 8192; }
          else { const int dir = (F.wave - 4) >> 1, half = (F.wave - 4) & 1; gbase = ST + item[dir] * 8192 + (size_t)half * 4096; rstride = 64; ibase = SI + dir * 16384 + half * 8192; }
#pragma unroll
          for (int pc = 0; pc < 8; ++pc) stg[pc] = __builtin_nontemporal_load((const u32x4*)(gbase + (size_t)(8 * pc + srow) * rstride + 8 * scc)); }
#pragma unroll
        for (int pc = 0; pc < 8; ++pc) { const int row = 8 * pc + srow; *(LAS u32x4*)(ibase + row * 128 + ((scc ^ ((row >> 1) & 7)) << 4)) = stg[pc]; }
#pragma unroll
        for (int e = 0; e < 8; e += 2) { *(LAS unsigned*)(VT + lane * GT_STRIDE + (8 * F.wave + e) * 2) = (unsigned)v0[e] | ((unsigned)v0[e + 1] << 16);
            *(LAS unsigned*)(VT + (lane + 64) * GT_STRIDE + (8 * F.wave + e) * 2) = (unsigned)v1[e] | ((unsigned)v1[e + 1] << 16); }
        __syncthreads();
        u32x4 qw[2][4], kd[2][4], ko[4], sw[2][4];
        { const int tk = 32 * ojb + r32, dvr = 32 * dvq + r32;
#pragma unroll
          for (int ks = 0; ks < 4; ++ks) { const int cq = ((h + 2 * ks) ^ ((ti >> 1) & 7)) << 4, ck = ((h + 2 * ks) ^ ((tk >> 1) & 7)) << 4, cs = ((h + 2 * ks) ^ ((dvr >> 1) & 7)) << 4;
#pragma unroll
            for (int dir = 0; dir < 2; ++dir) { qw[dir][ks] = *(const LAS u32x4*)(QI + dir * 8192 + ti * 128 + cq); kd[dir][ks] = *(const LAS u32x4*)(KI + dir * 8192 + ti * 128 + cq);
                sw[dir][ks] = *(const LAS u32x4*)(SI + dir * 16384 + dvr * 128 + cs); }
            ko[ks] = *(const LAS u32x4*)(KI + odir * 8192 + tk * 128 + ck); } }
        f32x16 o;
#pragma unroll
        for (int i = 0; i < 16; ++i) o[i] = 0.f;
#pragma unroll
        for (int dir = 0; dir < 2; ++dir) {
#pragma unroll
            for (int blkk = 0; blkk < 2; ++blkk) {
                if (blkk == 1 && dir != odir) continue;
                const int jb = blkk ? ojb : iblk;
                f32x16 sacc;
#pragma unroll
                for (int i = 0; i < 16; ++i) sacc[i] = 0.f;
#pragma unroll
                for (int ks = 0; ks < 4; ++ks) sacc = MFMA32(__builtin_bit_cast(bf16x8, blkk ? ko[ks] : kd[dir][ks]), __builtin_bit_cast(bf16x8, qw[dir][ks]), sacc);
                if (blkk == 0) {
#pragma unroll
                    for (int r = 0; r < 16; ++r) { const int j = 32 * jb + crow(r, h); const bool keep = dir == 0 ? (j <= ti) : (j >= ti); sacc[r] = keep ? sacc[r] : 0.f; }
                }
#pragma unroll
                for (int st = 0; st < 2; ++st) {
                    u32x4 pw; pw.x = pk2(sacc[8 * st], sacc[8 * st + 1]); pw.y = pk2(sacc[8 * st + 2], sacc[8 * st + 3]); pw.z = pk2(sacc[8 * st + 4], sacc[8 * st + 5]); pw.w = pk2(sacc[8 * st + 6], sacc[8 * st + 7]);
                    const LAS unsigned char* vp = VT + (32 * dvq + r32) * GT_STRIDE + (32 * jb + 16 * st + 4 * h) * 2;
                    const u32x2 lo = *(const LAS u32x2*)vp, hi = *(const LAS u32x2*)(vp + 16);
                    u32x4 vw; vw.x = lo.x; vw.y = lo.y; vw.z = hi.x; vw.w = hi.y;
                    o = MFMA32(__builtin_bit_cast(bf16x8, vw), __builtin_bit_cast(bf16x8, pw), o);
                }
            }
#pragma unroll
            for (int ks = 0; ks < 4; ++ks) o = MFMA32(__builtin_bit_cast(bf16x8, sw[dir][ks]), __builtin_bit_cast(bf16x8, qw[dir][ks]), o);
        }
        float ss = 0.f;
#pragma unroll
        for (int i = 0; i < 16; ++i) ss += o[i] * o[i];
        ss = xhalf_sum(ss);
        if (h == 0) SS[dvq * 64 + ti] = ss;
        const bf16_t* gp = PRJ + pidx(tok0 + ti, C_G + hd * 128 + 32 * dvq);
        u32x2 gw[4]; f32x4 gv[4];
#pragma unroll
        for (int g = 0; g < 4; ++g) { gw[g] = *(const u32x2*)(gp + 8 * g + 4 * h); gv[g] = *(const f32x4*)(gn + 8 * g + 4 * h); }
        __syncthreads();
        const float tot = SS[ti] + SS[64 + ti] + SS[128 + ti] + SS[192 + ti];
        const float rs = 1.0f / sqrtf(tot * (1.f / 128.f) + EPS);
        bf16_t* op = OM + (size_t)(tok0 + ti) * D + hd * 128 + 32 * dvq;
#pragma unroll
        for (int g = 0; g < 4; ++g) {
            const float g0 = bflo(gw[g].x), g1 = bfhi(gw[g].x), g2 = bflo(gw[g].y), g3 = bfhi(gw[g].y);
            u32x2 ow; ow.x = pk2(o[4 * g] * rs * gv[g][0] * silu_f(g0), o[4 * g + 1] * rs * gv[g][1] * silu_f(g1)); ow.y = pk2(o[4 * g + 2] * rs * gv[g][2] * silu_f(g2), o[4 * g + 3] * rs * gv[g][3] * silu_f(g3));
            *(u32x2*)(op + 8 * g + 4 * h) = ow;
        }
        __syncthreads();
    }
}

constexpr int N_PHASES = 2 + 10 * DEPTH;
#ifndef NB_CONV
#define NB_CONV 48
#endif
#ifndef NB_CONV_ODD
#define NB_CONV_ODD 64
#endif
struct Args { const float* in[27]; float* out; unsigned char* ws; int ph_lo, ph_hi; };
#define PH_IN(k) (lo <= (k) && (k) < hi)
#define PH_BAR(k) do { if (PH_IN(k) && PH_IN((k) + 1)) xcd_barrier(bar); } while (0)
template <int l> DI void layer_program(Frame& F, const XcdBarrier& bar, const int lo, const int hi) {
    constexpr int pb = 2 + 10 * l;
    constexpr bool odd = (l & 1) != 0, with_ctx = l < DEPTH - 1;
    if (PH_IN(pb)) {
        DenseSched S; S.ord.init(TALL / 256, odd ? 5 : 13, F.G, F.blk); S.A = (const char*)(F.ws + WS_H);
        S.B = (const char*)(F.ws + (odd ? WS_WINO + (size_t)(l >> 1) * ODD_IN * 2048 : WS_WINE + (size_t)(l >> 1) * EVEN_LD * 2048));
        EpiPrj E{(bf16_t*)(F.ws + WS_PRJ), odd ? ODD_IN : EVEN_LD};
        pg8::gemm_phase<EpiPrj, DenseSched, false>(F.lds, S, E, F.wave, (LAS unsigned*)(F.lds + MISC_OFF + 1024));
    }
    PH_BAR(pb);
    if (PH_IN(pb + 1)) {
        constexpr int NBC = odd ? NB_CONV_ODD : NB_CONV;
        if (NBC > 0 && F.blk >= F.G - NBC) convert_moe_layer(F, l, F.blk - (F.G - NBC), NBC);
        else { Frame Fm = F; Fm.G = F.G - NBC; if (odd) phase_swa(Fm, l); else phase_even_a(Fm, l); }
    }
    PH_BAR(pb + 1);
    if (!odd) {
        if (PH_IN(pb + 2)) phase_gla_scan(F, l);
        PH_BAR(pb + 2);
        if (PH_IN(pb + 3)) phase_gla_out(F, l);
        PH_BAR(pb + 3);
    }
    if (PH_IN(pb + 4)) {
        if (F.blk & 4) { __builtin_amdgcn_s_sleep(127); __builtin_amdgcn_s_sleep(64); }
        DenseSched S; S.ord.init(TLAT / 256, 4, F.G, F.blk); S.A = (const char*)(F.ws + WS_OMIX); S.B = (const char*)(F.ws + WS_WOUT + (size_t)l * 1024 * 2048);
        bf16_t* X = (bf16_t*)(F.ws + WS_X);
        EpiRes<l == 0> E{inp(F, 0), inp(F, 2), X, modv(F, l, 0) + 2048};
        pg8::gemm_phase<EpiRes<l == 0>, DenseSched, false>(F.lds, S, E, F.wave, (LAS unsigned*)(F.lds + MISC_OFF + 1024));
    }
    PH_BAR(pb + 4);
    if (PH_IN(pb + 5)) {
        constexpr int NCX = with_ctx ? (TCTX / 256) * 4 : 0;
        if (with_ctx && F.G > 2 * NCX) {
            if (F.blk < NCX) {
                DenseSched S; S.ord.init(TCTX / 256, 4, NCX, F.blk); S.pm0 = TLAT / 256; S.A = (const char*)(F.ws + WS_OMIX); S.B = (const char*)(F.ws + WS_WOUT + (size_t)l * 1024 * 2048);
                bf16_t* X = (bf16_t*)(F.ws + WS_X);
                EpiRes<l == 0> E{inp(F, 0), inp(F, 2), X, modv(F, l, 0) + 2048};
                pg8::gemm_phase<EpiRes<l == 0>, DenseSched, false>(F.lds, S, E, F.wave, (LAS unsigned*)(F.lds + MISC_OFF + 1024));
                dep_signal(F.wave, F.ctl + CW_DEP + 64 * l);
            } else {
                Frame Fr = F; Fr.blk = F.blk - NCX; Fr.G = F.G - NCX; phase_router(Fr, l, 0, TLAT / 32);
                dep_wait(F.wave, F.ctl + CW_DEP + 64 * l, NCX, F.ctl + CW_BAR);
                {
                    const int Gr = Fr.G, bb = Fr.blk, NL = TLAT / 32, NC = (TALL - TLAT) / 32, lo_g = (int)(((long)bb * NL) / Gr), hi_g = (int)(((long)(bb + 1) * NL) / Gr), nmin = NL / Gr;
                    const int nminblk = Gr - (NL % Gr);
                    if (NC <= nminblk) { const int rank = (hi_g - lo_g == nmin) ? ((NL % Gr) ? (nmin + 1) * bb - lo_g : bb) : NC;
                        Frame F1 = Fr; F1.G = 1; F1.blk = 0; const int gsel = rank < NC ? NL + rank : NL; phase_router(F1, l, gsel, rank < NC ? gsel + 1 : gsel); }
                    else { Fr.blk = Fr.G - 1 - Fr.blk; phase_router(Fr, l, NL, NL + NC); }
                }
            }
        } else {
            if (with_ctx) {
                DenseSched S; S.ord.init(TCTX / 256, 4, F.G, F.blk); S.pm0 = TLAT / 256; S.A = (const char*)(F.ws + WS_OMIX); S.B = (const char*)(F.ws + WS_WOUT + (size_t)l * 1024 * 2048);
                bf16_t* X = (bf16_t*)(F.ws + WS_X);
                EpiRes<l == 0> E{inp(F, 0), inp(F, 2), X, modv(F, l, 0) + 2048};
                pg8::gemm_phase<EpiRes<l == 0>, DenseSched, false>(F.lds, S, E, F.wave, (LAS unsigned*)(F.lds + MISC_OFF + 1024));
                xcd_barrier(bar);
            }
            phase_router(F, l, 0, TLAT / 32);
        }
    }
    PH_BAR(pb + 5);
    if (with_ctx && !(F.G > 2 * (TCTX / 256) * 4)) {
        if (PH_IN(pb + 6)) phase_router(F, l, TLAT / 32, TALL / 32);
        PH_BAR(pb + 6);
    }
    if (PH_IN(pb + 7)) {
        LAS int* ts = (LAS int*)(F.lds + MISC_OFF); LAS int* cn = ts + 64;
        moe_tables_build(F, l, ts, cn);
        MoeSched<true> S; S.T.tstart = ts; S.T.cnt = cn; S.ord.init(ts[NEXP], 8, F.G, F.blk); S.A = (const char*)(F.ws + WS_H); S.W = (const char*)(F.ws + WS_WGU + (size_t)l * 32 * 2048 * 2048); S.list = (const int*)(F.ws + WS_LIST); S.wlist = (const float*)(F.ws + WS_WTOK);
        EpiSwiglu E{(bf16_t*)(F.ws + WS_ACT), inp(F, 24) + (size_t)l * 32 * 2048};
        pg8::gemm_phase<EpiSwiglu, MoeSched<true>, true>(F.lds, S, E, F.wave, (LAS unsigned*)(F.lds + MISC_OFF + 1024));
    }
    PH_BAR(pb + 7);
    if (PH_IN(pb + 8)) {
        LAS int* ts = (LAS int*)(F.lds + MISC_OFF); LAS int* cn = ts + 64;
        moe_tables_build(F, l, ts, cn);
        MoeSched<false> S; S.T.tstart = ts; S.T.cnt = cn; S.ord.init(ts[NEXP], 4, F.G, F.blk); S.A = (const char*)(F.ws + WS_ACT); S.W = (const char*)(F.ws + WS_WDN + (size_t)l * 32 * 1024 * 2048); S.list = (const int*)(F.ws + WS_LIST); S.wlist = (const float*)(F.ws + WS_WTOK);
        EpiDown E{(bf16_t*)(F.ws + WS_Y), inp(F, 26) + (size_t)l * 32 * 1024};
        pg8::gemm_phase<EpiDown, MoeSched<false>, false>(F.lds, S, E, F.wave, (LAS unsigned*)(F.lds + MISC_OFF + 1024));
    }
    PH_BAR(pb + 8);
    if (PH_IN(pb + 9)) phase_combine(F, l);
    if (l < DEPTH - 1) PH_BAR(pb + 9);
}
__global__ void __launch_bounds__(512, 2) fwd_kernel(Args args) {
    extern __shared__ __attribute__((aligned(16))) unsigned char lds_raw[];
    Frame F; F.lds = (LAS unsigned char*)lds_raw; F.ws = args.ws; F.ctl = (unsigned*)(args.ws + WS_CTL); F.out = args.out;
    {
        const unsigned long long kp = (unsigned long long)__builtin_amdgcn_kernarg_segment_ptr(); unsigned klo = (unsigned)kp, khi = (unsigned)(kp >> 32);
        asm volatile("" : "+v"(klo), "+v"(khi)); klo = __builtin_amdgcn_readfirstlane(klo); khi = __builtin_amdgcn_readfirstlane(khi);
        F.in = (const float* const*)(((unsigned long long)khi << 32) | klo); }
    F.wave = __builtin_amdgcn_readfirstlane((int)(threadIdx.x >> 6)); F.G = gridDim.x; F.blk = blockIdx.x;
    const int lo = args.ph_lo, hi = args.ph_hi;
    if (threadIdx.x < 4) ((LAS unsigned*)(F.lds + XB_OFF))[threadIdx.x] = 0u;
    __syncthreads();
    XcdBarrier bar; bar.bar = F.ctl + CW_BAR; bar.x = 0; bar.st = (volatile LAS unsigned*)(F.lds + XB_OFF); bar.wave = F.wave;
    if (hi - lo > 1) bar = xcd_barrier_post(F.ctl + CW_BAR, (volatile LAS unsigned*)(F.lds + XB_OFF), F.wave);
    if (PH_IN(0)) phase_p0(F);
    PH_BAR(0);
    if (PH_IN(1)) phase_norm1_l0(F);
    PH_BAR(1);
    layer_program<0>(F, bar, lo, hi);
    layer_program<1>(F, bar, lo, hi);
    layer_program<2>(F, bar, lo, hi);
    layer_program<3>(F, bar, lo, hi);
}

#ifndef MK_PER_PHASE
#define MK_PER_PHASE 0
#endif
extern "C" void kernel_launch(void* const* d_in, const int* in_sizes, int n_in, void* d_out, int out_size, void* d_ws, size_t ws_size, hipStream_t stream) {
    static int grid = 0;
    if (grid == 0) {
        if (n_in != 27 || out_size != TLAT * D || ws_size < WS_END) { fprintf(stderr, "kernel_launch: unexpected problem shape (n_in %d, out %d, ws %zu < %zu)\n", n_in, out_size, ws_size, (size_t)WS_END); grid = -1; return; }
        int dev = 0, cus = 0, per_cu = 0;
        if (hipGetDevice(&dev) != hipSuccess || hipDeviceGetAttribute(&cus, hipDeviceAttributeMultiprocessorCount, dev) != hipSuccess) { grid = -1; return; }
        if (hipFuncSetAttribute((const void*)fwd_kernel, hipFuncAttributeMaxDynamicSharedMemorySize, LDS_BYTES) != hipSuccess) { fprintf(stderr, "kernel_launch: hipFuncSetAttribute failed\n"); grid = -1; return; }
        if (hipOccupancyMaxActiveBlocksPerMultiprocessor(&per_cu, (const void*)fwd_kernel, 512, LDS_BYTES) != hipSuccess || per_cu < 1) fprintf(stderr, "kernel_launch: occupancy query reports %d\n", per_cu);
        (void)hipGetLastError();
        grid = cus;
    }
    if (grid < 0) return;
    (void)hipMemsetAsync((char*)d_ws + WS_CTL, 0, CTL_ZERO_BYTES, stream);
    Args a{};
    for (int i = 0; i < 27; ++i) a.in[i] = (const float*)d_in[i];
    a.out = (float*)d_out; a.ws = (unsigned char*)d_ws;
#if MK_PER_PHASE
    for (int p = 0; p < N_PHASES; ++p) {
        const int l = (p - 2) / 10, q = (p - 2) % 10;
        if (p >= 2 && (((l & 1) && (q == 2 || q == 3)) || (l == DEPTH - 1 && q == 6))) continue;
        a.ph_lo = p; a.ph_hi = p + 1;
        hipLaunchKernelGGL(fwd_kernel, dim3(grid), dim3(512), LDS_BYTES, stream, a);
    }
#else
    a.ph_lo = 0; a.ph_hi = N_PHASES;
    hipLaunchKernelGGL(fwd_kernel, dim3(grid), dim3(512), LDS_BYTES, stream, a);
#endif
}
```
